# Optimizing an MI355X kernel written in HIP

```python
import jax, jax.numpy as jnp
from jax import lax
import numpy as np

D_MODEL = 1024
BATCH = 8
SEQ = 2048
DEPTH = 4

CTX_LEN = 256
GRID_W = 64
HEAD_DIM = 64
ROPE_THETA = 10000.0
NORM_EPS = 1e-6
NEG_INF = -1e30
Q_BLOCK = 128

NA_HEADS = 4
NA_KH = 8
NA_KW = 16
GB_Q_HEADS = 4
GB_KV_HEADS = 2
WC_Q_HEADS = 4
WC_KV_HEADS = 2
WC_WINDOW = 128
MLA_HEADS = 4
MLA_Q_RANK = 256
MLA_KV_RANK = 128
MLA_NOPE = 64
MLA_ROPE = 32
MLA_V = 64

N_BRANCH = 4
BRANCH_W = 256
MIX_W = N_BRANCH * BRANCH_W

D_FF = 3584
N_EXPERTS = 8
TOP_K = 2
N_DENSE = (DEPTH + 1) // 2
N_MOE = DEPTH // 2
ADA_W = 6 * D_MODEL

IN_SIZES = (NA_HEADS * HEAD_DIM, NA_HEADS * HEAD_DIM, NA_HEADS * HEAD_DIM,
            GB_Q_HEADS * HEAD_DIM, GB_KV_HEADS * HEAD_DIM, GB_KV_HEADS * HEAD_DIM,
            WC_Q_HEADS * HEAD_DIM, WC_KV_HEADS * HEAD_DIM, WC_KV_HEADS * HEAD_DIM,
            MLA_Q_RANK, MLA_KV_RANK + MLA_ROPE,
            N_BRANCH * D_MODEL)
IN_SPLITS = tuple(sum(IN_SIZES[: i + 1]) for i in range(len(IN_SIZES) - 1))
IN_W = sum(IN_SIZES)

kernel_name = 'hybrid_gated_mixer_dit_block'


def rmsnorm(x, g):
    xf = x.astype(jnp.float32)
    y = xf * lax.rsqrt(jnp.mean(xf * xf, axis=-1, keepdims=True) + NORM_EPS)
    return (y * g.astype(jnp.float32)).astype(x.dtype)


def modulate(xn, shift, scale):
    return xn * (1 + scale) + shift


def _axis_angles(pos, dim):
    inv = ROPE_THETA ** (-jnp.arange(0, dim, 2, dtype=jnp.float32) / dim)
    return pos.astype(jnp.float32)[:, None] * inv[None, :]


def axial_rope(n_tokens, rot_dim):
    t = jnp.arange(n_tokens)
    half = rot_dim // 2
    ang = jnp.concatenate([_axis_angles(t // GRID_W, half), _axis_angles(t % GRID_W, half)], axis=-1)
    return jnp.cos(ang), jnp.sin(ang)


def apply_rope(x, cos, sin):
    d2 = x.shape[-1] // 2
    x1, x2 = x[..., :d2], x[..., d2:]
    c, s = cos.astype(x.dtype), sin.astype(x.dtype)
    return jnp.concatenate([x1 * c - x2 * s, x1 * s + x2 * c], axis=-1)


def group_heads(q, n_kv):
    B, T, H, d = q.shape
    return q.reshape(B, T, n_kv, H // n_kv, d)


def dense_blocked_attn(q, k, v, scale):
    B, T, Hkv, G, dq = q.shape
    nb = T // Q_BLOCK
    qb = jnp.moveaxis(q.reshape(B, nb, Q_BLOCK, Hkv, G, dq), 1, 0)

    def one_block(qblk):
        s = jnp.einsum('bqhgd,bkhd->bhgqk', qblk, k, preferred_element_type=jnp.float32) * scale
        p = jax.nn.softmax(s, axis=-1).astype(v.dtype)
        return jnp.einsum('bhgqk,bkhd->bqhgd', p, v)

    out = lax.map(one_block, qb)
    return jnp.moveaxis(out, 0, 1).reshape(B, T, -1)


def sink_attn(q, k, v, sink, scale):
    B, T, Hkv, G, d = q.shape
    s = jnp.einsum('bqhgd,bkhd->bhgqk', q, k, preferred_element_type=jnp.float32) * scale
    s_sink = jnp.broadcast_to(sink.astype(jnp.float32).reshape(Hkv, G)[:, :, None, None], s.shape[:-1] + (1,))
    p = jax.nn.softmax(jnp.concatenate([s, s_sink], axis=-1), axis=-1)[..., :-1].astype(v.dtype)
    return jnp.einsum('bhgqk,bkhd->bqhgd', p, v).reshape(B, T, -1)


def window_sink_attn(q, k, v, kc, vc, sink, scale):
    B, S, Hkv, G, d = q.shape
    nb = S // Q_BLOCK
    nk = 3 * Q_BLOCK
    pad = ((0, 0), (Q_BLOCK, Q_BLOCK), (0, 0), (0, 0))
    kp = jnp.pad(k, pad).reshape(B, nb + 2, Q_BLOCK, Hkv, d)
    vp = jnp.pad(v, pad).reshape(B, nb + 2, Q_BLOCK, Hkv, d)
    kband = jnp.concatenate([kp[:, :-2], kp[:, 1:-1], kp[:, 2:]], axis=2)
    vband = jnp.concatenate([vp[:, :-2], vp[:, 1:-1], vp[:, 2:]], axis=2)
    qb = q.reshape(B, nb, Q_BLOCK, Hkv, G, d)
    qpos = jnp.arange(nb)[:, None] * Q_BLOCK + jnp.arange(Q_BLOCK)[None, :]
    kpos = jnp.arange(nb)[:, None] * Q_BLOCK - Q_BLOCK + jnp.arange(nk)[None, :]
    ok = ((jnp.abs(qpos[:, :, None] - kpos[:, None, :]) <= WC_WINDOW)
          & (kpos >= 0)[:, None, :] & (kpos < S)[:, None, :])
    s_loc = jnp.einsum('bnqhgd,bnkhd->bnhgqk', qb, kband, preferred_element_type=jnp.float32) * scale
    s_loc = jnp.where(ok[None, :, None, None], s_loc, NEG_INF)
    s_ctx = jnp.einsum('bnqhgd,bchd->bnhgqc', qb, kc, preferred_element_type=jnp.float32) * scale
    s_sink = jnp.broadcast_to(sink.astype(jnp.float32).reshape(Hkv, G)[:, :, None, None], s_loc.shape[:-1] + (1,))
    p = jax.nn.softmax(jnp.concatenate([s_loc, s_ctx, s_sink], axis=-1), axis=-1).astype(v.dtype)
    o = (jnp.einsum('bnhgqk,bnkhd->bnqhgd', p[..., :nk], vband)
         + jnp.einsum('bnhgqc,bchd->bnqhgd', p[..., nk:nk + kc.shape[1]], vc))
    return o.reshape(B, S, -1)


def natten_attn(q, k, v, kc, vc, rpb, scale):
    B, S, H, d = q.shape
    rows = S // GRID_W
    kh = min(NA_KH, rows)
    r = jnp.arange(rows)
    krow = jnp.clip(r - kh // 2, 0, rows - kh)[:, None] + jnp.arange(kh)[None, :]
    col = jnp.arange(GRID_W)
    cstart = jnp.clip(col - NA_KW // 2, 0, GRID_W - NA_KW)
    col_ok = (col[None, :] >= cstart[:, None]) & (col[None, :] < cstart[:, None] + NA_KW)
    dr = krow - r[:, None] + NA_KH - 1
    dc = jnp.clip(col[None, :] - col[:, None] + NA_KW - 1, 0, 2 * NA_KW - 2)
    bias = rpb.astype(jnp.float32)[:, dr[:, None, :, None], dc[None, :, None, :]]
    qg = q.reshape(B, rows, GRID_W, H, d)
    kwin = k.reshape(B, rows, GRID_W, H, d)[:, krow]
    vwin = v.reshape(B, rows, GRID_W, H, d)[:, krow]
    s_loc = jnp.einsum('brqhd,brjkhd->bhrqjk', qg, kwin, preferred_element_type=jnp.float32) * scale + bias[None]
    s_loc = jnp.where(col_ok[:, None, :], s_loc, NEG_INF)
    n_loc = kh * GRID_W
    s_loc = s_loc.reshape(B, H, rows, GRID_W, n_loc)
    s_ctx = jnp.einsum('brqhd,bchd->bhrqc', qg, kc, preferred_element_type=jnp.float32) * scale
    p = jax.nn.softmax(jnp.concatenate([s_loc, s_ctx], axis=-1), axis=-1).astype(v.dtype)
    p_loc = p[..., :n_loc].reshape(B, H, rows, GRID_W, kh, GRID_W)
    o = (jnp.einsum('bhrqjk,brjkhd->brqhd', p_loc, vwin)
         + jnp.einsum('bhrqc,bchd->brqhd', p[..., n_loc:], vc))
    return o.reshape(B, S, H * d)


def mixer_features(h, w_in_l, gb_qn, gb_kn, mla_qn, mla_kvn, mla_wqb_l, mla_wkvb_l, rope):
    B, T, _ = h.shape
    p = jnp.einsum('btd,de->bte', h, w_in_l)
    aq, ak, av, bq, bk, bv, cq, ck, cv, dqa, dkva, gate = jnp.split(p, IN_SPLITS, axis=-1)
    aq, ak, av = (t.reshape(B, T, NA_HEADS, HEAD_DIM) for t in (aq, ak, av))
    bq = rmsnorm(bq.reshape(B, T, GB_Q_HEADS, HEAD_DIM), gb_qn)
    bk = rmsnorm(bk.reshape(B, T, GB_KV_HEADS, HEAD_DIM), gb_kn)
    bv = bv.reshape(B, T, GB_KV_HEADS, HEAD_DIM)
    cq = cq.reshape(B, T, WC_Q_HEADS, HEAD_DIM)
    ck = ck.reshape(B, T, WC_KV_HEADS, HEAD_DIM)
    cv = cv.reshape(B, T, WC_KV_HEADS, HEAD_DIM)
    dq = jnp.einsum('btr,re->bte', rmsnorm(dqa, mla_qn), mla_wqb_l).reshape(B, T, MLA_HEADS, MLA_NOPE + MLA_ROPE)
    dkv_c, dk_pe = jnp.split(dkva, [MLA_KV_RANK], axis=-1)
    dkv = jnp.einsum('btr,re->bte', rmsnorm(dkv_c, mla_kvn), mla_wkvb_l).reshape(B, T, MLA_HEADS, MLA_NOPE + MLA_V)
    dk_nope, dv = jnp.split(dkv, [MLA_NOPE], axis=-1)
    dq_nope, dq_pe = jnp.split(dq, [MLA_NOPE], axis=-1)
    if rope is not None:
        cos_h, sin_h, cos_r, sin_r = rope
        ch, sh = cos_h[:, None, :], sin_h[:, None, :]
        bq, bk = apply_rope(bq, ch, sh), apply_rope(bk, ch, sh)
        cq, ck = apply_rope(cq, ch, sh), apply_rope(ck, ch, sh)
        dq_pe = apply_rope(dq_pe, cos_r[:, None, :], sin_r[:, None, :])
        dk_pe = apply_rope(dk_pe, cos_r, sin_r)
    dq = jnp.concatenate([dq_nope, dq_pe], axis=-1)
    dk = jnp.concatenate([dk_nope, jnp.broadcast_to(dk_pe[:, :, None, :], (B, T, MLA_HEADS, MLA_ROPE))], axis=-1)
    return (aq, ak, av), (bq, bk, bv), (cq, ck, cv), (dq, dk, dv), gate


def merge_branches(outs, gate, w_branch_l, w_out_l):
    B, T = gate.shape[:2]
    o = jnp.stack([t.reshape(B, T, BRANCH_W) for t in outs], axis=2)
    y = jnp.einsum('btnw,nwd->btnd', o, w_branch_l)
    g = jax.nn.sigmoid(gate.reshape(B, T, N_BRANCH, D_MODEL))
    return jnp.einsum('btd,de->bte', jnp.sum(g * y, axis=2), w_out_l)


def token_mixers(h, hc, w_in_l, rpb_l, gb_qn, gb_kn, sink_l, mla_qn, mla_kvn, mla_wqb_l, mla_wkvb_l,
                 w_branch_l, w_out_l, rope, with_ctx_out):
    scale = HEAD_DIM ** -0.5
    mla_scale = (MLA_NOPE + MLA_ROPE) ** -0.5
    (aq, ak, av), (bq, bk, bv), (cq, ck, cv), (dq, dk, dv), gate = mixer_features(
        h, w_in_l, gb_qn, gb_kn, mla_qn, mla_kvn, mla_wqb_l, mla_wkvb_l, rope)
    (aqc, akc, avc), (bqc, bkc, bvc), (cqc, ckc, cvc), (dqc, dkc, dvc), gate_c = mixer_features(
        hc, w_in_l, gb_qn, gb_kn, mla_qn, mla_kvn, mla_wqb_l, mla_wkvb_l, None)
    cat = lambda a, b: jnp.concatenate([a, b], axis=1)
    oa = natten_attn(aq, ak, av, akc, avc, rpb_l, scale)
    ob = dense_blocked_attn(group_heads(bq, GB_KV_HEADS), cat(bk, bkc), cat(bv, bvc), scale)
    oc = window_sink_attn(group_heads(cq, WC_KV_HEADS), ck, cv, ckc, cvc, sink_l, scale)
    od = dense_blocked_attn(group_heads(dq, MLA_HEADS), cat(dk, dkc), cat(dv, dvc), mla_scale)
    mix = merge_branches((oa, ob, oc, od), gate, w_branch_l, w_out_l)
    if not with_ctx_out:
        return mix, None
    oac = dense_blocked_attn(group_heads(aqc, NA_HEADS), akc, avc, scale)
    obc = dense_blocked_attn(group_heads(bqc, GB_KV_HEADS), bkc, bvc, scale)
    occ = sink_attn(group_heads(cqc, WC_KV_HEADS), ckc, cvc, sink_l, scale)
    odc = dense_blocked_attn(group_heads(dqc, MLA_HEADS), dkc, dvc, mla_scale)
    mix_c = merge_branches((oac, obc, occ, odc), gate_c, w_branch_l, w_out_l)
    return mix, mix_c


def swiglu(h, w1, w3, w2):
    a = jnp.einsum('btd,df->btf', h, w1)
    b = jnp.einsum('btd,df->btf', h, w3)
    return jnp.einsum('btf,fd->btd', jax.nn.silu(a) * b, w2)


def moe_swiglu(h, router, w1, w3, w2):
    logits = jnp.einsum('btd,de->bte', h, router, preferred_element_type=jnp.float32)
    top_val, top_idx = lax.top_k(logits, TOP_K)
    top_w = jax.nn.softmax(top_val, axis=-1)
    combine = jnp.einsum('btk,btke->bte', top_w,
                         jax.nn.one_hot(top_idx, N_EXPERTS, dtype=jnp.float32)).astype(h.dtype)
    out = jnp.zeros_like(h)
    for e in range(N_EXPERTS):
        out = out + combine[..., e:e + 1] * swiglu(h, w1[e], w3[e], w2[e])
    return out


def setup_inputs(seed: int = 0) -> dict:
    key = jax.random.key(seed)
    ks = jax.random.split(key, 32)
    D = D_MODEL

    def nrm(k, shape, s):
        return jax.random.normal(k, shape, jnp.float32) * s

    return {
        'x': nrm(ks[0], (BATCH, SEQ, D), 1.0),
        'c': nrm(ks[1], (BATCH, D), 1.0),
        'ctx': nrm(ks[2], (BATCH, CTX_LEN, D), 1.0),
        'c_ctx': nrm(ks[3], (D,), 1.0),
        'norm1_g': 1.0 + nrm(ks[4], (DEPTH, D), 0.02),
        'norm2_g': 1.0 + nrm(ks[5], (DEPTH, D), 0.02),
        'w_ada': nrm(ks[6], (DEPTH, D, ADA_W), 0.5 * D ** -0.5),
        'b_ada': nrm(ks[7], (DEPTH, ADA_W), 0.02),
        'w_in': nrm(ks[8], (DEPTH, D, IN_W), D ** -0.5),
        'na_rpb': nrm(ks[9], (DEPTH, NA_HEADS, 2 * NA_KH - 1, 2 * NA_KW - 1), 0.1),
        'gb_qnorm': 1.0 + nrm(ks[10], (DEPTH, HEAD_DIM), 0.02),
        'gb_knorm': 1.0 + nrm(ks[11], (DEPTH, HEAD_DIM), 0.02),
        'wc_sink': nrm(ks[12], (DEPTH, WC_Q_HEADS), 0.5),
        'mla_qnorm': 1.0 + nrm(ks[13], (DEPTH, MLA_Q_RANK), 0.02),
        'mla_kvnorm': 1.0 + nrm(ks[14], (DEPTH, MLA_KV_RANK), 0.02),
        'mla_wqb': nrm(ks[15], (DEPTH, MLA_Q_RANK, MLA_HEADS * (MLA_NOPE + MLA_ROPE)), MLA_Q_RANK ** -0.5),
        'mla_wkvb': nrm(ks[16], (DEPTH, MLA_KV_RANK, MLA_HEADS * (MLA_NOPE + MLA_V)), MLA_KV_RANK ** -0.5),
        'w_branch': nrm(ks[17], (DEPTH, N_BRANCH, BRANCH_W, D), BRANCH_W ** -0.5),
        'w_out': nrm(ks[18], (DEPTH, D, D), D ** -0.5),
        'ffn_w1': nrm(ks[19], (N_DENSE, D, D_FF), D ** -0.5),
        'ffn_w3': nrm(ks[20], (N_DENSE, D, D_FF), D ** -0.5),
        'ffn_w2': nrm(ks[21], (N_DENSE, D_FF, D), D_FF ** -0.5),
        'moe_router': nrm(ks[22], (N_MOE, D, N_EXPERTS), D ** -0.5),
        'moe_w1': nrm(ks[23], (N_MOE, N_EXPERTS, D, D_FF), D ** -0.5),
        'moe_w3': nrm(ks[24], (N_MOE, N_EXPERTS, D, D_FF), D ** -0.5),
        'moe_w2': nrm(ks[25], (N_MOE, N_EXPERTS, D_FF, D), D_FF ** -0.5),
        'final_g': 1.0 + nrm(ks[26], (D,), 0.02),
    }


def reference(x, c, ctx, c_ctx, norm1_g, norm2_g, w_ada, b_ada, w_in, na_rpb, gb_qnorm, gb_knorm, wc_sink,
              mla_qnorm, mla_kvnorm, mla_wqb, mla_wkvb, w_branch, w_out, ffn_w1, ffn_w3, ffn_w2,
              moe_router, moe_w1, moe_w3, moe_w2, final_g):
    S = x.shape[1]
    C = ctx.shape[1]
    rope = (*axial_rope(S, HEAD_DIM), *axial_rope(S, MLA_ROPE))
    silu_c = jax.nn.silu(c)
    silu_cc = jax.nn.silu(c_ctx)
    xc = ctx
    for l in range(DEPTH):
        with_ctx = l < DEPTH - 1
        mod = jnp.einsum('bd,de->be', silu_c, w_ada[l]) + b_ada[l]
        mod_c = jnp.einsum('d,de->e', silu_cc, w_ada[l]) + b_ada[l]
        sh1, sc1, g1, sh2, sc2, g2 = jnp.split(mod[:, None, :], 6, axis=-1)
        sh1c, sc1c, g1c, sh2c, sc2c, g2c = jnp.split(mod_c, 6, axis=-1)
        h = modulate(rmsnorm(x, norm1_g[l]), sh1, sc1)
        hc = modulate(rmsnorm(xc, norm1_g[l]), sh1c, sc1c)
        mix, mix_c = token_mixers(h, hc, w_in[l], na_rpb[l], gb_qnorm[l], gb_knorm[l], wc_sink[l],
                                  mla_qnorm[l], mla_kvnorm[l], mla_wqb[l], mla_wkvb[l],
                                  w_branch[l], w_out[l], rope, with_ctx)
        x = x + g1 * mix
        h2 = modulate(rmsnorm(x, norm2_g[l]), sh2, sc2)
        if with_ctx:
            xc = xc + g1c * mix_c
            h2c = modulate(rmsnorm(xc, norm2_g[l]), sh2c, sc2c)
            h2 = jnp.concatenate([h2c, h2], axis=1)
        if l % 2 == 0:
            f = swiglu(h2, ffn_w1[l // 2], ffn_w3[l // 2], ffn_w2[l // 2])
        else:
            f = moe_swiglu(h2, moe_router[l // 2], moe_w1[l // 2], moe_w3[l // 2], moe_w2[l // 2])
        if with_ctx:
            xc = xc + g2c * f[:, :C]
            f = f[:, C:]
        x = x + g2 * f
    return rmsnorm(x, final_g)
```

```cpp
#include <hip/hip_runtime.h>
#include <cstdio>
#include <cstdint>

#ifndef ONE_LAUNCH
#define ONE_LAUNCH 1
#endif

constexpr int D = 1024, BATCH = 8, SEQ = 2048, DEPTH = 4, CTX = 256, GW = 64;
constexpr int ML = BATCH * SEQ, MC = BATCH * CTX, MT = ML + MC;
constexpr int INW = 6304, DFF = 3584, NE = 8, ADAW = 6144;
constexpr int P_AQ = 0, P_AK = 256, P_AV = 512, P_BQ = 768, P_BK = 1024, P_BV = 1152, P_CQ = 1280, P_CK = 1536, P_CV = 1664,
              P_DQA = 1792, P_DKVA = 2048, P_GATE = 2208;
constexpr float EPS = 1e-6f;
constexpr int NTHREADS = 512, NWAVES = 8;
constexpr int MAXSLOT = 2 * MT + NE * 256;
constexpr int LDS_BYTES = 144 * 1024;

constexpr size_t al256(size_t x) { return (x + 255) & ~(size_t)255; }
constexpr size_t WS_CTL = 0;
constexpr size_t CTL_BYTES = 64 * 1024;
constexpr size_t WS_MOD = WS_CTL + CTL_BYTES;
constexpr size_t WS_ROPE = WS_MOD + al256((size_t)DEPTH * 9 * ADAW * 4);
constexpr size_t WS_HIST = WS_ROPE + al256((size_t)SEQ * 96 * 4);
constexpr size_t WS_TOPE = WS_HIST + al256(256 * 8 * 4);
constexpr size_t WS_TOPW = WS_TOPE + al256((size_t)MT * 2 * 4);
constexpr size_t WS_SLOT = WS_TOPW + al256((size_t)MT * 2 * 4);
constexpr size_t WS_ROWOF = WS_SLOT + al256((size_t)MT * 2 * 4);
constexpr size_t WS_PEXP = WS_ROWOF + al256((size_t)MAXSLOT * 4);
constexpr size_t WS_X = WS_PEXP + al256((size_t)(MAXSLOT / 128 + 64) * 4);
constexpr size_t WS_HB = WS_X + (size_t)MT * D * 4;
constexpr int INWP = 6400;
constexpr size_t WS_WIN = WS_HB + (size_t)MT * D * 2;
constexpr size_t WS_WMLA = WS_WIN + (size_t)DEPTH * INWP * D * 2;
constexpr size_t WS_WBR = WS_WMLA + (size_t)DEPTH * 1024 * 384 * 2;
constexpr size_t WS_WOUT = WS_WBR + (size_t)DEPTH * D * D * 2;
constexpr size_t WS_W13D = WS_WOUT + (size_t)DEPTH * D * D * 2;
constexpr size_t WS_W2D = WS_W13D + (size_t)2 * 2 * DFF * D * 2;
constexpr size_t WS_W13M = WS_W2D + (size_t)2 * D * DFF * 2;
constexpr size_t WS_W2M = WS_W13M + (size_t)NE * 2 * DFF * D * 2;
constexpr size_t WS_BIG = WS_W2M + (size_t)NE * D * DFF * 2;
constexpr size_t WS_QA = WS_BIG;
constexpr size_t WS_KA = WS_QA + (size_t)MT * 256 * 2;
constexpr size_t WS_VTA = WS_KA + (size_t)MT * 256 * 2;
constexpr size_t WS_QB = WS_VTA + (size_t)MT * 256 * 2;
constexpr size_t WS_KB = WS_QB + (size_t)MT * 256 * 2;
constexpr size_t WS_VTB = WS_KB + (size_t)MT * 128 * 2;
constexpr size_t WS_QC = WS_VTB + (size_t)MT * 128 * 2;
constexpr size_t WS_KC = WS_QC + (size_t)MT * 256 * 2;
constexpr size_t WS_VTC = WS_KC + (size_t)MT * 128 * 2;
constexpr size_t WS_QDN = WS_VTC + (size_t)MT * 128 * 2;
constexpr size_t WS_QDP = WS_QDN + (size_t)MT * 256 * 2;
constexpr size_t WS_KDN = WS_QDP + (size_t)MT * 128 * 2;
constexpr size_t WS_KPE = WS_KDN + (size_t)MT * 256 * 2;
constexpr size_t WS_VTD = WS_KPE + (size_t)MT * 32 * 2;
constexpr size_t WS_DA = WS_VTD + (size_t)MT * 256 * 2;
constexpr size_t WS_RSQ = WS_DA + (size_t)MT * 384 * 2;
constexpr size_t WS_RSKV = WS_RSQ + (size_t)MT * 4 * 4;
constexpr size_t WS_GATE = WS_RSKV + (size_t)MT * 4 * 4;
constexpr size_t WS_O = WS_GATE + (size_t)MT * 4096 * 2;
constexpr size_t WS_MIX = WS_O + (size_t)MT * D * 2;
constexpr size_t WS_END_A = WS_MIX + (size_t)MT * D * 2;
constexpr size_t WS_AS = WS_BIG;
constexpr size_t WS_ACT = WS_AS + (size_t)MAXSLOT * D * 2;
constexpr size_t WS_Y = WS_ACT + (size_t)MAXSLOT * DFF * 2;
constexpr int YSPLIT_P0 = 128;
constexpr size_t WS_Y2 = WS_Y + (size_t)MAXSLOT * D * 2;
constexpr size_t WS_END_F = WS_Y2 + (size_t)(MAXSLOT / 256 - YSPLIT_P0) * 256 * D * 2;
constexpr size_t WS_END = WS_END_A > WS_END_F ? WS_END_A : WS_END_F;
constexpr int GEMM_LDS_OFF = 1024;

#define XB_TMO      128
#define XB_XCNT(j)  (256  + 64 * (j))
#define XB_XSUB(j)  (1280 + 64 * (j))
#define XB_XGEN(j)  (2304 + 64 * (j))
#define XB_TOP      3328
#define XB_TOPGEN   3392
#define XCD_BAR_WORDS 3456
#define XB_SPIN_CAP (1u << 25)
#define LAS __attribute__((address_space(3)))

__device__ __forceinline__ unsigned xb_ld(unsigned* p)              { return __hip_atomic_load(p, __ATOMIC_RELAXED, __HIP_MEMORY_SCOPE_AGENT); }
__device__ __forceinline__ unsigned xb_add(unsigned* p, unsigned v) { return __hip_atomic_fetch_add(p, v, __ATOMIC_RELAXED, __HIP_MEMORY_SCOPE_AGENT); }
__device__ __forceinline__ unsigned xb_xcc_id() { return (unsigned)__builtin_amdgcn_s_getreg((3 << 11) | 20) & 0xFu; }
#define XB_SPIN(cond, bar) do { unsigned _sp = 0; while (cond) { __builtin_amdgcn_s_sleep(1); \
    if ((++_sp & 255u) == 0u) { if (xb_ld(&(bar)[XB_TMO])) break; if (_sp > XB_SPIN_CAP) { atomicAdd(&(bar)[XB_TMO], 1u); break; } } } } while (0)

struct XcdBarrier { unsigned* bar; unsigned x; volatile LAS unsigned* st; };

__device__ __forceinline__ XcdBarrier xcd_barrier_post(unsigned* bar, volatile LAS unsigned* st) {
    XcdBarrier b; b.bar = bar; b.x = xb_xcc_id(); b.st = st;
    if (threadIdx.x == 0) (void)xb_add(&bar[XB_XCNT(b.x)], 1u);
    return b;
}
__device__ __forceinline__ void xcd_barrier_complete(unsigned* bar, unsigned x, unsigned& nloc, unsigned& nx) {
    const unsigned G = gridDim.x * gridDim.y * gridDim.z;
    unsigned sum, cnt, mine, sp = 0u;
    for (;;) {
        sum = 0u; cnt = 0u; mine = 0u;
#pragma unroll
        for (unsigned j = 0; j < 16; ++j) { const unsigned c = xb_ld(&bar[XB_XCNT(j)]); sum += c; cnt += (c > 0u) ? 1u : 0u; mine = (j == x) ? c : mine; }
        if (sum == G) break;
        __builtin_amdgcn_s_sleep(1);
        if ((++sp & 255u) == 0u) { if (xb_ld(&bar[XB_TMO])) break; if (sp > XB_SPIN_CAP) { atomicAdd(&bar[XB_TMO], 1u); break; } }
    }
    nloc = mine > 0u ? mine : 1u; nx = cnt > 0u ? cnt : 1u;
}
__device__ __forceinline__ void xcd_barrier(const XcdBarrier& b) {
    asm volatile("s_waitcnt vmcnt(0)" ::: "memory");
    __syncthreads();
    if (threadIdx.x == 0) {
        unsigned* bar = b.bar;
        __builtin_amdgcn_s_waitcnt(0);
        unsigned nloc = b.st[0], nx = b.st[1];
        if (nloc == 0u) { xcd_barrier_complete(bar, b.x, nloc, nx); b.st[0] = nloc; b.st[1] = nx; }
        const unsigned old = xb_add(&bar[XB_XSUB(b.x)], 1u);
        const unsigned gen = old / nloc;
        if (old + 1u == (gen + 1u) * nloc) {
            __builtin_amdgcn_fence(__ATOMIC_RELEASE, "agent");
            asm volatile("s_waitcnt vmcnt(0)" ::: "memory");
            const unsigned og = xb_add(&bar[XB_TOP], 1u);
            const unsigned tg = og / nx;
            if (og + 1u == (tg + 1u) * nx) xb_add(&bar[XB_TOPGEN], 1u);
            else XB_SPIN(xb_ld(&bar[XB_TOPGEN]) == tg, bar);
            __builtin_amdgcn_fence(__ATOMIC_ACQUIRE, "agent");
            xb_add(&bar[XB_XGEN(b.x)], 1u);
            asm volatile("s_waitcnt vmcnt(0)" ::: "memory");
        } else {
            XB_SPIN(xb_ld(&bar[XB_XGEN(b.x)]) == gen, bar);
            __builtin_amdgcn_fence(__ATOMIC_ACQUIRE, "agent");
            asm volatile("s_waitcnt vmcnt(0)" ::: "memory");
        }
    }
    __syncthreads();
}

__device__ __forceinline__ float wave_sum(float v) {
#pragma unroll
    for (int o = 1; o < 64; o <<= 1) v += __shfl_xor(v, o);
    return v;
}
__device__ __forceinline__ float wave_max(float v) {
#pragma unroll
    for (int o = 1; o < 64; o <<= 1) v = fmaxf(v, __shfl_xor(v, o));
    return v;
}
__device__ __forceinline__ int opaque_tid() { int t = threadIdx.x; asm volatile("" : "+v"(t)); return t; }
__device__ __forceinline__ float siluf(float v) { return v / (1.f + expf(-v)); }
__device__ __forceinline__ float sigmoidf(float v) { return 1.f / (1.f + expf(-v)); }
__device__ __forceinline__ int modrow(int m) { return m < ML ? (m >> 11) : 8; }

struct Args { const float* in[27]; float* out; unsigned char* ws; int ph_lo, ph_hi; };

typedef const __attribute__((address_space(4))) Args* ArgsP;
struct Ctx {
    ArgsP a; float* lds;
    __device__ __forceinline__ const float* x() const { return a->in[0]; }
    __device__ __forceinline__ const float* c() const { return a->in[1]; }
    __device__ __forceinline__ const float* ctx() const { return a->in[2]; }
    __device__ __forceinline__ const float* c_ctx() const { return a->in[3]; }
    __device__ __forceinline__ const float* norm1_g() const { return a->in[4]; }
    __device__ __forceinline__ const float* norm2_g() const { return a->in[5]; }
    __device__ __forceinline__ const float* w_ada() const { return a->in[6]; }
    __device__ __forceinline__ const float* b_ada() const { return a->in[7]; }
    __device__ __forceinline__ const float* w_in() const { return a->in[8]; }
    __device__ __forceinline__ const float* na_rpb() const { return a->in[9]; }
    __device__ __forceinline__ const float* gb_qnorm() const { return a->in[10]; }
    __device__ __forceinline__ const float* gb_knorm() const { return a->in[11]; }
    __device__ __forceinline__ const float* wc_sink() const { return a->in[12]; }
    __device__ __forceinline__ const float* mla_qnorm() const { return a->in[13]; }
    __device__ __forceinline__ const float* mla_kvnorm() const { return a->in[14]; }
    __device__ __forceinline__ const float* mla_wqb() const { return a->in[15]; }
    __device__ __forceinline__ const float* mla_wkvb() const { return a->in[16]; }
    __device__ __forceinline__ const float* w_branch() const { return a->in[17]; }
    __device__ __forceinline__ const float* w_out() const { return a->in[18]; }
    __device__ __forceinline__ const float* ffn_w1() const { return a->in[19]; }
    __device__ __forceinline__ const float* ffn_w3() const { return a->in[20]; }
    __device__ __forceinline__ const float* ffn_w2() const { return a->in[21]; }
    __device__ __forceinline__ const float* moe_router() const { return a->in[22]; }
    __device__ __forceinline__ const float* moe_w1() const { return a->in[23]; }
    __device__ __forceinline__ const float* moe_w3() const { return a->in[24]; }
    __device__ __forceinline__ const float* moe_w2() const { return a->in[25]; }
    __device__ __forceinline__ const float* final_g() const { return a->in[26]; }
    __device__ __forceinline__ float* out() const { return a->out; }
    __device__ __forceinline__ float* MOD() const { return (float*)(a->ws + WS_MOD); }
    __device__ __forceinline__ float* ROPE() const { return (float*)(a->ws + WS_ROPE); }
    __device__ __forceinline__ unsigned short* X() const { return (unsigned short*)(a->ws + WS_X); }
    __device__ __forceinline__ float* TOPW() const { return (float*)(a->ws + WS_TOPW); }
    __device__ __forceinline__ unsigned short* ACT() const { return (unsigned short*)(a->ws + WS_ACT); }
    __device__ __forceinline__ unsigned short* Y() const { return (unsigned short*)(a->ws + WS_Y); }
    __device__ __forceinline__ unsigned short* Y2() const { return (unsigned short*)(a->ws + WS_Y2); }
    __device__ __forceinline__ unsigned short* HB() const { return (unsigned short*)(a->ws + WS_HB); }
    __device__ __forceinline__ unsigned short* AS() const { return (unsigned short*)(a->ws + WS_AS); }
    __device__ __forceinline__ unsigned short* W13D() const { return (unsigned short*)(a->ws + WS_W13D); }
    __device__ __forceinline__ unsigned short* W2D() const { return (unsigned short*)(a->ws + WS_W2D); }
    __device__ __forceinline__ unsigned short* W13M() const { return (unsigned short*)(a->ws + WS_W13M); }
    __device__ __forceinline__ unsigned short* W2M() const { return (unsigned short*)(a->ws + WS_W2M); }
    __device__ __forceinline__ unsigned short* QA() const { return (unsigned short*)(a->ws + WS_QA); }
    __device__ __forceinline__ unsigned short* KA() const { return (unsigned short*)(a->ws + WS_KA); }
    __device__ __forceinline__ unsigned short* VTA() const { return (unsigned short*)(a->ws + WS_VTA); }
    __device__ __forceinline__ unsigned short* QB() const { return (unsigned short*)(a->ws + WS_QB); }
    __device__ __forceinline__ unsigned short* KB() const { return (unsigned short*)(a->ws + WS_KB); }
    __device__ __forceinline__ unsigned short* VTB() const { return (unsigned short*)(a->ws + WS_VTB); }
    __device__ __forceinline__ unsigned short* QC() const { return (unsigned short*)(a->ws + WS_QC); }
    __device__ __forceinline__ unsigned short* KC() const { return (unsigned short*)(a->ws + WS_KC); }
    __device__ __forceinline__ unsigned short* VTC() const { return (unsigned short*)(a->ws + WS_VTC); }
    __device__ __forceinline__ unsigned short* QDN() const { return (unsigned short*)(a->ws + WS_QDN); }
    __device__ __forceinline__ unsigned short* QDP() const { return (unsigned short*)(a->ws + WS_QDP); }
    __device__ __forceinline__ unsigned short* KDN() const { return (unsigned short*)(a->ws + WS_KDN); }
    __device__ __forceinline__ unsigned short* KPE() const { return (unsigned short*)(a->ws + WS_KPE); }
    __device__ __forceinline__ unsigned short* VTD() const { return (unsigned short*)(a->ws + WS_VTD); }
    __device__ __forceinline__ unsigned short* DA() const { return (unsigned short*)(a->ws + WS_DA); }
    __device__ __forceinline__ unsigned short* GATE() const { return (unsigned short*)(a->ws + WS_GATE); }
    __device__ __forceinline__ unsigned short* O() const { return (unsigned short*)(a->ws + WS_O); }
    __device__ __forceinline__ unsigned short* MIX() const { return (unsigned short*)(a->ws + WS_MIX); }
    __device__ __forceinline__ unsigned short* WIN() const { return (unsigned short*)(a->ws + WS_WIN); }
    __device__ __forceinline__ unsigned short* WMLA() const { return (unsigned short*)(a->ws + WS_WMLA); }
    __device__ __forceinline__ unsigned short* WBR() const { return (unsigned short*)(a->ws + WS_WBR); }
    __device__ __forceinline__ unsigned short* WOUT() const { return (unsigned short*)(a->ws + WS_WOUT); }
    __device__ __forceinline__ float* RSQ() const { return (float*)(a->ws + WS_RSQ); }
    __device__ __forceinline__ float* RSKV() const { return (float*)(a->ws + WS_RSKV); }
    __device__ __forceinline__ unsigned short* PART() const { return (unsigned short*)(a->ws + WS_Y); }
    __device__ __forceinline__ unsigned char* ldsraw() const { return (unsigned char*)lds - 64; }
    __device__ __forceinline__ int* HIST() const { return (int*)(a->ws + WS_HIST); }
    __device__ __forceinline__ int* TOPE() const { return (int*)(a->ws + WS_TOPE); }
    __device__ __forceinline__ int* SLOT() const { return (int*)(a->ws + WS_SLOT); }
    __device__ __forceinline__ int* ROWOF() const { return (int*)(a->ws + WS_ROWOF); }
    __device__ __forceinline__ int* PEXP() const { return (int*)(a->ws + WS_PEXP); }
};

namespace pg8 {
#define PG8_LAS __attribute__((address_space(3)))
typedef unsigned short bf16_t;
typedef short bf16x8 __attribute__((ext_vector_type(8)));
typedef float f32x4 __attribute__((ext_vector_type(4)));
typedef unsigned u32x4 __attribute__((ext_vector_type(4)));
typedef unsigned u32x2 __attribute__((ext_vector_type(2)));
constexpr int BM = 256, BK = 64, HALF = 128, HTB = HALF * BK * 2, STAGE_BYTES = 8 * HTB, NXCD = 8, WGM = 4;
__host__ __device__ __forceinline__ int lds_byte(int r, int c) { const int st = (r >> 4) * 2 + (c >> 5), rr = r & 15, cc = c & 31, ob = rr * 64 + cc * 2; return st * 1024 + (ob ^ (((ob >> 9) & 1) << 5)); }
__host__ __device__ __forceinline__ void stage_rc(int b, int& R, int& C) { const int st = b / 1024, sb = b % 1024, swz = sb ^ (((sb >> 9) & 1) << 5); R = (st >> 1) * 16 + swz / 64; C = (st & 1) * 32 + (swz % 64) / 2; }
__host__ __device__ __forceinline__ int perm32(int rho) { const int n = rho >> 4, i = rho & 15; return 8 * (i >> 2) + 4 * n + (i & 3); }
struct Unit { int pm, pn, pc, koff, seg, nt; };
struct Gemm { const bf16_t* A; const bf16_t* Bt; int K, lda, ldb; };
struct StaticOrder {
    int nM, nN, nwg, G, c;
    __host__ __device__ void init(int M, int N, int G_, int c_) { nM = M / BM; nN = N / BM; nwg = nM * nN; G = G_; c = c_; }
    __host__ __device__ bool next(int i, Unit& u) const {
        const long L = (long)i * G + c; if (L >= nwg) return false;
        int wgid = (int)L; { const int q = nwg / NXCD, r = nwg % NXCD, xcd = wgid % NXCD, off = wgid / NXCD; wgid = (xcd < r ? xcd * (q + 1) : r * (q + 1) + (xcd - r) * q) + off; }
        const int nig = WGM * nN, gid = wgid / nig, fm = gid * WGM, gsz = (nM - fm) < WGM ? (nM - fm) : WGM;
        u.pm = fm + ((wgid % nig) % gsz); u.pn = (wgid % nig) / gsz; u.pc = u.pn; u.koff = 0; u.seg = 0; u.nt = 0; return true;
    }
    __device__ __forceinline__ void a_ready(const Unit&) const {}
    __device__ __forceinline__ void done(const Unit&) const {}
};
struct MoeOrder {
    int nM, nN, nwg, G, c; const PG8_LAS int* pexp;
    __device__ void init(int nP, int N, int G_, int c_, const PG8_LAS int* pexp_) { nM = nP; nN = N / BM; nwg = nM * nN; G = G_; c = c_; pexp = pexp_; }
    __device__ bool next(int i, Unit& u) const {
        const long L = (long)i * G + c; if (L >= nwg) return false;
        int wgid = (int)L; { const int q = nwg / NXCD, r = nwg % NXCD, xcd = wgid % NXCD, off = wgid / NXCD; wgid = (xcd < r ? xcd * (q + 1) : r * (q + 1) + (xcd - r) * q) + off; }
        const int nig = WGM * nN, gid = wgid / nig, fm = gid * WGM, gsz = (nM - fm) < WGM ? (nM - fm) : WGM;
        u.pm = fm + ((wgid % nig) % gsz); u.pc = (wgid % nig) / gsz; u.pn = pexp[u.pm] * nN + u.pc; u.koff = 0; u.seg = 0; u.nt = 0; return true;
    }
    __device__ __forceinline__ void a_ready(const Unit&) const {}
    __device__ __forceinline__ void done(const Unit&) const {}
};
typedef __bf16 bf16x2_t __attribute__((ext_vector_type(2)));
typedef float f32x2_t __attribute__((ext_vector_type(2)));
__device__ __forceinline__ unsigned cvt_pk_bf16(float lo, float hi) { f32x2_t f = {lo, hi}; bf16x2_t r = __builtin_convertvector(f, bf16x2_t); return __builtin_bit_cast(unsigned, r); }
__device__ __forceinline__ float silu_fast(float v) { return v * __builtin_amdgcn_rcpf(1.f + __builtin_amdgcn_exp2f(-1.4426950408889634f * v)); }
struct EpiSwiglu {
    static constexpr bool PERM = true, AFTER_DRAIN = false, KEEP = false;
    bf16_t* O; int ldc;
    __device__ __forceinline__ void operator()(const f32x4 (&acc)[2][2][4][2], const Unit& u, int wr, int wc, int fr, int fq) const {
        const int row0 = u.pm * BM + wr * 64 + fr, col0 = u.pc * 128 + wc * 32 + 8 * fq;
#pragma unroll
        for (int ai = 0; ai < 2; ++ai)
#pragma unroll
            for (int m = 0; m < 4; ++m) {
                bf16_t* rowp = O + (size_t)(row0 + ai * HALF + m * 16) * ldc + col0;
                float v[8];
#pragma unroll
                for (int n = 0; n < 2; ++n)
#pragma unroll
                    for (int j = 0; j < 4; ++j) v[n * 4 + j] = silu_fast(acc[ai][0][m][n][j]) * acc[ai][1][m][n][j];
                u32x4 w; w.x = cvt_pk_bf16(v[0], v[1]); w.y = cvt_pk_bf16(v[2], v[3]); w.z = cvt_pk_bf16(v[4], v[5]); w.w = cvt_pk_bf16(v[6], v[7]);
                *(u32x4*)rowp = w;
            }
    }
};
__device__ __forceinline__ f32x4 bf_lo4(unsigned a, unsigned b) { return (f32x4){__uint_as_float(a << 16), __uint_as_float(a & 0xffff0000u), __uint_as_float(b << 16), __uint_as_float(b & 0xffff0000u)}; }
__device__ __forceinline__ void resid_tile(const f32x4 (&acc)[2][2][4][2], bf16_t* X, unsigned ldx, const float* gate, int row0, int col0) {
    const float* g = gate + (unsigned)modrow(row0) * ADAW + col0;
    f32x4 gg[2][2];
#pragma unroll
    for (int bj = 0; bj < 2; ++bj) { gg[bj][0] = *(const f32x4*)(g + bj * HALF); gg[bj][1] = *(const f32x4*)(g + bj * HALF + 4); }
#pragma unroll
    for (int ai = 0; ai < 2; ++ai) {
        u32x4 xw[4][2];
        asm volatile("" ::: "memory");
#pragma unroll
        for (int m = 0; m < 4; ++m)
#pragma unroll
            for (int bj = 0; bj < 2; ++bj) xw[m][bj] = *(const u32x4*)(X + (unsigned)(row0 + ai * HALF + m * 16) * ldx + col0 + bj * HALF);
        asm volatile("" ::: "memory");
#pragma unroll
        for (int m = 0; m < 4; ++m)
#pragma unroll
            for (int bj = 0; bj < 2; ++bj) {
                const f32x4 r0 = bf_lo4(xw[m][bj].x, xw[m][bj].y) + gg[bj][0] * acc[ai][bj][m][0], r1 = bf_lo4(xw[m][bj].z, xw[m][bj].w) + gg[bj][1] * acc[ai][bj][m][1];
                u32x4 w; w.x = cvt_pk_bf16(r0[0], r0[1]); w.y = cvt_pk_bf16(r0[2], r0[3]); w.z = cvt_pk_bf16(r1[0], r1[1]); w.w = cvt_pk_bf16(r1[2], r1[3]);
                *(u32x4*)(X + (unsigned)(row0 + ai * HALF + m * 16) * ldx + col0 + bj * HALF) = w;
            }
    }
}
struct EpiResid {
    static constexpr bool PERM = true, AFTER_DRAIN = false, KEEP = false;
    bf16_t* X; int ldc; const float* gate;
    __device__ __forceinline__ void operator()(const f32x4 (&acc)[2][2][4][2], const Unit& u, int wr, int wc, int fr, int fq) const {
        resid_tile(acc, X, (unsigned)ldc, gate, u.pm * BM + wr * 64 + fr, u.pc * BM + wc * 32 + 8 * fq);
    }
};
struct EpiBf16Plain {
    static constexpr bool PERM = true, AFTER_DRAIN = false, KEEP = false;
    bf16_t* O; int ldc;
    __device__ __forceinline__ void operator()(const f32x4 (&acc)[2][2][4][2], const Unit& u, int wr, int wc, int fr, int fq) const {
        const int row0 = u.pm * BM + wr * 64 + fr, col0 = u.pc * BM + wc * 32 + 8 * fq;
#pragma unroll
        for (int ai = 0; ai < 2; ++ai)
#pragma unroll
            for (int m = 0; m < 4; ++m) {
                bf16_t* rowp = O + (size_t)(row0 + ai * HALF + m * 16) * ldc + col0;
#pragma unroll
                for (int bj = 0; bj < 2; ++bj) {
                    const f32x4 v0 = acc[ai][bj][m][0], v1 = acc[ai][bj][m][1];
                    u32x4 w; w.x = cvt_pk_bf16(v0[0], v0[1]); w.y = cvt_pk_bf16(v0[2], v0[3]); w.z = cvt_pk_bf16(v1[0], v1[1]); w.w = cvt_pk_bf16(v1[2], v1[3]);
                    *(u32x4*)(rowp + bj * HALF) = w;
                }
            }
    }
};
constexpr float C2A = 0.125f * 1.4426950408889634f;
constexpr float C2D = 0.10206207261596577f * 1.4426950408889634f;
__device__ __forceinline__ void st_bf16x8(bf16_t* p, const float (&v)[8]) {
    u32x4 w; w.x = cvt_pk_bf16(v[0], v[1]); w.y = cvt_pk_bf16(v[2], v[3]); w.z = cvt_pk_bf16(v[4], v[5]); w.w = cvt_pk_bf16(v[6], v[7]); *(u32x4*)p = w;
}
__device__ __forceinline__ void st_bf16x4(bf16_t* p, float a, float b, float c, float d) { u32x2 w; w.x = cvt_pk_bf16(a, b); w.y = cvt_pk_bf16(c, d); *(u32x2*)p = w; }
__device__ __forceinline__ bf16_t f2bf(float f) { return (bf16_t)(cvt_pk_bf16(f, 0.f) & 0xffffu); }

struct EpiInproj {
    static constexpr bool PERM = true, AFTER_DRAIN = false, KEEP = false;
    unsigned char* ws; const float *rope, *gq, *gk;
    __device__ __forceinline__ void operator()(const f32x4 (&acc)[2][2][4][2], const Unit& u, int wr, int wc, int fr_, int fq_) const {
        int fr = fr_, fq = fq_; asm volatile("" : "+v"(fr), "+v"(fq));
        bf16_t* const QA = (bf16_t*)(ws + WS_QA); bf16_t* const KA = (bf16_t*)(ws + WS_KA); bf16_t* const VTA = (bf16_t*)(ws + WS_VTA); bf16_t* const QB = (bf16_t*)(ws + WS_QB);
        bf16_t* const KB = (bf16_t*)(ws + WS_KB); bf16_t* const VTB = (bf16_t*)(ws + WS_VTB); bf16_t* const QC = (bf16_t*)(ws + WS_QC); bf16_t* const KC = (bf16_t*)(ws + WS_KC);
        bf16_t* const VTC = (bf16_t*)(ws + WS_VTC); bf16_t* const DA = (bf16_t*)(ws + WS_DA); bf16_t* const KPE = (bf16_t*)(ws + WS_KPE); bf16_t* const GATE = (bf16_t*)(ws + WS_GATE);
        float* const RSQ = (float*)(ws + WS_RSQ); float* const RSKV = (float*)(ws + WS_RSKV);
        const int pc = u.pc, row0 = u.pm * BM + wr * 64 + fr;
        const bool lat = u.pm < ML / BM;
        if (pc >= 9) {
#pragma unroll
            for (int ai = 0; ai < 2; ++ai)
#pragma unroll
                for (int m = 0; m < 4; ++m) {
                    unsigned char* rowp = (unsigned char*)GATE + (unsigned)(row0 + ai * HALF + m * 16) * 4096 + (pc - 9) * 256 + wc * 32 + 8 * fq;
#pragma unroll
                    for (int bj = 0; bj < 2; ++bj) {
                        u32x2 w = {0u, 0u};
#pragma unroll
                        for (int n = 0; n < 2; ++n)
#pragma unroll
                            for (int j = 0; j < 4; ++j) {
                                const float gte = __builtin_amdgcn_rcpf(1.f + __builtin_amdgcn_exp2f(-1.4426950408889634f * acc[ai][bj][m][n][j]));
                                w[n] = __builtin_amdgcn_cvt_pk_u8_f32(fmaf(gte, 256.f, -0.5f), j, w[n]);
                            }
                        *(u32x2*)(rowp + bj * HALF) = w;
                    }
                }
        } else if (pc == 7) {
#pragma unroll
            for (int ai = 0; ai < 2; ++ai)
#pragma unroll
                for (int m = 0; m < 4; ++m) {
                    const int row = row0 + ai * HALF + m * 16;
                    float ss = 0.f;
#pragma unroll
                    for (int bj = 0; bj < 2; ++bj) {
                        float v[8];
#pragma unroll
                        for (int n = 0; n < 2; ++n)
#pragma unroll
                            for (int j = 0; j < 4; ++j) { v[n * 4 + j] = acc[ai][bj][m][n][j]; ss += v[n * 4 + j] * v[n * 4 + j]; }
                        st_bf16x8(DA + (unsigned)row * 384 + bj * HALF + wc * 32 + 8 * fq, v);
                    }
                    ss += __shfl_xor(ss, 16); ss += __shfl_xor(ss, 32);
                    if (fq == 0) RSQ[row * 4 + wc] = ss;
                }
        } else if (pc == 8) {
            const float* cr = rope + SEQ * 64; const float* sr = cr + SEQ * 16;
            const bool rope8 = (wc == 0) && lat;
            f32x4 rc = {1.f, 1.f, 1.f, 1.f}, rsn = {0.f, 0.f, 0.f, 0.f}, rcn = rc, rsnn = rsn;
            if (rope8) { const int t0 = row0 & (SEQ - 1); rc = *(const f32x4*)(cr + t0 * 16 + 4 * fq); rsn = *(const f32x4*)(sr + t0 * 16 + 4 * fq); }
#pragma unroll
            for (int ai = 0; ai < 2; ++ai)
#pragma unroll
                for (int m = 0; m < 4; ++m) {
                    const int row = row0 + ai * HALF + m * 16;
                    if (rope8 && (ai * 4 + m) < 7) { const int k1 = ai * 4 + m + 1, tn = (row0 + (k1 >> 2) * HALF + (k1 & 3) * 16) & (SEQ - 1); rcn = *(const f32x4*)(cr + tn * 16 + 4 * fq); rsnn = *(const f32x4*)(sr + tn * 16 + 4 * fq); }
                    float ss = 0.f, v[8];
#pragma unroll
                    for (int n = 0; n < 2; ++n)
#pragma unroll
                        for (int j = 0; j < 4; ++j) { v[n * 4 + j] = acc[ai][0][m][n][j]; ss += v[n * 4 + j] * v[n * 4 + j]; }
                    st_bf16x8(DA + (unsigned)row * 384 + 256 + wc * 32 + 8 * fq, v);
                    ss += __shfl_xor(ss, 16); ss += __shfl_xor(ss, 32);
                    if (fq == 0) RSKV[row * 4 + wc] = ss;
                    if (wc == 0) {
                        f32x4 x1 = acc[ai][1][m][0], x2 = acc[ai][1][m][1];
                        if (lat) { const f32x4 o1 = x1 * rc - x2 * rsn, o2 = x1 * rsn + x2 * rc; x1 = o1; x2 = o2; }
                        st_bf16x4(KPE + (unsigned)row * 32 + 4 * fq, x1[0], x1[1], x1[2], x1[3]);
                        st_bf16x4(KPE + (unsigned)row * 32 + 16 + 4 * fq, x2[0], x2[1], x2[2], x2[3]);
                    }
                    rc = rcn; rsn = rsnn;
                }
        } else {
            const bool do_norm = (pc == 3) || (pc == 5 && wc < 2);
            const bool do_rope = (pc == 3 || pc == 4 || pc == 5) && lat;
            const float qs = (pc == 0 || pc == 3 || pc == 4) ? C2A : 1.f;
            const float* g = (pc == 3) ? gq : gk;
            const float* ch = rope; const float* sh = rope + SEQ * 32;
            unsigned dofs = 0, ld = 256; bool tr = false;
            if (pc == 0) dofs = (unsigned)(WS_QA / 2); else if (pc == 1) dofs = (unsigned)(WS_KA / 2); else if (pc == 3) dofs = (unsigned)(WS_QB / 2); else if (pc == 4) dofs = (unsigned)(WS_QC / 2);
            else if (pc == 5) { dofs = (unsigned)((wc < 2 ? WS_KB : WS_KC) / 2); ld = 128; }
            else if (pc == 2) { dofs = (unsigned)(WS_VTA / 2) + 64u * wc * MT; tr = true; }
            else { dofs = (unsigned)((wc < 2 ? WS_VTB : WS_VTC) / 2) + 64u * (wc & 1) * MT; tr = true; }
            if (!tr) dofs += (pc == 5 ? 64u * (wc & 1) : 64u * wc);
            bf16_t* const wsb = (bf16_t*)ws;
            f32x4 gA[2], gB[2];
#pragma unroll
            for (int n = 0; n < 2; ++n) { gA[n] = (f32x4){1.f, 1.f, 1.f, 1.f}; gB[n] = gA[n]; }
            if (do_norm) {
#pragma unroll
                for (int n = 0; n < 2; ++n) { gA[n] = *(const f32x4*)(g + 8 * fq + 4 * n); gB[n] = *(const f32x4*)(g + 32 + 8 * fq + 4 * n); }
            }
            f32x4 rc[2], rsn[2], rcn[2], rsnn[2];
#pragma unroll
            for (int n = 0; n < 2; ++n) { rc[n] = (f32x4){1.f, 1.f, 1.f, 1.f}; rsn[n] = (f32x4){0.f, 0.f, 0.f, 0.f}; rcn[n] = rc[n]; rsnn[n] = rsn[n]; }
            if (do_rope) {
                const int t0 = row0 & (SEQ - 1);
#pragma unroll
                for (int n = 0; n < 2; ++n) { rc[n] = *(const f32x4*)(ch + t0 * 32 + 8 * fq + 4 * n); rsn[n] = *(const f32x4*)(sh + t0 * 32 + 8 * fq + 4 * n); }
            }
#pragma unroll
            for (int ai = 0; ai < 2; ++ai)
#pragma unroll
                for (int m = 0; m < 4; ++m) {
                    asm volatile("" ::: "memory"); int row = row0 + ai * HALF + m * 16; asm volatile("" : "+v"(row));
                    if (do_rope && (ai * 4 + m) < 7) {
                        const int k1 = ai * 4 + m + 1, tn = (row0 + (k1 >> 2) * HALF + (k1 & 3) * 16) & (SEQ - 1);
#pragma unroll
                        for (int n = 0; n < 2; ++n) { rcn[n] = *(const f32x4*)(ch + tn * 32 + 8 * fq + 4 * n); rsnn[n] = *(const f32x4*)(sh + tn * 32 + 8 * fq + 4 * n); }
                    }
                    float rs = 1.f;
                    if (do_norm) {
                        float ss = 0.f;
#pragma unroll
                        for (int n = 0; n < 2; ++n)
#pragma unroll
                            for (int j = 0; j < 4; ++j) ss += acc[ai][0][m][n][j] * acc[ai][0][m][n][j] + acc[ai][1][m][n][j] * acc[ai][1][m][n][j];
                        ss += __shfl_xor(ss, 16); ss += __shfl_xor(ss, 32);
                        rs = rsqrtf(ss * (1.f / 64.f) + EPS);
                    }
#pragma unroll
                    for (int n = 0; n < 2; ++n) {
                        f32x4 x1 = acc[ai][0][m][n], x2 = acc[ai][1][m][n];
                        if (do_norm) { x1 = x1 * rs * gA[n]; x2 = x2 * rs * gB[n]; }
                        if (do_rope) { const f32x4 a = x1 * rc[n] - x2 * rsn[n], b = x1 * rsn[n] + x2 * rc[n]; x1 = a; x2 = b; }
                        x1 = x1 * qs; x2 = x2 * qs;
                        if (tr) {
#pragma unroll
                            for (int j = 0; j < 4; ++j) { wsb[dofs + (unsigned)(8 * fq + 4 * n + j) * MT + row] = f2bf(x1[j]); wsb[dofs + (unsigned)(32 + 8 * fq + 4 * n + j) * MT + row] = f2bf(x2[j]); }
                        } else {
                            st_bf16x4(wsb + dofs + (unsigned)row * ld + 8 * fq + 4 * n, x1[0], x1[1], x1[2], x1[3]);
                            st_bf16x4(wsb + dofs + (unsigned)row * ld + 32 + 8 * fq + 4 * n, x2[0], x2[1], x2[2], x2[3]);
                        }
                    }
#pragma unroll
                    for (int n = 0; n < 2; ++n) { rc[n] = rcn[n]; rsn[n] = rsnn[n]; }
                }
        }
    }
};

struct EpiMla {
    static constexpr bool PERM = true, AFTER_DRAIN = false, KEEP = false;
    unsigned char* ws; const float* rope;
    __device__ __forceinline__ void operator()(const f32x4 (&acc)[2][2][4][2], const Unit& u, int wr, int wc, int fr_, int fq_) const {
        int fr = fr_, fq = fq_; asm volatile("" : "+v"(fr), "+v"(fq));
        bf16_t* const QDN = (bf16_t*)(ws + WS_QDN); bf16_t* const QDP = (bf16_t*)(ws + WS_QDP); bf16_t* const KDN = (bf16_t*)(ws + WS_KDN); bf16_t* const VTD = (bf16_t*)(ws + WS_VTD);
        const float* const RSQ = (const float*)(ws + WS_RSQ); const float* const RSKV = (const float*)(ws + WS_RSKV);
        const int pc = u.pc, row0 = u.pm * BM + wr * 64 + fr;
        const bool lat = u.pm < ML / BM;
        const float* cr = rope + SEQ * 64; const float* sr = cr + SEQ * 16;
        float rs8[8];
        {
            f32x4 pq8[8];
#pragma unroll
            for (int k = 0; k < 8; ++k) pq8[k] = *(const f32x4*)((pc < 2 ? RSQ : RSKV) + (row0 + (k >> 2) * HALF + (k & 3) * 16) * 4);
#pragma unroll
            for (int k = 0; k < 8; ++k) rs8[k] = rsqrtf(((pq8[k][0] + pq8[k][1]) + (pq8[k][2] + pq8[k][3])) * (pc < 2 ? 1.f / 256.f : 1.f / 128.f) + EPS) * (pc < 2 ? C2D : 1.f);
        }
        const bool rope1 = (pc == 1) && lat;
        f32x4 rc = {1.f, 1.f, 1.f, 1.f}, rsn = {0.f, 0.f, 0.f, 0.f}, rcn = rc, rsnn = rsn;
        if (rope1) { const int t0 = row0 & (SEQ - 1); rc = *(const f32x4*)(cr + t0 * 16 + 4 * fq); rsn = *(const f32x4*)(sr + t0 * 16 + 4 * fq); }
#pragma unroll
        for (int ai = 0; ai < 2; ++ai)
#pragma unroll
            for (int m = 0; m < 4; ++m) {
                asm volatile("" ::: "memory"); int row = row0 + ai * HALF + m * 16; asm volatile("" : "+v"(row));
                if (rope1 && (ai * 4 + m) < 7) { const int k1 = ai * 4 + m + 1, tn = (row0 + (k1 >> 2) * HALF + (k1 & 3) * 16) & (SEQ - 1); rcn = *(const f32x4*)(cr + tn * 16 + 4 * fq); rsnn = *(const f32x4*)(sr + tn * 16 + 4 * fq); }
                const float rs = rs8[ai * 4 + m];
                if (pc == 1) {
                    float o1[4], o2[4];
#pragma unroll
                    for (int j = 0; j < 4; ++j) {
                        const float a = acc[ai][0][m][0][j] * rs, b = acc[ai][0][m][1][j] * rs;
                        const float c = rc[j], sn = rsn[j];
                        o1[j] = a * c - b * sn; o2[j] = a * sn + b * c;
                    }
                    rc = rcn; rsn = rsnn;
                    st_bf16x4(QDP + (unsigned)row * 128 + 32 * wc + 4 * fq, o1[0], o1[1], o1[2], o1[3]);
                    st_bf16x4(QDP + (unsigned)row * 128 + 32 * wc + 16 + 4 * fq, o2[0], o2[1], o2[2], o2[3]);
                } else {
                    float x1[8], x2[8];
#pragma unroll
                    for (int n = 0; n < 2; ++n)
#pragma unroll
                        for (int j = 0; j < 4; ++j) { x1[n * 4 + j] = acc[ai][0][m][n][j] * rs; x2[n * 4 + j] = acc[ai][1][m][n][j] * rs; }
                    if (pc == 3) {
                        bf16_t* vt = VTD + (unsigned)(64 * wc) * MT;
#pragma unroll
                        for (int i = 0; i < 8; ++i) { vt[(unsigned)(8 * fq + i) * MT + row] = f2bf(x1[i]); vt[(unsigned)(32 + 8 * fq + i) * MT + row] = f2bf(x2[i]); }
                    } else {
                        bf16_t* dst = (pc == 0 ? QDN : KDN) + (unsigned)row * 256 + 64 * wc;
                        st_bf16x8(dst + 8 * fq, x1); st_bf16x8(dst + 32 + 8 * fq, x2);
                    }
                }
            }
    }
};

struct EpiBranch {
    static constexpr bool PERM = true, AFTER_DRAIN = false, KEEP = true;
    bf16_t* MIX; const bf16_t* GATE;
    static __device__ __forceinline__ float gq(unsigned w, int b) { return fmaf((float)((w >> (8 * b)) & 0xffu), 1.f / 256.f, 1.f / 512.f); }
    __device__ __forceinline__ bool seg(f32x4 (&acc)[2][2][4][2], const Unit& u, int wr, int wc, int fr, int fq) const {
        const int row0 = u.pm * BM + wr * 64 + fr, col0 = u.pc * BM + wc * 32 + 8 * fq, s = u.seg;
        const unsigned char* gbase = (const unsigned char*)GATE + (unsigned)row0 * 4096 + s * 1024 + col0;
        const unsigned nxo = s < 3 ? 1024u : 0u;
        const bool notlast = s < 3;
#pragma unroll
        for (int ai = 0; ai < 2; ++ai)
#pragma unroll
            for (int mp = 0; mp < 2; ++mp) {
                u32x2 gc[2][2], gn[2][2];
                asm volatile("" ::: "memory");
#pragma unroll
                for (int mm = 0; mm < 2; ++mm)
#pragma unroll
                    for (int bj = 0; bj < 2; ++bj) { const unsigned char* gp = gbase + (unsigned)(ai * HALF + (2 * mp + mm) * 16) * 4096 + bj * HALF; gc[mm][bj] = *(const u32x2*)gp; gn[mm][bj] = *(const u32x2*)(gp + nxo); }
                asm volatile("" ::: "memory");
#pragma unroll
                for (int mm = 0; mm < 2; ++mm)
#pragma unroll
                    for (int bj = 0; bj < 2; ++bj) {
                        float v[8];
#pragma unroll
                        for (int n = 0; n < 2; ++n)
#pragma unroll
                            for (int j = 0; j < 4; ++j) {
                                const float gcv = gq(gc[mm][bj][n], j), rn = __builtin_amdgcn_rcpf(gq(gn[mm][bj][n], j));
                                acc[ai][bj][2 * mp + mm][n][j] *= notlast ? gcv * rn : gcv; v[n * 4 + j] = acc[ai][bj][2 * mp + mm][n][j];
                            }
                        if (!notlast) st_bf16x8(MIX + (unsigned)(row0 + ai * HALF + (2 * mp + mm) * 16) * D + col0 + bj * HALF, v);
                    }
            }
        return notlast;
    }
};
struct BranchOrder {
    StaticOrder T;
    __device__ void init(int M, int G_, int c_) { T.init(M, D, G_, c_); }
    __device__ bool next(int i, Unit& u) const { if (!T.next(i >> 2, u)) return false; u.seg = i & 3; u.koff = (i & 3) * 512; return true; }
    __device__ __forceinline__ void a_ready(const Unit&) const {}
    __device__ __forceinline__ void done(const Unit&) const {}
};
struct TailOrder {
    StaticOrder T; int c, nsplit, kpiece;
    __device__ void init(int G_, int c_, int nsplit_, int kpiece_) { T.init(ML, D, G_, c_); c = c_; nsplit = nsplit_; kpiece = kpiece_; }
    __device__ bool next(int i, Unit& u) const {
        if (i == 0) return T.next(0, u);
        if (i > 1 || c >= 32 * nsplit) return false;
        const int t = c / nsplit, p = c - t * nsplit;
        u.pm = ML / BM + (t >> 2); u.pn = t & 3; u.pc = u.pn; u.koff = p * kpiece * 2; u.seg = 1 + p; u.nt = kpiece / BK; return true;
    }
    __device__ __forceinline__ void a_ready(const Unit&) const {}
    __device__ __forceinline__ void done(const Unit&) const {}
};
struct EpiResidTail {
    static constexpr bool PERM = true, AFTER_DRAIN = false, KEEP = false;
    bf16_t* X; const float* gate; bf16_t* PART;
    __device__ __forceinline__ void operator()(const f32x4 (&acc)[2][2][4][2], const Unit& u, int wr, int wc, int fr, int fq) const {
        const int row0 = u.pm * BM + wr * 64 + fr, col0 = u.pc * BM + wc * 32 + 8 * fq;
        if (u.seg == 0) { resid_tile(acc, X, (unsigned)D, gate, row0, col0); return; }
        bf16_t* pp0 = PART + ((unsigned)(u.seg - 1) * MC + (unsigned)(row0 - ML)) * D + col0;
#pragma unroll
        for (int ai = 0; ai < 2; ++ai)
#pragma unroll
            for (int m = 0; m < 4; ++m)
#pragma unroll
                for (int bj = 0; bj < 2; ++bj) {
                    const f32x4 v0 = acc[ai][bj][m][0], v1 = acc[ai][bj][m][1];
                    u32x4 w; w.x = cvt_pk_bf16(v0[0], v0[1]); w.y = cvt_pk_bf16(v0[2], v0[3]); w.z = cvt_pk_bf16(v1[0], v1[1]); w.w = cvt_pk_bf16(v1[2], v1[3]);
                    *(u32x4*)(pp0 + (unsigned)(ai * HALF + m * 16) * D + bj * HALF) = w;
                }
    }
};
struct InprojLastOrder {
    StaticOrder T; int G, c;
    __device__ void init(int G_, int c_) { T.init(ML, INWP, G_, c_); G = G_; c = c_; }
    __device__ bool next(int i, Unit& u) const {
        const int L = i * G + c, nlat = (ML / BM) * (INWP / BM);
        if (L < nlat) return T.next(i, u);
        const int q = L - nlat; if (q >= (MC / BM) * 9) return false;
        u.pm = ML / BM + q / 9; u.pn = q % 9; u.pc = u.pn; u.koff = 0; u.seg = 0; u.nt = 0; return true;
    }
    __device__ __forceinline__ void a_ready(const Unit&) const {}
    __device__ __forceinline__ void done(const Unit&) const {}
};
struct MoeDownOrder {
    int nP, G, c, khalf; const PG8_LAS int* pexp;
    __device__ void init(int nP_, int G_, int c_, int khalf_, const PG8_LAS int* pexp_) { nP = nP_; G = G_; c = c_; khalf = khalf_; pexp = pexp_; }
    __device__ bool next(int i, Unit& u) const {
        const int nfull = YSPLIT_P0 * 4;
        int L, half = -1;
        if (i * G + c < nfull) {
            const int L0 = i * G + c, wgid = (L0 % NXCD) * (nfull / NXCD) + L0 / NXCD, gid = wgid / (WGM * 4), w = wgid % (WGM * 4);
            L = (gid * WGM + (w % WGM)) * 4 + w / WGM;
        } else { const int q = (i * G + c) - nfull; L = nfull + (q >> 1); half = q & 1; }
        if (L >= nP * 4) return false;
        u.pm = L >> 2; u.pc = L & 3; u.pn = pexp[u.pm] * 4 + u.pc; u.koff = half > 0 ? khalf * 2 : 0; u.seg = half + 1; u.nt = half >= 0 ? khalf / BK : 0; return true;
    }
    __device__ __forceinline__ void a_ready(const Unit&) const {}
    __device__ __forceinline__ void done(const Unit&) const {}
};
struct EpiY {
    static constexpr bool PERM = true, AFTER_DRAIN = false, KEEP = false;
    bf16_t *Y, *Y2;
    __device__ __forceinline__ void operator()(const f32x4 (&acc)[2][2][4][2], const Unit& u, int wr, int wc, int fr, int fq) const {
        const int row0 = u.pm * BM + wr * 64 + fr, col0 = u.pc * BM + wc * 32 + 8 * fq;
        bf16_t* base = (u.seg == 2) ? Y2 - (unsigned)(YSPLIT_P0 * BM) * D : Y;
#pragma unroll
        for (int ai = 0; ai < 2; ++ai)
#pragma unroll
            for (int m = 0; m < 4; ++m) {
                bf16_t* rowp = base + (unsigned)(row0 + ai * HALF + m * 16) * D + col0;
#pragma unroll
                for (int bj = 0; bj < 2; ++bj) {
                    const f32x4 v0 = acc[ai][bj][m][0], v1 = acc[ai][bj][m][1];
                    u32x4 w; w.x = cvt_pk_bf16(v0[0], v0[1]); w.y = cvt_pk_bf16(v0[2], v0[3]); w.z = cvt_pk_bf16(v1[0], v1[1]); w.w = cvt_pk_bf16(v1[2], v1[3]);
                    *(u32x4*)(rowp + bj * HALF) = w;
                }
            }
    }
};
template <class Epi, class Sched, bool ALIGN_EPI = false, bool SP2 = false>
__device__ __forceinline__ void gemm_phase(PG8_LAS unsigned char* lds, const Gemm g, const Sched& S, const Epi& E) {
    int tid_ = threadIdx.x; asm volatile("" : "+v"(tid_));
    const int tid = tid_, wid = __builtin_amdgcn_readfirstlane(tid >> 6), lane = tid & 63, wr = wid >> 2, wc = wid & 3, fr = lane & 15, fq = lane >> 4;
    const int K = g.K, ntdef = K / BK; const int lda = g.lda, ldb = g.ldb;
    unsigned voffA[2], voffB[2];
#pragma unroll
    for (int i = 0; i < 2; ++i) { int R, C; stage_rc(tid * 16 + i * 8192, R, C); const int Rb = Epi::PERM ? ((R & ~31) + perm32(R & 31)) : R;
        voffA[i] = (unsigned)(R * lda + C) * 2u; voffB[i] = (unsigned)(Rb * ldb + C) * 2u; }
    const size_t kstep = (size_t)(BK * 2);
    const size_t hstepA = (size_t)HALF * lda * 2, hstepB = (size_t)HALF * ldb * 2;
    const size_t tstepA = 2 * hstepA, tstepB = 2 * hstepB;
    const unsigned ldsw = (unsigned)wid * 1024u;
    const int aoff = lds_byte(wr * 64 + fr, fq * 8), boff = lds_byte(wc * 32 + fr, fq * 8);
#define PG8_SA(b, h) (((b) * 2 + (h)) * HTB)
#define PG8_SB(b, h) ((4 + (b) * 2 + (h)) * HTB)
#define PG8_STAGE(bufoff, gbase, voff) do { _Pragma("unroll") for (int _i = 0; _i < 2; ++_i) \
        __builtin_amdgcn_global_load_lds((const unsigned*)((const char*)(gbase) + (voff)[_i]), (PG8_LAS unsigned*)(lds + (bufoff) + ldsw + _i * 8192), 16, 0, 0); } while (0)
#define PG8_LDA(dst, b, h) do { _Pragma("unroll") for (int m = 0; m < 4; ++m) _Pragma("unroll") for (int k = 0; k < 2; ++k) dst[m][k] = *(const PG8_LAS bf16x8*)(lds + PG8_SA(b, h) + aoff + m * 2048 + k * 1024); } while (0)
#define PG8_LDB(dst, b, h) do { _Pragma("unroll") for (int n = 0; n < 2; ++n) _Pragma("unroll") for (int k = 0; k < 2; ++k) dst[n][k] = *(const PG8_LAS bf16x8*)(lds + PG8_SB(b, h) + boff + n * 2048 + k * 1024); } while (0)
#define PG8_MMA(ai, bj, At, Bt) do { __builtin_amdgcn_s_setprio(1); _Pragma("unroll") for (int m = 0; m < 4; ++m) _Pragma("unroll") for (int n = 0; n < 2; ++n) _Pragma("unroll") for (int k = 0; k < 2; ++k) \
        acc[ai][bj][m][n] = __builtin_amdgcn_mfma_f32_16x16x32_bf16(Bt[n][k], At[m][k], acc[ai][bj][m][n], 0, 0, 0); __builtin_amdgcn_s_setprio(0); } while (0)
#define PG8_WAIT_V(n) asm volatile("s_waitcnt vmcnt(" #n ")" ::: "memory")
#define PG8_WAIT_L(n) asm volatile("s_waitcnt lgkmcnt(" #n ")" ::: "memory")
#define PG8_BAR __builtin_amdgcn_s_barrier()
#define PG8_SCHED __builtin_amdgcn_sched_barrier(0)
    Unit cur, nxt; int ui = 0;
    if (!S.next(0, cur)) return;
    f32x4 acc[2][2][4][2];
#pragma unroll
    for (int a = 0; a < 2; ++a)
#pragma unroll
        for (int b = 0; b < 2; ++b)
#pragma unroll
            for (int m = 0; m < 4; ++m)
#pragma unroll
                for (int n = 0; n < 2; ++n) acc[a][b][m][n] = (f32x4){0.f, 0.f, 0.f, 0.f};
    bf16x8 At[4][2], B0[2][2], B1[2][2];
    const char* cA = (const char*)g.A + (size_t)cur.pm * tstepA + cur.koff; const char* cB = (const char*)g.Bt + (size_t)cur.pn * tstepB + cur.koff;
    S.a_ready(cur);
    if constexpr (SP2) {
        PG8_STAGE(PG8_SB(0, 0), cB, voffB); PG8_STAGE(PG8_SB(0, 1), cB + hstepB, voffB); PG8_STAGE(PG8_SA(0, 0), cA, voffA); PG8_STAGE(PG8_SA(0, 1), cA + hstepA, voffA);
        if (wr == 1) PG8_BAR;
        PG8_WAIT_V(2); PG8_BAR;
        PG8_STAGE(PG8_SB(1, 0), cB + kstep, voffB); PG8_STAGE(PG8_SA(1, 0), cA + kstep, voffA); PG8_STAGE(PG8_SB(1, 1), cB + hstepB + kstep, voffB);
        PG8_WAIT_V(6); PG8_BAR;
    } else {
        PG8_STAGE(PG8_SB(0, 0), cB, voffB); PG8_STAGE(PG8_SA(0, 0), cA, voffA); PG8_STAGE(PG8_SB(0, 1), cB + hstepB, voffB); PG8_STAGE(PG8_SA(0, 1), cA + hstepA, voffA);
        if (wr == 1) PG8_BAR;
        PG8_WAIT_V(4); PG8_BAR;
        PG8_STAGE(PG8_SB(1, 0), cB + kstep, voffB); PG8_STAGE(PG8_SA(1, 0), cA + kstep, voffA); PG8_STAGE(PG8_SB(1, 1), cB + hstepB + kstep, voffB);
        PG8_WAIT_V(6); PG8_BAR;
    }
    for (;;) {
        const int nt = cur.nt ? cur.nt : ntdef;
        const bool has_next = S.next(ui + 1, nxt);
        const char* nA = has_next ? (const char*)g.A + (size_t)nxt.pm * tstepA + nxt.koff : cA; const char* nB = has_next ? (const char*)g.Bt + (size_t)nxt.pn * tstepB + nxt.koff : cB;
#pragma nounroll
        for (int t = 0; t < nt; t += 2) {
            const bool last = (t == nt - 2);
            const char* a1 = cA + (size_t)(t + 1) * kstep;
            const char* a2 = last ? nA : cA + (size_t)(t + 2) * kstep; const char* b2 = last ? nB : cB + (size_t)(t + 2) * kstep;
            const char* a3 = a2 + kstep; const char* b3 = b2 + kstep;
            if (last && has_next) S.a_ready(nxt);
            if constexpr (SP2) {
            PG8_LDB(B0, 0, 0); PG8_LDB(B1, 0, 1); PG8_SCHED; PG8_LDA(At, 0, 0); PG8_STAGE(PG8_SA(1, 1), a1 + hstepA, voffA);
            PG8_WAIT_V(8); PG8_WAIT_L(0); PG8_BAR; PG8_MMA(0, 0, At, B0); PG8_MMA(0, 1, At, B1); PG8_BAR; PG8_SCHED;
            PG8_LDA(At, 0, 1); PG8_STAGE(PG8_SB(0, 0), b2, voffB); PG8_STAGE(PG8_SB(0, 1), b2 + hstepB, voffB); PG8_STAGE(PG8_SA(0, 0), a2, voffA);
            PG8_WAIT_V(8); PG8_WAIT_L(0); PG8_BAR; PG8_MMA(1, 0, At, B0); PG8_MMA(1, 1, At, B1); PG8_BAR; PG8_SCHED;
            PG8_LDB(B0, 1, 0); PG8_LDB(B1, 1, 1); PG8_SCHED; PG8_LDA(At, 1, 0); PG8_STAGE(PG8_SA(0, 1), a2 + hstepA, voffA);
            PG8_WAIT_V(8); PG8_WAIT_L(0); PG8_BAR; PG8_MMA(0, 0, At, B0); PG8_MMA(0, 1, At, B1); PG8_BAR; PG8_SCHED;
            PG8_LDA(At, 1, 1); PG8_STAGE(PG8_SB(1, 0), b3, voffB); PG8_STAGE(PG8_SB(1, 1), b3 + hstepB, voffB); PG8_STAGE(PG8_SA(1, 0), a3, voffA);
            PG8_WAIT_V(8); PG8_WAIT_L(0); PG8_BAR; PG8_MMA(1, 0, At, B0); PG8_MMA(1, 1, At, B1); PG8_BAR; PG8_SCHED;
            } else {
            PG8_LDB(B0, 0, 0); PG8_SCHED; PG8_LDA(At, 0, 0); PG8_STAGE(PG8_SA(1, 1), a1 + hstepA, voffA);
            PG8_WAIT_L(8); PG8_BAR; PG8_WAIT_L(0); PG8_MMA(0, 0, At, B0); PG8_BAR; PG8_SCHED;
            PG8_LDB(B1, 0, 1); PG8_STAGE(PG8_SB(0, 0), b2, voffB);
            PG8_BAR; PG8_WAIT_L(0); PG8_MMA(0, 1, At, B1); PG8_BAR;
            PG8_LDA(At, 0, 1); PG8_STAGE(PG8_SA(0, 0), a2, voffA);
            PG8_BAR; PG8_WAIT_L(0); PG8_MMA(1, 0, At, B0); PG8_BAR; PG8_SCHED;
            PG8_STAGE(PG8_SB(0, 1), b2 + hstepB, voffB);
            PG8_WAIT_V(6); PG8_BAR; PG8_MMA(1, 1, At, B1); PG8_BAR;
            PG8_LDB(B0, 1, 0); PG8_SCHED; PG8_LDA(At, 1, 0); PG8_STAGE(PG8_SA(0, 1), a2 + hstepA, voffA);
            PG8_WAIT_L(8); PG8_BAR; PG8_WAIT_L(0); PG8_MMA(0, 0, At, B0); PG8_BAR; PG8_SCHED;
            PG8_LDB(B1, 1, 1); PG8_STAGE(PG8_SB(1, 0), b3, voffB);
            PG8_BAR; PG8_WAIT_L(0); PG8_MMA(0, 1, At, B1); PG8_BAR;
            PG8_LDA(At, 1, 1); PG8_STAGE(PG8_SA(1, 0), a3, voffA);
            PG8_BAR; PG8_WAIT_L(0); PG8_MMA(1, 0, At, B0); PG8_BAR; PG8_SCHED;
            PG8_STAGE(PG8_SB(1, 1), b3 + hstepB, voffB);
            PG8_WAIT_V(6); PG8_BAR; PG8_MMA(1, 1, At, B1); PG8_BAR;
            }
        }
        if constexpr (ALIGN_EPI) { if (wr == 0) PG8_BAR; }
        bool keep = false;
        if constexpr (Epi::KEEP) keep = E.seg(acc, cur, wr, wc, fr, fq); else { E(acc, cur, wr, wc, fr, fq); }
        S.done(cur);
        if (!has_next) break;
        if (!keep) {
#pragma unroll
        for (int a = 0; a < 2; ++a)
#pragma unroll
            for (int b = 0; b < 2; ++b)
#pragma unroll
                for (int m = 0; m < 4; ++m)
#pragma unroll
                    for (int n = 0; n < 2; ++n) acc[a][b][m][n] = (f32x4){0.f, 0.f, 0.f, 0.f};
        }
        cur = nxt; cA = nA; cB = nB; ++ui;
        if constexpr (ALIGN_EPI) { if (wr == 1) PG8_BAR; }
    }
    PG8_WAIT_V(0);
    if constexpr (!ALIGN_EPI) { if (wr == 0) PG8_BAR; }
    PG8_BAR;
#undef PG8_SA
#undef PG8_SB
#undef PG8_STAGE
#undef PG8_LDA
#undef PG8_LDB
#undef PG8_MMA
#undef PG8_WAIT_V
#undef PG8_WAIT_L
#undef PG8_BAR
#undef PG8_SCHED
}
}

__device__ __forceinline__ float bf2f(unsigned short b) { return __uint_as_float(((unsigned)b) << 16); }

namespace at {
typedef short bf16x8 __attribute__((ext_vector_type(8)));
typedef float f32x16 __attribute__((ext_vector_type(16)));
typedef float f32x2v __attribute__((ext_vector_type(2)));
typedef unsigned short bf16_t;
constexpr int VST = 144;
constexpr int KBYTES = 64 * 208, VBYTES = 64 * VST, BUFB = KBYTES + VBYTES;
constexpr int RPB_OFF = 2 * BUFB;
constexpr float LOG2E = 1.4426950408889634f;
enum { PLAIN = 0, WINDOW = 1, NATTEN = 2 };
struct Unit {
    const bf16_t *Q, *Q2, *K, *K2, *VT; bf16_t* O;
    int ldq, ldq2, ldk;
    int qrow0;
    int ntile, nloc, krow_loc0, krow_ctx0;
    int t0, j0;
    int rr, c0, krlo;
    float sink2; int has_sink;
};
__device__ __forceinline__ int sig(int r) { return (r & ~12) | ((r & 4) << 1) | ((r & 8) >> 1); }
__device__ __forceinline__ bf16x8 pack8(const f32x16& p, int s) {
    pg8::u32x4 w;
    w.x = pg8::cvt_pk_bf16(p[8 * s + 0], p[8 * s + 1]); w.y = pg8::cvt_pk_bf16(p[8 * s + 2], p[8 * s + 3]);
    w.z = pg8::cvt_pk_bf16(p[8 * s + 4], p[8 * s + 5]); w.w = pg8::cvt_pk_bf16(p[8 * s + 6], p[8 * s + 7]);
    return __builtin_bit_cast(bf16x8, w);
}
template <int DQK, int MODE>
__device__ __forceinline__ void attn_unit(unsigned char* lds_, const Unit& U, int tid) {
    static_assert(DQK == 64 && MODE != PLAIN, "masked 64-dim units only");
    typedef __attribute__((address_space(3))) unsigned char* ldsp_t;
    constexpr int NKS = DQK / 16, TK = 8192, TILE = 16384;
    const ldsp_t ldsl = (ldsp_t)lds_;
    unsigned char* const lds = lds_;
    const int lane = tid & 63, r = lane & 31, h = lane >> 5;
    const int wave = __builtin_amdgcn_readfirstlane(tid >> 6);
    bf16x8 qf[NKS];
    {
        const bf16_t* qp = U.Q + (unsigned)(U.qrow0 + r) * U.ldq + 8 * h;
#pragma unroll
        for (int ks = 0; ks < 4; ++ks) qf[ks] = *(const bf16x8*)(qp + 16 * ks);
    }
    f32x16 o0, o1;
#pragma unroll
    for (int i = 0; i < 16; ++i) { o0[i] = 0.f; o1[i] = 0.f; }
    float m = 0.f, lsum = 0.f;
    f32x16 negm;
#pragma unroll
    for (int i = 0; i < 16; ++i) negm[i] = 0.f;
    asm volatile("" : "+v"(negm));
    unsigned vm0 = 0u, vm1 = 0u; int vb = 0;
    if (MODE == NATTEN) {
        const int qc = U.c0 + r;
        int cst = qc - 8; cst = cst < 0 ? 0 : (cst > 48 ? 48 : cst);
#pragma unroll
        for (int i = 0; i < 16; ++i) {
            const int kc = 8 * h + (i & 7) + 16 * (i >> 3), e0 = kc - cst, e1 = kc + 32 - cst;
            if (e0 >= 0 && e0 < 16) vm0 |= 1u << i;
            if (e1 >= 0 && e1 < 16) vm1 |= 1u << i;
        }
        vb = 8 * h - qc + 15;
    }
    constexpr float THR = 8.f;
    const int drow = 8 * wave + (lane >> 3), dch = (lane & 7) ^ ((drow >> 1) & 7);
    const int sr = sig(r);
    unsigned kx[4], vx[4];
#pragma unroll
    for (int j = 0; j < 4; ++j) { kx[j] = (unsigned)(sr * 128 + (((2 * j + h) ^ ((sr >> 1) & 7)) << 4)); vx[j] = (unsigned)(TK + r * 128 + (((2 * j + h) ^ ((r >> 1) & 7)) << 4)); }
    auto tile_krow = [&](int ti) { return ti < U.nloc ? U.krow_loc0 + 64 * ti : U.krow_ctx0 + 64 * (ti - U.nloc); };
    auto issue = [&](int ti) {
        const int kr0 = tile_krow(ti); const unsigned pa = (unsigned)((ti & 1) * TILE + wave * 1024);
        __builtin_amdgcn_global_load_lds((const unsigned*)(U.K + (unsigned)(kr0 + drow) * U.ldk + dch * 8), (__attribute__((address_space(3))) unsigned*)(ldsl + pa), 16, 0, 0);
        __builtin_amdgcn_global_load_lds((const unsigned*)(U.VT + (unsigned)drow * MT + kr0 + dch * 8), (__attribute__((address_space(3))) unsigned*)(ldsl + pa + TK), 16, 0, 0);
    };
    auto need_of = [&](int ti, bool& masked, int& jt, int& kr) -> bool {
        bool need = true; masked = false; jt = 0; kr = 0;
        if (MODE == WINDOW && ti < U.nloc) {
            jt = U.j0 + 64 * ti;
            need = (jt + 63 >= U.t0 - 128) && (jt <= U.t0 + 31 + 128);
            masked = !((jt >= U.t0 + 31 - 128) && (jt + 63 <= U.t0 + 128));
        }
        if (MODE == NATTEN && ti < U.nloc) {
            kr = U.krlo + ti;
            int s0 = U.rr - 4; s0 = s0 < 0 ? 0 : (s0 > 24 ? 24 : s0);
            need = (kr >= s0) && (kr < s0 + 8);
            masked = true;
        }
        return need;
    };
    f32x16 c0, c1;
    issue(0);
    for (int ti = 0; ti < U.ntile; ++ti) {
        asm volatile("s_waitcnt vmcnt(0)" ::: "memory");
        __syncthreads();
        if (ti + 1 < U.ntile) issue(ti + 1);
        bool mk_c; int jt_c, kr_c;
        if (need_of(ti, mk_c, jt_c, kr_c)) {
            const ldsp_t tb = ldsl + (ti & 1) * TILE;
            {
#pragma unroll
                for (int ks = 0; ks < NKS; ++ks) {
                    const bf16x8 a0 = *(const __attribute__((address_space(3))) bf16x8*)(tb + kx[ks]), a1 = *(const __attribute__((address_space(3))) bf16x8*)(tb + kx[ks] + 32 * 128);
                    c0 = __builtin_amdgcn_mfma_f32_32x32x16_bf16(a0, qf[ks], ks == 0 ? negm : c0, 0, 0, 0);
                    c1 = __builtin_amdgcn_mfma_f32_32x32x16_bf16(a1, qf[ks], ks == 0 ? negm : c1, 0, 0, 0);
                }
            }
            if (mk_c) {
                if (MODE == WINDOW) {
                    const int t = U.t0 + r;
#pragma unroll
                    for (int i = 0; i < 16; ++i) {
                        const int j = jt_c + 8 * h + (i & 7) + 16 * (i >> 3);
                        const int d0 = t - j, d1 = t - (j + 32);
                        if (d0 > 128 || d0 < -128) c0[i] = -INFINITY;
                        if (d1 > 128 || d1 < -128) c1[i] = -INFINITY;
                    }
                }
                if (MODE == NATTEN) {
                    const float* rp = (const float*)(lds + RPB_OFF) + (kr_c - U.rr + 7) * 31 + vb;
#pragma unroll
                    for (int i = 0; i < 16; ++i) {
                        const int ko = (i & 7) + 16 * (i >> 3);
                        c0[i] = ((vm0 >> i) & 1u) ? c0[i] + rp[ko] : -INFINITY;
                        c1[i] = ((vm1 >> i) & 1u) ? c1[i] + rp[ko + 32] : -INFINITY;
                    }
                }
            }
            float mx = fmaxf(c0[0], c1[0]);
#pragma unroll
            for (int i = 1; i < 16; ++i) mx = fmaxf(fmaxf(mx, c0[i]), c1[i]);
            mx = fmaxf(mx, __shfl_xor(mx, 32));
            const bool grow = mx > THR, init = (lsum == 0.f) && (mx < -THR) && (mx > -1e30f);
            if (__any(grow || init)) {
                const float d = (grow || init) ? mx : 0.f;
                const float alpha = init ? 1.f : __builtin_amdgcn_exp2f(-d);
                m += d; lsum *= alpha;
#pragma unroll
                for (int i = 0; i < 16; ++i) { o0[i] *= alpha; o1[i] *= alpha; c0[i] -= d; c1[i] -= d; negm[i] -= d; }
                asm volatile("" : "+v"(negm));
            }
            f32x2v ps2 = {0.f, 0.f};
#pragma unroll
            for (int i = 0; i < 8; ++i) {
                c0[2 * i] = __builtin_amdgcn_exp2f(c0[2 * i]); c0[2 * i + 1] = __builtin_amdgcn_exp2f(c0[2 * i + 1]);
                c1[2 * i] = __builtin_amdgcn_exp2f(c1[2 * i]); c1[2 * i + 1] = __builtin_amdgcn_exp2f(c1[2 * i + 1]);
                const f32x2v a = {c0[2 * i], c0[2 * i + 1]}, bq = {c1[2 * i], c1[2 * i + 1]}; ps2 += a; ps2 += bq;
            }
            lsum += ps2.x + ps2.y;
#pragma unroll
            for (int s = 0; s < 2; ++s) {
                const bf16x8 p0 = pack8(c0, s), p1 = pack8(c1, s);
                const bf16x8 v00 = *(const __attribute__((address_space(3))) bf16x8*)(tb + vx[s]), v01 = *(const __attribute__((address_space(3))) bf16x8*)(tb + vx[s] + 32 * 128);
                const bf16x8 v10 = *(const __attribute__((address_space(3))) bf16x8*)(tb + vx[2 + s]), v11 = *(const __attribute__((address_space(3))) bf16x8*)(tb + vx[2 + s] + 32 * 128);
                o0 = __builtin_amdgcn_mfma_f32_32x32x16_bf16(v00, p0, o0, 0, 0, 0);
                o1 = __builtin_amdgcn_mfma_f32_32x32x16_bf16(v01, p0, o1, 0, 0, 0);
                o0 = __builtin_amdgcn_mfma_f32_32x32x16_bf16(v10, p1, o0, 0, 0, 0);
                o1 = __builtin_amdgcn_mfma_f32_32x32x16_bf16(v11, p1, o1, 0, 0, 0);
            }
        }
    }
    float l = lsum + __shfl_xor(lsum, 32);
    if (U.has_sink) l += __builtin_amdgcn_exp2f(U.sink2 - m);
    const float inv = 1.f / l;
    bf16_t* op = U.O + (unsigned)(U.qrow0 + r) * D + 4 * h;
#pragma unroll
    for (int g = 0; g < 4; ++g) {
        pg8::st_bf16x4(op + 8 * g, o0[4 * g] * inv, o0[4 * g + 1] * inv, o0[4 * g + 2] * inv, o0[4 * g + 3] * inv);
        pg8::st_bf16x4(op + 32 + 8 * g, o1[4 * g] * inv, o1[4 * g + 1] * inv, o1[4 * g + 2] * inv, o1[4 * g + 3] * inv);
    }
    __syncthreads();
}
template <int DQK>
__device__ __forceinline__ void attn_plain2(unsigned char* lds_, const Unit& U, int tid) {
    typedef __attribute__((address_space(3))) unsigned char* ldsp_t;
    constexpr int NKS = DQK / 16;
    constexpr int TK = 8192, TK2 = (DQK == 96 ? 4096 : 0), TV = 8192, TILE = TK + TK2 + TV, B2 = 2 * TILE;
    constexpr float THR = 8.f;
    const ldsp_t lds = (ldsp_t)lds_;
    const int lane = tid & 63, r = lane & 31, h = lane >> 5;
    const int wave = __builtin_amdgcn_readfirstlane(tid >> 6);
    bf16x8 qf[NKS];
    {
        const bf16_t* qp = U.Q + (unsigned)(U.qrow0 + r) * U.ldq + 8 * h;
#pragma unroll
        for (int ks = 0; ks < 4; ++ks) qf[ks] = *(const bf16x8*)(qp + 16 * ks);
        if (DQK == 96) {
            const bf16_t* qp2 = U.Q2 + (unsigned)(U.qrow0 + r) * U.ldq2 + 8 * h;
#pragma unroll
            for (int ks = 4; ks < NKS; ++ks) qf[ks] = *(const bf16x8*)(qp2 + 16 * (ks - 4));
        }
    }
    f32x16 o0, o1;
#pragma unroll
    for (int i = 0; i < 16; ++i) { o0[i] = 0.f; o1[i] = 0.f; }
    float m = 0.f, lsum = 0.f;
    f32x16 negm;
#pragma unroll
    for (int i = 0; i < 16; ++i) negm[i] = 0.f;
    asm volatile("" : "+v"(negm));
    const int drow = 8 * wave + (lane >> 3), dch = (lane & 7) ^ ((drow >> 1) & 7);
    const int d2row = 16 * wave + (lane >> 2), d2ch = (lane & 3) ^ ((d2row >> 2) & 3);
    const int sr = sig(r);
    unsigned kx[4], vx[4], k2x[2];
#pragma unroll
    for (int j = 0; j < 4; ++j) { kx[j] = (unsigned)(sr * 128 + (((2 * j + h) ^ ((sr >> 1) & 7)) << 4)); vx[j] = (unsigned)(TK + TK2 + r * 128 + (((2 * j + h) ^ ((r >> 1) & 7)) << 4)); }
#pragma unroll
    for (int j = 0; j < 2; ++j) k2x[j] = (unsigned)(TK + sr * 64 + (((2 * j + h) ^ ((sr >> 2) & 3)) << 4));
    auto tile_krow = [&](int ti) { return ti < U.nloc ? U.krow_loc0 + 64 * ti : U.krow_ctx0 + 64 * (ti - U.nloc); };
#define AT_DMA(src, dstoff) __builtin_amdgcn_global_load_lds((const unsigned*)(src), (__attribute__((address_space(3))) unsigned*)(lds + (dstoff)), 16, 0, 0)
    auto issue = [&](int si, const int buf) {
        const int ka0 = tile_krow(2 * si), kb0 = tile_krow(2 * si + 1);
        const unsigned pa = (unsigned)(buf * B2 + wave * 1024), pb = pa + TILE;
        AT_DMA(U.K + (unsigned)(ka0 + drow) * U.ldk + dch * 8, pa);
        AT_DMA(U.K + (unsigned)(kb0 + drow) * U.ldk + dch * 8, pb);
        if (DQK == 96) { if (wave < 4) { AT_DMA(U.K2 + (unsigned)(ka0 + d2row) * 32 + d2ch * 8, pa + TK); AT_DMA(U.K2 + (unsigned)(kb0 + d2row) * 32 + d2ch * 8, pb + TK); } }
        AT_DMA(U.VT + (unsigned)drow * MT + ka0 + dch * 8, pa + TK + TK2);
        AT_DMA(U.VT + (unsigned)drow * MT + kb0 + dch * 8, pb + TK + TK2);
    };
    const int nstep = U.ntile >> 1;
    auto step = [&](int si, const int buf) {
        asm volatile("s_waitcnt vmcnt(0)" ::: "memory");
        __syncthreads();
        if (si + 1 < nstep) issue(si + 1, buf ^ 1);
        const ldsp_t ba = lds + buf * B2; const ldsp_t bb = ba + TILE;
        f32x16 a0, a1, b0, b1;
        {
#pragma unroll
            for (int ks = 0; ks < NKS; ++ks) {
                const unsigned ko = ks < 4 ? kx[ks & 3] : k2x[(ks - 4) & 1]; const int hs = ks < 4 ? 32 * 128 : 32 * 64;
                const bf16x8 fa0 = *(const __attribute__((address_space(3))) bf16x8*)(ba + ko), fa1 = *(const __attribute__((address_space(3))) bf16x8*)(ba + ko + hs);
                const bf16x8 fb0 = *(const __attribute__((address_space(3))) bf16x8*)(bb + ko), fb1 = *(const __attribute__((address_space(3))) bf16x8*)(bb + ko + hs);
                a0 = __builtin_amdgcn_mfma_f32_32x32x16_bf16(fa0, qf[ks], ks == 0 ? negm : a0, 0, 0, 0);
                b0 = __builtin_amdgcn_mfma_f32_32x32x16_bf16(fb0, qf[ks], ks == 0 ? negm : b0, 0, 0, 0);
                a1 = __builtin_amdgcn_mfma_f32_32x32x16_bf16(fa1, qf[ks], ks == 0 ? negm : a1, 0, 0, 0);
                b1 = __builtin_amdgcn_mfma_f32_32x32x16_bf16(fb1, qf[ks], ks == 0 ? negm : b1, 0, 0, 0);
            }
        }
        float mx = fmaxf(a0[0], a1[0]), my = fmaxf(b0[0], b1[0]);
#pragma unroll
        for (int i = 1; i < 16; ++i) { mx = fmaxf(fmaxf(mx, a0[i]), a1[i]); my = fmaxf(fmaxf(my, b0[i]), b1[i]); }
        mx = fmaxf(mx, my);
        mx = fmaxf(mx, __shfl_xor(mx, 32));
        const bool grow = mx > THR, init = (lsum == 0.f) && (mx < -THR) && (mx > -1e30f);
        if (__any(grow || init)) {
            const float d = (grow || init) ? mx : 0.f;
            const float alpha = init ? 1.f : __builtin_amdgcn_exp2f(-d);
            m += d; lsum *= alpha;
#pragma unroll
            for (int i = 0; i < 16; ++i) { o0[i] *= alpha; o1[i] *= alpha; a0[i] -= d; a1[i] -= d; b0[i] -= d; b1[i] -= d; negm[i] -= d; }
            asm volatile("" : "+v"(negm));
        }
        f32x2v ps2 = {0.f, 0.f}, pt2 = {0.f, 0.f};
#pragma unroll
        for (int i = 0; i < 8; ++i) {
            a0[2 * i] = __builtin_amdgcn_exp2f(a0[2 * i]); a0[2 * i + 1] = __builtin_amdgcn_exp2f(a0[2 * i + 1]);
            a1[2 * i] = __builtin_amdgcn_exp2f(a1[2 * i]); a1[2 * i + 1] = __builtin_amdgcn_exp2f(a1[2 * i + 1]);
            const f32x2v x = {a0[2 * i], a0[2 * i + 1]}, y = {a1[2 * i], a1[2 * i + 1]}; ps2 += x; ps2 += y;
        }
#pragma unroll
        for (int st = 0; st < 2; ++st) {
            const bf16x8 p0 = pack8(a0, st), p1 = pack8(a1, st);
            const bf16x8 v00 = *(const __attribute__((address_space(3))) bf16x8*)(ba + vx[st]), v01 = *(const __attribute__((address_space(3))) bf16x8*)(ba + vx[st] + 32 * 128);
            const bf16x8 v10 = *(const __attribute__((address_space(3))) bf16x8*)(ba + vx[2 + st]), v11 = *(const __attribute__((address_space(3))) bf16x8*)(ba + vx[2 + st] + 32 * 128);
            o0 = __builtin_amdgcn_mfma_f32_32x32x16_bf16(v00, p0, o0, 0, 0, 0);
            o1 = __builtin_amdgcn_mfma_f32_32x32x16_bf16(v01, p0, o1, 0, 0, 0);
            o0 = __builtin_amdgcn_mfma_f32_32x32x16_bf16(v10, p1, o0, 0, 0, 0);
            o1 = __builtin_amdgcn_mfma_f32_32x32x16_bf16(v11, p1, o1, 0, 0, 0);
        }
#pragma unroll
        for (int i = 0; i < 8; ++i) {
            b0[2 * i] = __builtin_amdgcn_exp2f(b0[2 * i]); b0[2 * i + 1] = __builtin_amdgcn_exp2f(b0[2 * i + 1]);
            b1[2 * i] = __builtin_amdgcn_exp2f(b1[2 * i]); b1[2 * i + 1] = __builtin_amdgcn_exp2f(b1[2 * i + 1]);
            const f32x2v x = {b0[2 * i], b0[2 * i + 1]}, y = {b1[2 * i], b1[2 * i + 1]}; pt2 += x; pt2 += y;
        }
        lsum += (ps2.x + ps2.y) + (pt2.x + pt2.y);
#pragma unroll
        for (int st = 0; st < 2; ++st) {
            const bf16x8 p0 = pack8(b0, st), p1 = pack8(b1, st);
            const bf16x8 v00 = *(const __attribute__((address_space(3))) bf16x8*)(bb + vx[st]), v01 = *(const __attribute__((address_space(3))) bf16x8*)(bb + vx[st] + 32 * 128);
            const bf16x8 v10 = *(const __attribute__((address_space(3))) bf16x8*)(bb + vx[2 + st]), v11 = *(const __attribute__((address_space(3))) bf16x8*)(bb + vx[2 + st] + 32 * 128);
            o0 = __builtin_amdgcn_mfma_f32_32x32x16_bf16(v00, p0, o0, 0, 0, 0);
            o1 = __builtin_amdgcn_mfma_f32_32x32x16_bf16(v01, p0, o1, 0, 0, 0);
            o0 = __builtin_amdgcn_mfma_f32_32x32x16_bf16(v10, p1, o0, 0, 0, 0);
            o1 = __builtin_amdgcn_mfma_f32_32x32x16_bf16(v11, p1, o1, 0, 0, 0);
        }
    };
    issue(0, 0);
    for (int si = 0; si < nstep; si += 2) {
        step(si, 0);
        if (si + 1 < nstep) step(si + 1, 1);
    }
#undef AT_DMA
    float l = lsum + __shfl_xor(lsum, 32);
    if (U.has_sink) l += __builtin_amdgcn_exp2f(U.sink2 - m);
    const float inv = 1.f / l;
    bf16_t* op = U.O + (unsigned)(U.qrow0 + r) * D + 4 * h;
#pragma unroll
    for (int g = 0; g < 4; ++g) {
        pg8::st_bf16x4(op + 8 * g, o0[4 * g] * inv, o0[4 * g + 1] * inv, o0[4 * g + 2] * inv, o0[4 * g + 3] * inv);
        pg8::st_bf16x4(op + 32 + 8 * g, o1[4 * g] * inv, o1[4 * g + 1] * inv, o1[4 * g + 2] * inv, o1[4 * g + 3] * inv);
    }
    __syncthreads();
}
}

struct ConvDesc { const float* src; size_t ldn; unsigned short* dst; size_t ldd; int mode; };
__device__ __forceinline__ void conv_issue(const ConvDesc& d, float4 (&v)[4]) {
    const int tid = opaque_tid();
    const int rq = tid & 7, kk0 = tid >> 3;
    const int cq = d.mode == 1 ? (16 * (rq & 1) + 4 * (rq >> 1)) : rq * 4;
#pragma unroll
    for (int i = 0; i < 4; ++i) v[i] = d.mode == 2 ? make_float4(0.f, 0.f, 0.f, 0.f) : *(const float4*)(d.src + (size_t)(kk0 + 64 * i) * d.ldn + cq);
}
__device__ __forceinline__ void conv_finish(const ConvDesc& d, const float4 (&v)[4], float* t  ) {
    const int tid = opaque_tid();
    {
        const int rq = tid & 7, kk0 = tid >> 3;
        __syncthreads();
#pragma unroll
        for (int i = 0; i < 4; ++i) { float* p = t + (kk0 + 64 * i) * 33 + rq * 4; p[0] = v[i].x; p[1] = v[i].y; p[2] = v[i].z; p[3] = v[i].w; }
    }
    __syncthreads();
    {
        const int rr = tid >> 4, kq = tid & 15;
#pragma unroll
        for (int i = 0; i < 2; ++i) {
            const int k = i * 128 + kq * 8;
            float f[8];
#pragma unroll
            for (int j = 0; j < 8; ++j) f[j] = t[(k + j) * 33 + rr];
            pg8::u32x4 w; w.x = pg8::cvt_pk_bf16(f[0], f[1]); w.y = pg8::cvt_pk_bf16(f[2], f[3]); w.z = pg8::cvt_pk_bf16(f[4], f[5]); w.w = pg8::cvt_pk_bf16(f[6], f[7]);
            *(pg8::u32x4*)(d.dst + (size_t)rr * d.ldd + k) = w;
        }
    }
}
__device__ __forceinline__ ConvDesc conv_item(const float* src, size_t ldn, unsigned short* dst, size_t ldd, int mode = 0) {
    ConvDesc d; d.src = src; d.ldn = ldn; d.dst = dst; d.ldd = ldd; d.mode = mode; return d;
}
constexpr int FFN_CONV_ITEMS = 896 + 448;
__device__ __forceinline__ ConvDesc conv_ffn_item(int it, const float* w1, const float* w3, const float* w2, unsigned short* w13t, unsigned short* w2t) {
    if (it < 896) {
        const int rb = it >> 2, kb = it & 3, R0 = rb * 32, pn = R0 >> 8, cc = R0 & 255;
        const float* src = (cc < 128 ? w1 : w3) + (size_t)(kb * 256) * DFF + pn * 128 + (cc & 127);
        return conv_item(src, DFF, w13t + (size_t)R0 * D + kb * 256, D);
    } else {
        const int it2 = it - 896, rb = it2 / 14, kb = it2 % 14;
        return conv_item(w2 + (size_t)(kb * 256) * D + rb * 32, D, w2t + (size_t)(rb * 32) * DFF + kb * 256, DFF);
    }
}
__device__ __forceinline__ ConvDesc conv_win_item(const Ctx C, int l, int r) {
    const int rb = r >> 2, kb = r & 3, R0 = rb * 32, pc = R0 >> 8, cc = R0 & 255, wc = (cc >> 5) & 3, bj = cc >> 7;
    int col0, mode = 0;
    if (pc <= 4) col0 = (pc == 0 ? P_AQ : pc == 1 ? P_AK : pc == 2 ? P_AV : pc == 3 ? P_BQ : P_CQ) + 64 * wc + 32 * bj;
    else if (pc == 5) col0 = (wc < 2 ? P_BK + 64 * wc : P_CK + 64 * (wc - 2)) + 32 * bj;
    else if (pc == 6) col0 = (wc < 2 ? P_BV + 64 * wc : P_CV + 64 * (wc - 2)) + 32 * bj;
    else if (pc == 7) col0 = P_DQA + cc;
    else if (pc == 8) { if (cc < 128) col0 = P_DKVA + cc; else if (cc == 128) { col0 = P_DKVA + 128; mode = 1; } else { col0 = 0; mode = 2; } }
    else col0 = P_GATE + (pc - 9) * 256 + cc;
    return conv_item(C.w_in() + ((size_t)l * D + kb * 256) * INW + col0, INW, C.WIN() + ((size_t)l * INWP + R0) * D + kb * 256, D, mode);
}
__device__ __forceinline__ ConvDesc conv_brout_item(const Ctx C, int l, int r) {
    if (r < 128) { const int nb = (r >> 5) & 3, rb = r & 31;
        return conv_item(C.w_branch() + ((size_t)(l * 4 + nb) * 256) * D + rb * 32, D, C.WBR() + ((size_t)l * D + rb * 32) * D + nb * 256, D); }
    else { const int q = r - 128, rb = (q >> 2) & 31, kb = q & 3;
        return conv_item(C.w_out() + ((size_t)l * D + kb * 256) * D + rb * 32, D, C.WOUT() + ((size_t)l * D + rb * 32) * D + kb * 256, D); }
}
__device__ __forceinline__ ConvDesc conv_dense_item(const Ctx C, int l2, int r) {
    return conv_ffn_item(r, C.ffn_w1() + (size_t)l2 * D * DFF, C.ffn_w3() + (size_t)l2 * D * DFF, C.ffn_w2() + (size_t)l2 * DFF * D, C.W13D() + (size_t)l2 * 2 * DFF * D, C.W2D() + (size_t)l2 * D * DFF);
}
__device__ __forceinline__ ConvDesc conv_moe_item(const Ctx C, int l2, int it) {
    const int e = it / FFN_CONV_ITEMS, r = it % FFN_CONV_ITEMS; const size_t le = (size_t)l2 * NE + e;
    return conv_ffn_item(r, C.moe_w1() + le * D * DFF, C.moe_w3() + le * D * DFF, C.moe_w2() + le * DFF * D, C.W13M() + (size_t)e * 2 * DFF * D, C.W2M() + (size_t)e * D * DFF);
}
constexpr int MOE_CONV_ITEMS = NE * FFN_CONV_ITEMS;
constexpr int BG_J0 = 0, BG_J1 = BG_J0 + FFN_CONV_ITEMS  , BG_J2 = BG_J1 + 800  , BG_J3 = BG_J2 + 256  , BG_J4 = BG_J3 + MOE_CONV_ITEMS  ,
              BG_J5 = BG_J4 + 800  , BG_J6 = BG_J5 + 256  , BG_J7 = BG_J6 + FFN_CONV_ITEMS  , BG_J8 = BG_J7 + 800  ,
              BG_J9 = BG_J8 + 256  , BG_END = BG_J9 + MOE_CONV_ITEMS  ;
__device__ __forceinline__ ConvDesc bg_item(const Ctx C, int g) {
    if (g < BG_J1) return conv_dense_item(C, 0, g - BG_J0);
    if (g < BG_J2) return conv_win_item(C, 1, g - BG_J1);
    if (g < BG_J3) return conv_brout_item(C, 1, g - BG_J2);
    if (g < BG_J4) return conv_moe_item(C, 0, g - BG_J3);
    if (g < BG_J5) return conv_win_item(C, 2, g - BG_J4);
    if (g < BG_J6) return conv_brout_item(C, 2, g - BG_J5);
    if (g < BG_J7) return conv_dense_item(C, 1, g - BG_J6);
    if (g < BG_J8) return conv_win_item(C, 3, g - BG_J7);
    if (g < BG_J9) return conv_brout_item(C, 3, g - BG_J8);
    return conv_moe_item(C, 1, g - BG_J9);
}
__device__ __forceinline__ void bg_run(const Ctx C, int first, int limit, int per_wg, int rank, int nwg) {
    const int g0 = first + rank;
    if (per_wg > 0 && g0 < limit) {
        ConvDesc d0, d1; float4 v0[4], v1[4];
        d0 = bg_item(C, g0); conv_issue(d0, v0);
        for (int j = 0; j < per_wg; ++j) {
            const int gn = first + rank + (j + 1) * nwg; const bool hn = (j + 1 < per_wg) && (gn < limit);
            if (hn) { d1 = bg_item(C, gn); conv_issue(d1, v1); }
            conv_finish(d0, v0, C.lds);
            if (!hn) break;
            d0 = d1;
#pragma unroll
            for (int i = 0; i < 4; ++i) v0[i] = v1[i];
        }
    }
    __syncthreads();
}
constexpr int BGW_IN = 248 * 11, BGW_MLA = 224 * 7, BGW_BR = 224 * 18, BGW_LAYER = BGW_IN + BGW_MLA + BGW_BR;
static_assert(BGW_LAYER + BGW_IN + BGW_MLA + BGW_BR >= BG_J9 && BGW_LAYER + BGW_IN + BGW_MLA <= BG_J9, "layer 1's windows must end exactly at the start of MoE layer 3's items");
__device__ __forceinline__ int bg_layer_base(int l) { return l == 0 ? 0 : (l == 1 ? BGW_LAYER : (l == 2 ? BG_J9 : BG_J9 + BGW_LAYER)); }
static_assert(BG_J9 + BGW_LAYER + 120 * 11 + BGW_MLA >= BG_END, "the background list must be finished by the end of layer 3's MLA phase");

__device__ __forceinline__ void conv_prologue(const Ctx C) {
    const int tidx_ = opaque_tid();
    {
        auto desc = [&](int it, ConvDesc& d) { if (it < 800) d = conv_win_item(C, 0, it); else d = conv_brout_item(C, 0, it - 800); };
        int it = blockIdx.x;
        if (it < 800 + 256) {
            ConvDesc d0, d1; float4 v0[4], v1[4];
            desc(it, d0); conv_issue(d0, v0);
            for (;;) {
                const int itn = it + (int)gridDim.x; const bool hn = itn < 800 + 256;
                if (hn) { desc(itn, d1); conv_issue(d1, v1); }
                conv_finish(d0, v0, C.lds);
                if (!hn) break;
                d0 = d1; it = itn;
#pragma unroll
                for (int i = 0; i < 4; ++i) v0[i] = v1[i];
            }
        }
    }
    __syncthreads();
    for (int it = (int)blockIdx.x - (int)(gridDim.x / 2); it >= 0 && it < DEPTH * 32; it += (int)gridDim.x) {
        const int l = it >> 5, rb = it & 31;
        float* t = C.lds;
        {
            const int tc = tidx_ & 31, tr = tidx_ >> 5, R = rb * 32 + tc;
            const int pc = R >> 8, cc = R & 255, bj = cc >> 7, wc = (cc >> 5) & 3, sl = cc & 31;
            const bool qpart = pc < 2;
            int col = -1;
            if (pc == 0) col = wc * 96 + 32 * bj + sl;
            else if (pc == 1) { if (bj == 0) col = wc * 96 + 64 + 16 * ((sl >> 2) & 1) + 4 * (sl >> 3) + (sl & 3); }
            else if (pc == 2) col = wc * 128 + 32 * bj + sl;
            else col = wc * 128 + 64 + 32 * bj + sl;
            const float* wsrc = qpart ? C.mla_wqb() + (size_t)l * 256 * 384 : C.mla_wkvb() + (size_t)l * 128 * 512;
            const float* gsrc = qpart ? C.mla_qnorm() + l * 256 : C.mla_kvnorm() + l * 128;
            const int wst = qpart ? 384 : 512, kb = qpart ? 0 : 256, zb = qpart ? 256 : 0, nz = qpart ? 8 : 16;
            const int cl = col < 0 ? 0 : col;
            float wv[16], gv[16];
            if (qpart) {
#pragma unroll
                for (int j = 0; j < 16; ++j) { wv[j] = wsrc[(size_t)(tr + 16 * j) * wst + cl]; gv[j] = gsrc[tr + 16 * j]; }
#pragma unroll
                for (int j = 0; j < 16; ++j) t[(kb + tr + 16 * j) * 33 + tc] = col < 0 ? 0.f : wv[j] * gv[j];
            } else {
#pragma unroll
                for (int j = 0; j < 8; ++j) { wv[j] = wsrc[(size_t)(tr + 16 * j) * wst + cl]; gv[j] = gsrc[tr + 16 * j]; }
#pragma unroll
                for (int j = 0; j < 8; ++j) t[(kb + tr + 16 * j) * 33 + tc] = wv[j] * gv[j];
            }
            for (int j = 0; j < nz; ++j) t[(zb + tr + 16 * j) * 33 + tc] = 0.f;
        }
        __syncthreads();
        {
            const int rr = tidx_ >> 4, kq = tidx_ & 15;
#pragma unroll
            for (int j = 0; j < 3; ++j) {
                const int k = (j * 16 + kq) * 8;
                float f[8];
#pragma unroll
                for (int q = 0; q < 8; ++q) f[q] = t[(k + q) * 33 + rr];
                pg8::u32x4 w; w.x = pg8::cvt_pk_bf16(f[0], f[1]); w.y = pg8::cvt_pk_bf16(f[2], f[3]); w.z = pg8::cvt_pk_bf16(f[4], f[5]); w.w = pg8::cvt_pk_bf16(f[6], f[7]);
                *(pg8::u32x4*)(C.WMLA() + ((size_t)l * 1024 + rb * 32 + rr) * 384 + k) = w;
            }
        }
        __syncthreads();
    }
}
__device__ __forceinline__ void ph_prologue(const Ctx C) {
    const int tidx_ = opaque_tid();
    const int lane = tidx_ & 63, wave = tidx_ >> 6;
    {
        float* sc = C.lds;
        float* part = C.lds + 9 * D;
        for (int i = tidx_; i < 9 * D; i += NTHREADS) { const int r = i >> 10, d = i & (D - 1); sc[i] = siluf(r < 8 ? C.c()[r * D + d] : C.c_ctx()[d]); }
        __syncthreads();
        for (int it = blockIdx.x; it < DEPTH * (ADAW / 64); it += gridDim.x) {
            const int l = it / (ADAW / 64), e = (it % (ADAW / 64)) * 64 + lane;
            float acc[9];
#pragma unroll
            for (int r = 0; r < 9; ++r) acc[r] = 0.f;
            const float* w = C.w_ada() + ((size_t)l * D + wave * 128) * ADAW + e;
#pragma unroll 8
            for (int d = 0; d < 128; ++d) {
                const float wv = w[(size_t)d * ADAW];
#pragma unroll
                for (int r = 0; r < 9; ++r) acc[r] = fmaf(sc[r * D + wave * 128 + d], wv, acc[r]);
            }
#pragma unroll
            for (int r = 0; r < 9; ++r) part[(wave * 9 + r) * 64 + lane] = acc[r];
            __syncthreads();
            for (int i = tidx_; i < 9 * 64; i += NTHREADS) {
                float t = 0.f;
#pragma unroll
                for (int w8 = 0; w8 < 8; ++w8) t += part[w8 * 576 + i];
                const int r = i >> 6, ee = (it % (ADAW / 64)) * 64 + (i & 63);
                C.MOD()[((size_t)l * 9 + r) * ADAW + ee] = t + C.b_ada()[l * ADAW + ee];
            }
            __syncthreads();
        }
    }
    for (int i = blockIdx.x * NTHREADS + tidx_; i < SEQ * 32; i += gridDim.x * NTHREADS) {
        const int t = i >> 5, j = i & 31;
        const int pos = j < 16 ? (t / GW) : (t % GW);
        const float inv = powf(10000.f, -(float)(j & 15) / 16.f);
        const float ang = (float)pos * inv;
        C.ROPE()[t * 32 + j] = cosf(ang); C.ROPE()[SEQ * 32 + t * 32 + j] = sinf(ang);
        if (j < 16) {
            const int pos2 = j < 8 ? (t / GW) : (t % GW);
            const float inv2 = powf(10000.f, -(float)(j & 7) / 8.f);
            const float a2 = (float)pos2 * inv2;
            C.ROPE()[SEQ * 64 + t * 16 + j] = cosf(a2); C.ROPE()[SEQ * 64 + SEQ * 16 + t * 16 + j] = sinf(a2);
        }
    }
}

__device__ __forceinline__ int block_row(int b, int i, int nrows) { return (nrows == MT && i >= 64) ? ML + b * 8 + (i - 64) : b * 64 + i; }
__device__ __forceinline__ void ph_norm(const Ctx C, int l, int mode) {
    const int tidx_ = opaque_tid();
    const int lane = tidx_ & 63, wave = tidx_ >> 6;
#define CB(i) ((((i) >> 1) << 9) + lane * 8 + (((i) & 1) << 2))
    const bool moe_prev = (mode == 0 && l > 0 && ((l - 1) & 1)) || mode == 2;
    const int lp = (mode == 2) ? DEPTH - 1 : l - 1;
    const int nrows = (mode == 2) ? ML : ((mode == 1 && l == DEPTH - 1) ? ML : MT);
    const bool route = (mode == 1) && (l & 1);
    int* hist = (int*)C.lds;
    float* const Rl = C.lds + 64;
    if (route) {
        if (tidx_ < NE) hist[tidx_] = 0;
        const float* R = C.moe_router() + (size_t)(l >> 1) * D * NE;
        for (int q = tidx_; q < D * 2; q += NTHREADS) { const int d = q >> 1; *(float4*)(Rl + d * 8 + (d >> 3) * 4 + (q & 1) * 4) = *(const float4*)(R + q * 4); }
        __syncthreads();
    }
    const int rows_per_block = nrows / gridDim.x;
    const bool src_f32 = (mode == 0 && l == 0);
    auto ldrow = [&](int row, float4 (&dst)[4]) {
        if (src_f32) {
            const float* s0 = row < ML ? C.x() + (size_t)row * D : C.ctx() + (size_t)(row - ML) * D;
#pragma unroll
            for (int i = 0; i < 4; ++i) dst[i] = *(const float4*)(s0 + CB(i));
        } else {
            const unsigned short* s0 = C.X() + (size_t)row * D;
#pragma unroll
            for (int i = 0; i < 4; i += 2) { const uint4 t = *(const uint4*)(s0 + CB(i)); dst[i].x = __uint_as_float(t.x); dst[i].y = __uint_as_float(t.y); dst[i + 1].x = __uint_as_float(t.z); dst[i + 1].y = __uint_as_float(t.w); }
        }
    };
    float4 hA0, hA1, hA2, hA3, hB0, hB1, hB2, hB3;
    {
        const float* gn0 = mode == 2 ? C.final_g() : (mode == 0 ? C.norm1_g() : C.norm2_g()) + l * D;
        const float* md0 = C.MOD() + ((size_t)l * 9 + (blockIdx.x >> 5)) * ADAW + (mode == 0 ? 0 : 3 * D);
        auto ld = [&](int i, float4& a, float4& b) {
            const float4 g = *(const float4*)(gn0 + CB(i));
            float4 sh = make_float4(0.f, 0.f, 0.f, 0.f), sc = sh;
            if (mode != 2) { sh = *(const float4*)(md0 + CB(i)); sc = *(const float4*)(md0 + D + CB(i)); }
            a = make_float4(g.x * (1.f + sc.x), g.y * (1.f + sc.y), g.z * (1.f + sc.z), g.w * (1.f + sc.w)); b = sh;
        };
        ld(0, hA0, hB0); ld(1, hA1, hB1); ld(2, hA2, hB2); ld(3, hA3, hB3);
    }
    float4 gM0 = make_float4(0.f, 0.f, 0.f, 0.f), gM1 = gM0, gM2 = gM0, gM3 = gM0;
    if (moe_prev) { const float* g2 = C.MOD() + ((size_t)lp * 9 + (blockIdx.x >> 5)) * ADAW + 5 * D; gM0 = *(const float4*)(g2 + CB(0)); gM1 = *(const float4*)(g2 + CB(1)); gM2 = *(const float4*)(g2 + CB(2)); gM3 = *(const float4*)(g2 + CB(3)); }
    float4 vn[4], vm[4];
#pragma unroll
    for (int i = 0; i < 4; ++i) { vn[i] = make_float4(0.f, 0.f, 0.f, 0.f); vm[i] = vn[i]; }
    if (wave < rows_per_block) ldrow(block_row(blockIdx.x, wave, nrows), vn);
    if (wave + NWAVES < rows_per_block) ldrow(block_row(blockIdx.x, wave + NWAVES, nrows), vm);
    int ps0 = 0, ps1 = 0; float pw0 = 0.f, pw1 = 0.f;
    if (moe_prev && wave < rows_per_block) { const int r0_ = block_row(blockIdx.x, wave, nrows); ps0 = C.SLOT()[r0_ * 2]; ps1 = C.SLOT()[r0_ * 2 + 1]; pw0 = C.TOPW()[r0_ * 2]; pw1 = C.TOPW()[r0_ * 2 + 1]; }
    for (int ri = wave; ri < rows_per_block; ri += NWAVES) {
        const int row = block_row(blockIdx.x, ri, nrows);
        const int mr = modrow(row);
        const int s0 = ps0, s1 = ps1; const float w0 = pw0, w1 = pw1;
        uint4 yr0[2] = {make_uint4(0, 0, 0, 0), make_uint4(0, 0, 0, 0)}, yr1[2] = {make_uint4(0, 0, 0, 0), make_uint4(0, 0, 0, 0)};
        if (moe_prev) {
#pragma unroll
            for (int q = 0; q < 2; ++q) { yr0[q] = *(const uint4*)(C.Y() + (size_t)s0 * D + CB(2 * q)); yr1[q] = *(const uint4*)(C.Y() + (size_t)s1 * D + CB(2 * q)); }
            if (ri + NWAVES < rows_per_block) { const int rn = block_row(blockIdx.x, ri + NWAVES, nrows); ps0 = C.SLOT()[rn * 2]; ps1 = C.SLOT()[rn * 2 + 1]; pw0 = C.TOPW()[rn * 2]; pw1 = C.TOPW()[rn * 2 + 1]; }
        }
        float4 v[4];
#pragma unroll
        for (int i = 0; i < 4; ++i) {
            if (src_f32) v[i] = vn[i];
            else { const unsigned a = __float_as_uint(vn[i].x), b = __float_as_uint(vn[i].y); v[i] = make_float4(__uint_as_float(a << 16), __uint_as_float(a & 0xffff0000u), __uint_as_float(b << 16), __uint_as_float(b & 0xffff0000u)); }
            vn[i] = vm[i];
        }
        if (ri + 2 * NWAVES < rows_per_block) ldrow(block_row(blockIdx.x, ri + 2 * NWAVES, nrows), vm);
        bool wr_x = (mode == 0 && l == 0);
        {
            const int np = (mode == 1 && l < DEPTH - 1) ? 4 : ((mode == 0 && l > 0 && !((l - 1) & 1)) ? 7 : 0);
            if (np && row >= ML) {
                const float* gt = (mode == 1) ? C.MOD() + ((size_t)l * 9 + 8) * ADAW + 2 * D : C.MOD() + ((size_t)(l - 1) * 9 + 8) * ADAW + 5 * D;
                const unsigned short* pb = C.PART() + (size_t)(row - ML) * D;
                float4 g4[4], sm[4];
#pragma unroll
                for (int i = 0; i < 4; ++i) { g4[i] = *(const float4*)(gt + CB(i)); sm[i] = make_float4(0.f, 0.f, 0.f, 0.f); }
                auto addp = [&](const uint4 t, int q) {
                    sm[2 * q].x += __uint_as_float(t.x << 16); sm[2 * q].y += __uint_as_float(t.x & 0xffff0000u); sm[2 * q].z += __uint_as_float(t.y << 16); sm[2 * q].w += __uint_as_float(t.y & 0xffff0000u);
                    sm[2 * q + 1].x += __uint_as_float(t.z << 16); sm[2 * q + 1].y += __uint_as_float(t.z & 0xffff0000u); sm[2 * q + 1].z += __uint_as_float(t.w << 16); sm[2 * q + 1].w += __uint_as_float(t.w & 0xffff0000u);
                };
                if (np == 4) {
                    uint4 t[4][2];
#pragma unroll
                    for (int p = 0; p < 4; ++p) { t[p][0] = *(const uint4*)(pb + (size_t)p * MC * D + CB(0)); t[p][1] = *(const uint4*)(pb + (size_t)p * MC * D + CB(2)); }
#pragma unroll
                    for (int p = 0; p < 4; ++p) { addp(t[p][0], 0); addp(t[p][1], 1); }
                } else {
                    uint4 t[7][2];
#pragma unroll
                    for (int p = 0; p < 7; ++p) { t[p][0] = *(const uint4*)(pb + (size_t)p * MC * D + CB(0)); t[p][1] = *(const uint4*)(pb + (size_t)p * MC * D + CB(2)); }
#pragma unroll
                    for (int p = 0; p < 7; ++p) { addp(t[p][0], 0); addp(t[p][1], 1); }
                }
#pragma unroll
                for (int i = 0; i < 4; ++i) { v[i].x += g4[i].x * sm[i].x; v[i].y += g4[i].y * sm[i].y; v[i].z += g4[i].z * sm[i].z; v[i].w += g4[i].w * sm[i].w; }
                wr_x = true;
            }
        }
        if (moe_prev && (row < ML || lp != DEPTH - 1)) {
            auto unp = [&](const uint4 t, float4& a, float4& b) {
                a = make_float4(__uint_as_float(t.x << 16), __uint_as_float(t.x & 0xffff0000u), __uint_as_float(t.y << 16), __uint_as_float(t.y & 0xffff0000u));
                b = make_float4(__uint_as_float(t.z << 16), __uint_as_float(t.z & 0xffff0000u), __uint_as_float(t.w << 16), __uint_as_float(t.w & 0xffff0000u));
            };
#pragma unroll
            for (int i = 0; i < 4; i += 2) {
                float4 y0a, y0b, y1a, y1b; unp(yr0[i >> 1], y0a, y0b); unp(yr1[i >> 1], y1a, y1b);
                if (s0 >= YSPLIT_P0 * 256) { float4 ta, tb; unp(*(const uint4*)(C.Y2() + (size_t)(s0 - YSPLIT_P0 * 256) * D + CB(i)), ta, tb); y0a.x += ta.x; y0a.y += ta.y; y0a.z += ta.z; y0a.w += ta.w; y0b.x += tb.x; y0b.y += tb.y; y0b.z += tb.z; y0b.w += tb.w; }
                if (s1 >= YSPLIT_P0 * 256) { float4 ta, tb; unp(*(const uint4*)(C.Y2() + (size_t)(s1 - YSPLIT_P0 * 256) * D + CB(i)), ta, tb); y1a.x += ta.x; y1a.y += ta.y; y1a.z += ta.z; y1a.w += ta.w; y1b.x += tb.x; y1b.y += tb.y; y1b.z += tb.z; y1b.w += tb.w; }
                float4 ga = i == 0 ? gM0 : gM2, gb = i == 0 ? gM1 : gM3;
                if (row >= ML) { const float* g2 = C.MOD() + ((size_t)lp * 9 + 8) * ADAW + 5 * D; ga = *(const float4*)(g2 + CB(i)); gb = *(const float4*)(g2 + CB(i + 1)); }
                v[i].x += ga.x * (w0 * y0a.x + w1 * y1a.x); v[i].y += ga.y * (w0 * y0a.y + w1 * y1a.y);
                v[i].z += ga.z * (w0 * y0a.z + w1 * y1a.z); v[i].w += ga.w * (w0 * y0a.w + w1 * y1a.w);
                v[i + 1].x += gb.x * (w0 * y0b.x + w1 * y1b.x); v[i + 1].y += gb.y * (w0 * y0b.y + w1 * y1b.y);
                v[i + 1].z += gb.z * (w0 * y0b.z + w1 * y1b.z); v[i + 1].w += gb.w * (w0 * y0b.w + w1 * y1b.w);
            }
            wr_x = true;
        }
        if (wr_x && mode != 2) {
#pragma unroll
            for (int i = 0; i < 4; i += 2) { pg8::u32x4 w; w.x = pg8::cvt_pk_bf16(v[i].x, v[i].y); w.y = pg8::cvt_pk_bf16(v[i].z, v[i].w); w.z = pg8::cvt_pk_bf16(v[i + 1].x, v[i + 1].y); w.w = pg8::cvt_pk_bf16(v[i + 1].z, v[i + 1].w); *(pg8::u32x4*)(C.X() + (size_t)row * D + CB(i)) = w; }
        }
        float ss = 0.f;
#pragma unroll
        for (int i = 0; i < 4; ++i) ss += v[i].x * v[i].x + v[i].y * v[i].y + v[i].z * v[i].z + v[i].w * v[i].w;
        ss = wave_sum(ss);
        const float rs = rsqrtf(ss * (1.0f / D) + EPS);
        float4 a0 = hA0, a1 = hA1, a2 = hA2, a3 = hA3, b0 = hB0, b1 = hB1, b2 = hB2, b3 = hB3;
        if (mode != 2 && row >= ML) {
            const float* gn = (mode == 0 ? C.norm1_g() : C.norm2_g()) + l * D;
            const float* md = C.MOD() + ((size_t)l * 9 + 8) * ADAW + (mode == 0 ? 0 : 3 * D);
            float4 cg[4], csc[4];
#pragma unroll
            for (int i = 0; i < 4; ++i) { cg[i] = *(const float4*)(gn + CB(i)); csc[i] = *(const float4*)(md + D + CB(i)); }
            b0 = *(const float4*)(md + CB(0)); b1 = *(const float4*)(md + CB(1)); b2 = *(const float4*)(md + CB(2)); b3 = *(const float4*)(md + CB(3));
            auto mk = [&](int i) { return make_float4(cg[i].x * (1.f + csc[i].x), cg[i].y * (1.f + csc[i].y), cg[i].z * (1.f + csc[i].z), cg[i].w * (1.f + csc[i].w)); };
            a0 = mk(0); a1 = mk(1); a2 = mk(2); a3 = mk(3);
        }
        float4 h[4];
#pragma unroll
        for (int i = 0; i < 4; ++i) {
            const float4 a = i == 0 ? a0 : i == 1 ? a1 : i == 2 ? a2 : a3, bsh = i == 0 ? b0 : i == 1 ? b1 : i == 2 ? b2 : b3;
            h[i].x = v[i].x * rs * a.x + bsh.x; h[i].y = v[i].y * rs * a.y + bsh.y;
            h[i].z = v[i].z * rs * a.z + bsh.z; h[i].w = v[i].w * rs * a.w + bsh.w;
            if (mode == 2) *(float4*)(C.out() + (size_t)row * D + CB(i)) = h[i];
            else { pg8::u32x2 w; w.x = pg8::cvt_pk_bf16(h[i].x, h[i].y); w.y = pg8::cvt_pk_bf16(h[i].z, h[i].w); *(pg8::u32x2*)(C.HB() + (size_t)row * D + CB(i)) = w; }
        }
        if (route) {
            float lg[NE];
#pragma unroll
            for (int e = 0; e < NE; ++e) lg[e] = 0.f;
#pragma unroll
            for (int i = 0; i < 4; ++i) {
                const float hv[4] = {h[i].x, h[i].y, h[i].z, h[i].w};
#pragma unroll
                for (int j = 0; j < 4; ++j) {
                    const int d = CB(i) + j;
                    const float4 ra = *(const float4*)(Rl + d * 8 + (d >> 3) * 4), rb = *(const float4*)(Rl + d * 8 + (d >> 3) * 4 + 4);
                    lg[0] = fmaf(hv[j], ra.x, lg[0]); lg[1] = fmaf(hv[j], ra.y, lg[1]); lg[2] = fmaf(hv[j], ra.z, lg[2]); lg[3] = fmaf(hv[j], ra.w, lg[3]);
                    lg[4] = fmaf(hv[j], rb.x, lg[4]); lg[5] = fmaf(hv[j], rb.y, lg[5]); lg[6] = fmaf(hv[j], rb.z, lg[6]); lg[7] = fmaf(hv[j], rb.w, lg[7]);
                }
            }
#pragma unroll
            for (int e = 0; e < NE; ++e) lg[e] = wave_sum(lg[e]);
            int e0 = 0; float v0 = lg[0];
#pragma unroll
            for (int e = 1; e < NE; ++e) if (lg[e] > v0) { v0 = lg[e]; e0 = e; }
            int e1 = -1; float v1 = -3.0e38f;
#pragma unroll
            for (int e = 0; e < NE; ++e) if (e != e0 && lg[e] > v1) { v1 = lg[e]; e1 = e; }
            const float p1 = expf(v1 - v0), w0 = 1.f / (1.f + p1), w1 = p1 / (1.f + p1);
            if (lane == 0) {
                C.TOPE()[row * 2] = e0; C.TOPE()[row * 2 + 1] = e1; C.TOPW()[row * 2] = w0; C.TOPW()[row * 2 + 1] = w1;
                atomicAdd(&hist[e0], 1); atomicAdd(&hist[e1], 1);
            }
        }
    }
    if (route) { __syncthreads(); if (tidx_ < NE) C.HIST()[blockIdx.x * NE + tidx_] = hist[tidx_]; __syncthreads(); }
}

#undef CB
__device__ __forceinline__ void ph_assign(const Ctx C, int l) {
    const int tidx_ = opaque_tid();
    const int tid = tidx_, lane = tid & 63, wave = tid >> 6;
    const int nrows = (l == DEPTH - 1) ? ML : MT;
    const int rpb = nrows / gridDim.x;
    int* sh = (int*)C.lds;
    int ev[3] = {-1, -1, -1};
    if (wave == 0) {
#pragma unroll
        for (int q = 0; q < 3; ++q) { const int idx = 64 * q + lane; if (idx < 2 * rpb) ev[q] = C.TOPE()[block_row(blockIdx.x, idx >> 1, nrows) * 2 + (idx & 1)]; }
    }
    {
        const int e = wave;
        int tot = 0, base = 0;
#pragma unroll
        for (int k = 0; k < 4; ++k) { const int b = lane + 64 * k; const int hh = (b < (int)gridDim.x) ? C.HIST()[b * NE + e] : 0; tot += hh; base += (b < (int)blockIdx.x) ? hh : 0; }
#pragma unroll
        for (int o = 1; o < 64; o <<= 1) { tot += __shfl_xor(tot, o); base += __shfl_xor(base, o); }
        if (lane == 0) { sh[e] = tot; sh[8 + e] = base; }
    }
    __syncthreads();
    if (tid == 0) { int sacc = 0; for (int e = 0; e < NE; ++e) { sh[16 + e] = sacc; sacc += (sh[e] + 255) / 256 * 256; } sh[24] = sacc; }
    __syncthreads();
    if (wave == 0) {
        int cur[NE];
#pragma unroll
        for (int e = 0; e < NE; ++e) cur[e] = sh[16 + e] + sh[8 + e];
#pragma unroll
        for (int q = 0; q < 3; ++q) {
            const int cb = 64 * q; if (cb >= 2 * rpb) break;
            const int idx = cb + lane; const bool valid = idx < 2 * rpb;
            const int erow = block_row(blockIdx.x, (valid ? idx : 0) >> 1, nrows);
            const int e = ev[q];
            int slot = 0;
#pragma unroll
            for (int ex = 0; ex < NE; ++ex) {
                const unsigned long long mask = __ballot(e == ex);
                const int rank = __popcll(mask & ((1ull << lane) - 1ull));
                if (e == ex) slot = cur[ex] + rank;
                cur[ex] += __popcll(mask);
            }
            if (valid) { C.SLOT()[erow * 2 + (idx & 1)] = slot; sh[64 + idx] = slot; }
        }
    }
    __syncthreads();
    for (int idx0 = wave; idx0 < 2 * rpb; idx0 += 6 * NWAVES) {
        const int last = 2 * rpb - 1;
#define AS_IDX(q) (idx0 + (q) * NWAVES > last ? idx0 : idx0 + (q) * NWAVES)
#define AS_SRC(q) ((const uint4*)(C.HB() + (size_t)block_row(blockIdx.x, AS_IDX(q) >> 1, nrows) * D))
#define AS_DST(q) ((uint4*)(C.AS() + (size_t)sh[64 + AS_IDX(q)] * D))
        const uint4 a0 = AS_SRC(0)[lane], a1 = AS_SRC(0)[lane + 64], b0 = AS_SRC(1)[lane], b1 = AS_SRC(1)[lane + 64], c0 = AS_SRC(2)[lane], c1 = AS_SRC(2)[lane + 64];
        const uint4 d0 = AS_SRC(3)[lane], d1 = AS_SRC(3)[lane + 64], e0 = AS_SRC(4)[lane], e1 = AS_SRC(4)[lane + 64], f0 = AS_SRC(5)[lane], f1 = AS_SRC(5)[lane + 64];
        AS_DST(0)[lane] = a0; AS_DST(0)[lane + 64] = a1; AS_DST(1)[lane] = b0; AS_DST(1)[lane + 64] = b1; AS_DST(2)[lane] = c0; AS_DST(2)[lane + 64] = c1;
        AS_DST(3)[lane] = d0; AS_DST(3)[lane + 64] = d1; AS_DST(4)[lane] = e0; AS_DST(4)[lane + 64] = e1; AS_DST(5)[lane] = f0; AS_DST(5)[lane + 64] = f1;
#undef AS_IDX
#undef AS_SRC
#undef AS_DST
    }
    for (int e = 0; e < NE; ++e) {
        const int beg = sh[16 + e] + sh[e], end = sh[16 + e + 1];
        for (int sl = beg + (int)blockIdx.x + wave * (int)gridDim.x; sl < end; sl += NWAVES * (int)gridDim.x) { uint4* dst = (uint4*)(C.AS() + (size_t)sl * D); dst[lane] = make_uint4(0, 0, 0, 0); dst[lane + 64] = make_uint4(0, 0, 0, 0); }
    }
    if (blockIdx.x == 0) {
        for (int e = 0; e < NE; ++e) for (int p = sh[16 + e] / 256 + tid; p < sh[16 + e + 1] / 256; p += NTHREADS) C.PEXP()[p] = e;
        if (tid == 0) C.PEXP()[MAXSLOT / 128] = sh[24] / 256;
    }
    __syncthreads();
}

__device__ __forceinline__ void ph_inproj(const Ctx C, int l) {
    PG8_LAS unsigned char* glds = (PG8_LAS unsigned char*)(C.ldsraw() + GEMM_LDS_OFF);
    pg8::Gemm g; g.A = C.HB(); g.Bt = C.WIN() + (size_t)l * INWP * D; g.K = D; g.lda = D; g.ldb = D;
    pg8::StaticOrder S; S.init(MT, INWP, gridDim.x, blockIdx.x);
    pg8::EpiInproj E; E.ws = C.a->ws; E.rope = C.ROPE(); E.gq = C.gb_qnorm() + l * 64; E.gk = C.gb_knorm() + l * 64;
    if (l == DEPTH - 1) { pg8::InprojLastOrder S2; S2.init(gridDim.x, blockIdx.x); pg8::gemm_phase<pg8::EpiInproj, pg8::InprojLastOrder, true, true>(glds, g, S2, E); }
    else pg8::gemm_phase<pg8::EpiInproj, pg8::StaticOrder, true, true>(glds, g, S, E);
    {
        const int c = blockIdx.x, base = bg_layer_base(l);
        if (l == DEPTH - 1) { if (c >= 136) bg_run(C, base, base + 120 * 11, 11, c - 136, 120); }
        else if (c >= 8) bg_run(C, base, base + BGW_IN, 11, c - 8, 248);
    }
}
__device__ __forceinline__ void ph_mla(const Ctx C, int l) {
    PG8_LAS unsigned char* glds = (PG8_LAS unsigned char*)(C.ldsraw() + GEMM_LDS_OFF);
    pg8::Gemm g; g.A = C.DA(); g.Bt = C.WMLA() + (size_t)l * 1024 * 384; g.K = 384; g.lda = 384; g.ldb = 384;
    pg8::StaticOrder S; S.init(MT, 1024, gridDim.x, blockIdx.x);
    pg8::EpiMla E; E.ws = C.a->ws; E.rope = C.ROPE();
    pg8::gemm_phase<pg8::EpiMla, pg8::StaticOrder, true, false>(glds, g, S, E);
    if (blockIdx.x >= 32) {
        const int base = bg_layer_base(l) + (l == DEPTH - 1 ? 120 * 11 : BGW_IN);
        bg_run(C, base, (l == DEPTH - 1) ? BG_END : base + BGW_MLA, 7, blockIdx.x - 32, 224);
    }
}

__device__ __forceinline__ void ph_attn(const Ctx C, int l) {
    const int tid = opaque_tid();
    const int wave = __builtin_amdgcn_readfirstlane(tid >> 6);
    unsigned char* lds = C.ldsraw() + GEMM_LDS_OFF;
    const int u = ((int)blockIdx.x & 7) * ((int)gridDim.x >> 3) + ((int)blockIdx.x >> 3);
    const bool has_ctx = (l < DEPTH - 1) && (u < 128);
    const int cb = u >> 4, cmx = (u >> 2) & 3, ch = u & 3, ckvh = ch >> 1;
    for (int pass = 0; pass < 2; ++pass) {
        if (pass == 1 && !(has_ctx && cmx < 3)) break;
        at::Unit U{}; U.Q2 = nullptr; U.ldq2 = 0; U.K2 = nullptr; U.ldq = 256;
        if (pass == 0) {
            const int b = u >> 5, kvh = (u >> 4) & 1, tb = u & 15, hq = 2 * kvh + (wave >> 2), t0 = tb * 128 + 32 * (wave & 3);
            U.Q = C.QB() + hq * 64; U.K = C.KB() + kvh * 64; U.ldk = 128; U.VT = C.VTB() + (size_t)(kvh * 64) * MT;
            U.O = C.O() + 256 + hq * 64; U.qrow0 = b * SEQ + t0; U.nloc = 32; U.ntile = 36; U.krow_loc0 = b * SEQ; U.krow_ctx0 = ML + b * CTX;
        } else {
            U.qrow0 = ML + cb * CTX + 32 * wave; U.nloc = 0; U.ntile = 4; U.krow_loc0 = 0; U.krow_ctx0 = ML + cb * CTX; U.O = C.O() + cmx * 256 + ch * 64;
            if (cmx == 0) { U.Q = C.QA() + ch * 64; U.K = C.KA() + ch * 64; U.ldk = 256; U.VT = C.VTA() + (size_t)(ch * 64) * MT; }
            else if (cmx == 1) { U.Q = C.QB() + ch * 64; U.K = C.KB() + ckvh * 64; U.ldk = 128; U.VT = C.VTB() + (size_t)(ckvh * 64) * MT; }
            else { U.Q = C.QC() + ch * 64; U.K = C.KC() + ckvh * 64; U.ldk = 128; U.VT = C.VTC() + (size_t)(ckvh * 64) * MT; U.sink2 = C.wc_sink()[l * 4 + ch] * at::LOG2E; U.has_sink = 1; }
        }
        at::attn_plain2<64>(lds, U, tid);
    }
    for (int pass = 0; pass < 2; ++pass) {
        if (pass == 1 && !(has_ctx && cmx == 3)) break;
        at::Unit U{}; U.ldq = 256; U.ldq2 = 128; U.ldk = 256; U.K2 = C.KPE();
        if (pass == 0) {
            const int b = u >> 5, h = (u >> 3) & 3, tb = u & 7, t0 = tb * 256 + 32 * wave;
            U.Q = C.QDN() + h * 64; U.Q2 = C.QDP() + h * 32; U.K = C.KDN() + h * 64; U.VT = C.VTD() + (size_t)(h * 64) * MT;
            U.O = C.O() + 768 + h * 64; U.qrow0 = b * SEQ + t0; U.nloc = 32; U.ntile = 36; U.krow_loc0 = b * SEQ; U.krow_ctx0 = ML + b * CTX;
        } else {
            U.Q = C.QDN() + ch * 64; U.Q2 = C.QDP() + ch * 32; U.K = C.KDN() + ch * 64; U.VT = C.VTD() + (size_t)(ch * 64) * MT;
            U.O = C.O() + 768 + ch * 64; U.qrow0 = ML + cb * CTX + 32 * wave; U.nloc = 0; U.ntile = 4; U.krow_loc0 = 0; U.krow_ctx0 = ML + cb * CTX;
        }
        at::attn_plain2<96>(lds, U, tid);
    }
    {
        const int b = u >> 5, kvh = (u >> 4) & 1, tb = u & 15, hq = 2 * kvh + (wave >> 2), t0 = tb * 128 + 32 * (wave & 3);
        const int jlo = tb * 128 - 128 < 0 ? 0 : tb * 128 - 128, jhi = tb * 128 + 256 > SEQ ? SEQ : tb * 128 + 256;
        at::Unit U{}; U.Q = C.QC() + hq * 64; U.ldq = 256; U.Q2 = nullptr; U.ldq2 = 0; U.K = C.KC() + kvh * 64; U.ldk = 128; U.K2 = nullptr; U.VT = C.VTC() + (size_t)(kvh * 64) * MT;
        U.O = C.O() + 512 + hq * 64; U.qrow0 = b * SEQ + t0; U.nloc = (jhi - jlo) >> 6; U.ntile = U.nloc + 4; U.krow_loc0 = b * SEQ + jlo; U.krow_ctx0 = ML + b * CTX;
        U.t0 = t0; U.j0 = jlo; U.sink2 = C.wc_sink()[l * 4 + hq] * at::LOG2E; U.has_sink = 1;
        at::attn_unit<64, at::WINDOW>(lds, U, tid);
    }
    {
        const int b = u >> 5, h = (u >> 3) & 3, rb = u & 7, r0 = 4 * rb, rr = r0 + (wave >> 1), c0 = 32 * (wave & 1);
        int krlo = r0 - 4; krlo = krlo < 0 ? 0 : (krlo > 24 ? 24 : krlo);
        int krhi = r0 + 3 - 4; krhi = (krhi < 0 ? 0 : (krhi > 24 ? 24 : krhi)) + 8;
        float* rpb = (float*)(lds + at::RPB_OFF);
        for (int i = tid; i < 465; i += NTHREADS) rpb[i] = C.na_rpb()[(l * 4 + h) * 465 + i] * at::LOG2E;
        at::Unit U{}; U.Q = C.QA() + h * 64; U.ldq = 256; U.Q2 = nullptr; U.ldq2 = 0; U.K = C.KA() + h * 64; U.ldk = 256; U.K2 = nullptr; U.VT = C.VTA() + (size_t)(h * 64) * MT;
        U.O = C.O() + h * 64; U.qrow0 = b * SEQ + rr * 64 + c0; U.nloc = krhi - krlo; U.ntile = U.nloc + 4; U.krow_loc0 = b * SEQ + 64 * krlo; U.krow_ctx0 = ML + b * CTX;
        U.rr = rr; U.c0 = c0; U.krlo = krlo;
        at::attn_unit<64, at::NATTEN>(lds, U, tid);
    }
}

__device__ __forceinline__ void ph_branch(const Ctx C, int l) {
    PG8_LAS unsigned char* glds = (PG8_LAS unsigned char*)(C.ldsraw() + GEMM_LDS_OFF);
    pg8::Gemm g; g.A = C.O(); g.Bt = C.WBR() + (size_t)l * D * D; g.K = 256; g.lda = D; g.ldb = D;
    pg8::BranchOrder S; S.init((l == DEPTH - 1) ? ML : MT, gridDim.x, blockIdx.x);
    pg8::EpiBranch E; E.MIX = C.MIX(); E.GATE = C.GATE();
    pg8::gemm_phase<pg8::EpiBranch, pg8::BranchOrder, true, true>(glds, g, S, E);
    if (l < DEPTH - 1 && blockIdx.x >= 32) {
        const int base = bg_layer_base(l) + BGW_IN + BGW_MLA;
        bg_run(C, base, (l == 1) ? BG_J9 : base + BGW_BR, 18, blockIdx.x - 32, 224);
    }
}
__device__ __forceinline__ void ph_out(const Ctx C, int l) {
    PG8_LAS unsigned char* glds = (PG8_LAS unsigned char*)(C.ldsraw() + GEMM_LDS_OFF);
    pg8::Gemm g; g.A = C.MIX(); g.Bt = C.WOUT() + (size_t)l * D * D; g.K = D; g.lda = D; g.ldb = D;
    if (l == DEPTH - 1) {
        pg8::StaticOrder S; S.init(ML, D, gridDim.x, blockIdx.x);
        pg8::EpiResid E; E.X = C.X(); E.ldc = D; E.gate = C.MOD() + (size_t)l * 9 * ADAW + 2 * D;
        pg8::gemm_phase<pg8::EpiResid, pg8::StaticOrder, true, true>(glds, g, S, E);
    } else {
        pg8::TailOrder S; S.init(gridDim.x, blockIdx.x, 4, 256);
        pg8::EpiResidTail E; E.X = C.X(); E.gate = C.MOD() + (size_t)l * 9 * ADAW + 2 * D; E.PART = C.PART();
        pg8::gemm_phase<pg8::EpiResidTail, pg8::TailOrder, true, false>(glds, g, S, E);
    }
}

__device__ __forceinline__ void ph_up(const Ctx C, int l) {
    PG8_LAS unsigned char* glds = (PG8_LAS unsigned char*)(C.ldsraw() + GEMM_LDS_OFF);
    pg8::EpiSwiglu E; E.O = C.ACT(); E.ldc = DFF;
    if (l & 1) {
        pg8::Gemm g; g.A = C.AS(); g.Bt = C.W13M(); g.K = D; g.lda = D; g.ldb = D;
        const int np_ = __builtin_amdgcn_readfirstlane(C.PEXP()[MAXSLOT / 128]);
        {
            PG8_LAS int* pt = (PG8_LAS int*)(glds + pg8::STAGE_BYTES);
            const int t_ = opaque_tid(); if (t_ < np_) pt[t_] = C.PEXP()[t_];
            __syncthreads();
        }
        pg8::MoeOrder S; S.init(np_, 2 * DFF, gridDim.x, blockIdx.x, (const PG8_LAS int*)(glds + pg8::STAGE_BYTES));
        pg8::gemm_phase<pg8::EpiSwiglu, pg8::MoeOrder, true, true>(glds, g, S, E);
    } else {
        pg8::Gemm g; g.A = C.HB(); g.Bt = C.W13D() + (size_t)(l >> 1) * 2 * DFF * D; g.K = D; g.lda = D; g.ldb = D;
        pg8::StaticOrder S; S.init(MT, 2 * DFF, gridDim.x, blockIdx.x);
        pg8::gemm_phase<pg8::EpiSwiglu, pg8::StaticOrder, true, true>(glds, g, S, E);
    }
}

__device__ __forceinline__ void ph_down(const Ctx C, int l) {
    PG8_LAS unsigned char* glds = (PG8_LAS unsigned char*)(C.ldsraw() + GEMM_LDS_OFF);
    if (l & 1) {
        pg8::Gemm g; g.A = C.ACT(); g.Bt = C.W2M(); g.K = DFF; g.lda = DFF; g.ldb = DFF;
        const int np_ = __builtin_amdgcn_readfirstlane(C.PEXP()[MAXSLOT / 128]);
        {
            PG8_LAS int* pt = (PG8_LAS int*)(glds + pg8::STAGE_BYTES);
            const int t_ = opaque_tid(); if (t_ < np_) pt[t_] = C.PEXP()[t_];
            __syncthreads();
        }
        pg8::MoeDownOrder S; S.init(np_, gridDim.x, blockIdx.x, DFF / 2, (const PG8_LAS int*)(glds + pg8::STAGE_BYTES));
        pg8::EpiY E; E.Y = C.Y(); E.Y2 = C.Y2();
        pg8::gemm_phase<pg8::EpiY, pg8::MoeDownOrder, true, true>(glds, g, S, E);
    } else {
        pg8::Gemm g; g.A = C.ACT(); g.Bt = C.W2D() + (size_t)(l >> 1) * D * DFF; g.K = DFF; g.lda = DFF; g.ldb = DFF;
        pg8::TailOrder S; S.init(gridDim.x, blockIdx.x, 7, 512);
        pg8::EpiResidTail E; E.X = C.X(); E.gate = C.MOD() + (size_t)l * 9 * ADAW + 5 * D; E.PART = C.PART();
        pg8::gemm_phase<pg8::EpiResidTail, pg8::TailOrder, true, true>(glds, g, S, E);
    }
}

template <int KMASK>
__global__ void __launch_bounds__(NTHREADS, 2) fwd_kernel(Args args) {
    extern __shared__ __attribute__((aligned(16))) unsigned char lds_raw[];
    Ctx C; C.a = (ArgsP)__builtin_amdgcn_kernarg_segment_ptr(); C.lds = (float*)(lds_raw + 64);
    volatile LAS unsigned* stw = (volatile LAS unsigned*)(LAS unsigned char*)lds_raw;
    if (threadIdx.x < 4) stw[threadIdx.x] = 0u;
    __syncthreads();
    const int lo = args.ph_lo, hi = args.ph_hi;
    XcdBarrier bar; bar.bar = (unsigned*)(args.ws + WS_CTL); bar.x = 0; bar.st = stw;
    if (hi - lo > 1) bar = xcd_barrier_post((unsigned*)(args.ws + WS_CTL), stw);
    int ph = 0;
#ifndef ONLY
#define ONLY -1
#endif
#ifndef PHMASK
#define PHMASK 0xFFFF
#endif
#ifndef DBL_ID
#define DBL_ID -1
#endif
#define PHASE(id, body) do { if ((ONLY < 0 || ONLY == (id)) && ((PHMASK >> (id)) & 1) && ((KMASK >> (id)) & 1) && ph >= lo && ph < hi) { body; if ((id) == DBL_ID && (((id) != 1 && (id) != 10) || (l & 1))) { xcd_barrier(bar); body; } if (ph + 1 < hi) xcd_barrier(bar); } ++ph; } while (0)
    { const int l = 0; PHASE(0, ((blockIdx.x & 1) ? (conv_prologue(C), ph_prologue(C)) : (ph_prologue(C), conv_prologue(C)))); }
    for (int l = 0; l < DEPTH; ++l) {
        PHASE(1, ph_norm(C, l, 0));
        PHASE(2, ph_inproj(C, l));
        PHASE(3, ph_mla(C, l));
        PHASE(4, ph_attn(C, l));
        PHASE(5, ph_branch(C, l));
        PHASE(6, ph_out(C, l));
        PHASE(7, ph_norm(C, l, 1));
        if (l & 1) PHASE(8, ph_assign(C, l));
        PHASE(9, ph_up(C, l));
        PHASE(10, ph_down(C, l));
    }
    { const int l = 0; PHASE(11, ph_norm(C, DEPTH - 1, 2)); }
#undef PHASE
}
constexpr int N_PHASES = 1 + DEPTH * 9 + (DEPTH / 2) + 1;

extern "C" void kernel_launch(void* const* d_in, const int* in_sizes, int n_in, void* d_out, int out_size, void* d_ws, size_t ws_size, hipStream_t stream) {
    static int grid = 0;
    if (grid == 0) {
        if (n_in != 27 || out_size != ML * D || ws_size < WS_END) {
            fprintf(stderr, "kernel_launch: unexpected shapes: n_in %d out %d ws %zu (need %zu)\n", n_in, out_size, ws_size, (size_t)WS_END); grid = -1; return; }
        int dev = 0, cus = 0, per_cu = 0;
        if (hipGetDevice(&dev) != hipSuccess || hipDeviceGetAttribute(&cus, hipDeviceAttributeMultiprocessorCount, dev) != hipSuccess) { grid = -1; return; }
#if ONE_LAUNCH
        if (hipFuncSetAttribute((const void*)fwd_kernel<0xFFFF>, hipFuncAttributeMaxDynamicSharedMemorySize, LDS_BYTES) != hipSuccess) { fprintf(stderr, "kernel_launch: hipFuncSetAttribute failed\n"); grid = -1; return; }
        if (hipOccupancyMaxActiveBlocksPerMultiprocessor(&per_cu, (const void*)fwd_kernel<0xFFFF>, NTHREADS, LDS_BYTES) != hipSuccess || per_cu < 1)
            fprintf(stderr, "kernel_launch: occupancy query reports %d blocks per CU\n", per_cu);
#else
        if (hipFuncSetAttribute((const void*)fwd_kernel<0xFFEF>, hipFuncAttributeMaxDynamicSharedMemorySize, LDS_BYTES) != hipSuccess ||
            hipFuncSetAttribute((const void*)fwd_kernel<0x0010>, hipFuncAttributeMaxDynamicSharedMemorySize, LDS_BYTES) != hipSuccess) { fprintf(stderr, "kernel_launch: hipFuncSetAttribute failed\n"); grid = -1; return; }
#endif
        (void)hipGetLastError();
        grid = cus;
        if (grid != 256) fprintf(stderr, "kernel_launch: %d CUs (built for 256)\n", grid);
        if (grid > 256 || (ML % grid) || (MT % grid)) grid = 256;
    }
    if (grid < 0) return;
    (void)hipMemsetAsync((char*)d_ws + WS_CTL, 0, CTL_BYTES, stream);
#ifdef NAN_POISON
    (void)hipMemsetAsync((char*)d_ws + CTL_BYTES, 0xFF, WS_END - CTL_BYTES, stream);
#endif
    Args a{};
    for (int i = 0; i < 27; ++i) a.in[i] = (const float*)d_in[i];
    a.out = (float*)d_out; a.ws = (unsigned char*)d_ws;
#if ONE_LAUNCH
    a.ph_lo = 0; a.ph_hi = N_PHASES;
    hipLaunchKernelGGL(fwd_kernel<0xFFFF>, dim3(grid), dim3(NTHREADS), LDS_BYTES, stream, a);
#else
    {
        int p = 0;
        auto launch = [&](int id) { a.ph_lo = p; a.ph_hi = p + 1; ++p;
            if (id == 4) hipLaunchKernelGGL(fwd_kernel<0x0010>, dim3(grid), dim3(NTHREADS), LDS_BYTES, stream, a);
            else hipLaunchKernelGGL(fwd_kernel<0xFFEF>, dim3(grid), dim3(NTHREADS), LDS_BYTES, stream, a); };
        launch(0);
        for (int l = 0; l < DEPTH; ++l) { for (int id = 1; id <= 7; ++id) launch(id); if (l & 1) launch(8); launch(9); launch(10); }
        launch(11);
    }
#endif
}
```

```cpp
#include <hip/hip_runtime.h>
#include <cstdio>
#include <cstdint>

#ifndef ONE_LAUNCH
#define ONE_LAUNCH 1
#endif

constexpr int D = 1024, BATCH = 8, SEQ = 2048, DEPTH = 4, CTX = 256, GW = 64;
constexpr int ML = BATCH * SEQ, MC = BATCH * CTX, MT = ML + MC;
constexpr int INW = 6304, DFF = 3584, NE = 8, ADAW = 6144;
constexpr int P_AQ = 0, P_AK = 256, P_AV = 512, P_BQ = 768, P_BK = 1024, P_BV = 1152, P_CQ = 1280, P_CK = 1536, P_CV = 1664,
              P_DQA = 1792, P_DKVA = 2048, P_GATE = 2208;
constexpr float EPS = 1e-6f;
constexpr int NTHREADS = 512, NWAVES = 8;
constexpr int MAXSLOT = 2 * MT + NE * 256;
constexpr int LDS_BYTES = 144 * 1024;

constexpr size_t al256(size_t x) { return (x + 255) & ~(size_t)255; }
constexpr size_t WS_CTL = 0;
constexpr size_t CTL_BYTES = 64 * 1024;
constexpr size_t WS_MOD = WS_CTL + CTL_BYTES;
constexpr size_t WS_ROPE = WS_MOD + al256((size_t)DEPTH * 9 * ADAW * 4);
constexpr size_t WS_HIST = WS_ROPE + al256((size_t)SEQ * 96 * 4);
constexpr size_t WS_TOPE = WS_HIST + al256(256 * 8 * 4);
constexpr size_t WS_TOPW = WS_TOPE + al256((size_t)MT * 2 * 4);
constexpr size_t WS_SLOT = WS_TOPW + al256((size_t)MT * 2 * 4);
constexpr size_t WS_ROWOF = WS_SLOT + al256((size_t)MT * 2 * 4);
constexpr size_t WS_PEXP = WS_ROWOF + al256((size_t)MAXSLOT * 4);
constexpr size_t WS_X = WS_PEXP + al256((size_t)(MAXSLOT / 128 + 64) * 4);
constexpr size_t WS_HB = WS_X + (size_t)MT * D * 4;
constexpr int INWP = 6400;
constexpr size_t WS_WIN = WS_HB + (size_t)MT * D * 2;
constexpr size_t WS_WMLA = WS_WIN + (size_t)DEPTH * INWP * D * 2;
constexpr size_t WS_WBR = WS_WMLA + (size_t)DEPTH * 1024 * 384 * 2;
constexpr size_t WS_WOUT = WS_WBR + (size_t)DEPTH * D * D * 2;
constexpr size_t WS_W13D = WS_WOUT + (size_t)DEPTH * D * D * 2;
constexpr size_t WS_W2D = WS_W13D + (size_t)2 * 2 * DFF * D * 2;
constexpr size_t WS_W13M = WS_W2D + (size_t)2 * D * DFF * 2;
constexpr size_t WS_W2M = WS_W13M + (size_t)NE * 2 * DFF * D * 2;
constexpr size_t WS_BIG = WS_W2M + (size_t)NE * D * DFF * 2;
constexpr size_t WS_QA = WS_BIG;
constexpr size_t WS_KA = WS_QA + (size_t)MT * 256 * 2;
constexpr size_t WS_VTA = WS_KA + (size_t)MT * 256 * 2;
constexpr size_t WS_QB = WS_VTA + (size_t)MT * 256 * 2;
constexpr size_t WS_KB = WS_QB + (size_t)MT * 256 * 2;
constexpr size_t WS_VTB = WS_KB + (size_t)MT * 128 * 2;
constexpr size_t WS_QC = WS_VTB + (size_t)MT * 128 * 2;
constexpr size_t WS_KC = WS_QC + (size_t)MT * 256 * 2;
constexpr size_t WS_VTC = WS_KC + (size_t)MT * 128 * 2;
constexpr size_t WS_QDN = WS_VTC + (size_t)MT * 128 * 2;
constexpr size_t WS_QDP = WS_QDN + (size_t)MT * 256 * 2;
constexpr size_t WS_KDN = WS_QDP + (size_t)MT * 128 * 2;
constexpr size_t WS_KPE = WS_KDN + (size_t)MT * 256 * 2;
constexpr size_t WS_VTD = WS_KPE + (size_t)MT * 32 * 2;
constexpr size_t WS_DA = WS_VTD + (size_t)MT * 256 * 2;
constexpr size_t WS_RSQ = WS_DA + (size_t)MT * 384 * 2;
constexpr size_t WS_RSKV = WS_RSQ + (size_t)MT * 4 * 4;
constexpr size_t WS_GATE = WS_RSKV + (size_t)MT * 4 * 4;
constexpr size_t WS_O = WS_GATE + (size_t)MT * 4096 * 2;
constexpr size_t WS_MIX = WS_O + (size_t)MT * D * 2;
constexpr size_t WS_END_A = WS_MIX + (size_t)MT * D * 2;
constexpr size_t WS_AS = WS_BIG;
constexpr size_t WS_ACT = WS_AS + (size_t)MAXSLOT * D * 2;
constexpr size_t WS_Y = WS_ACT + (size_t)MAXSLOT * DFF * 2;
constexpr int YSPLIT_P0 = 128;
constexpr size_t WS_Y2 = WS_Y + (size_t)MAXSLOT * D * 2;
constexpr size_t WS_END_F = WS_Y2 + (size_t)(MAXSLOT / 256 - YSPLIT_P0) * 256 * D * 2;
constexpr size_t WS_END = WS_END_A > WS_END_F ? WS_END_A : WS_END_F;
constexpr int GEMM_LDS_OFF = 1024;

#define XB_TMO      128
#define XB_XCNT(j)  (256  + 64 * (j))
#define XB_XSUB(j)  (1280 + 64 * (j))
#define XB_XGEN(j)  (2304 + 64 * (j))
#define XB_TOP      3328
#define XB_TOPGEN   3392
#define XCD_BAR_WORDS 3456
#define XB_SPIN_CAP (1u << 25)
#define LAS __attribute__((address_space(3)))

__device__ __forceinline__ unsigned xb_ld(unsigned* p)              { return __hip_atomic_load(p, __ATOMIC_RELAXED, __HIP_MEMORY_SCOPE_AGENT); }
__device__ __forceinline__ unsigned xb_add(unsigned* p, unsigned v) { return __hip_atomic_fetch_add(p, v, __ATOMIC_RELAXED, __HIP_MEMORY_SCOPE_AGENT); }
__device__ __forceinline__ unsigned xb_xcc_id() { return (unsigned)__builtin_amdgcn_s_getreg((3 << 11) | 20) & 0xFu; }
#define XB_SPIN(cond, bar) do { unsigned _sp = 0; while (cond) { __builtin_amdgcn_s_sleep(1); \
    if ((++_sp & 255u) == 0u) { if (xb_ld(&(bar)[XB_TMO])) break; if (_sp > XB_SPIN_CAP) { atomicAdd(&(bar)[XB_TMO], 1u); break; } } } } while (0)

struct XcdBarrier { unsigned* bar; unsigned x; volatile LAS unsigned* st; };

__device__ __forceinline__ XcdBarrier xcd_barrier_post(unsigned* bar, volatile LAS unsigned* st) {
    XcdBarrier b; b.bar = bar; b.x = xb_xcc_id(); b.st = st;
    if (threadIdx.x == 0) (void)xb_add(&bar[XB_XCNT(b.x)], 1u);
    return b;
}
__device__ __forceinline__ void xcd_barrier_complete(unsigned* bar, unsigned x, unsigned& nloc, unsigned& nx) {
    const unsigned G = gridDim.x * gridDim.y * gridDim.z;
    unsigned sum, cnt, mine, sp = 0u;
    for (;;) {
        sum = 0u; cnt = 0u; mine = 0u;
#pragma unroll
        for (unsigned j = 0; j < 16; ++j) { const unsigned c = xb_ld(&bar[XB_XCNT(j)]); sum += c; cnt += (c > 0u) ? 1u : 0u; mine = (j == x) ? c : mine; }
        if (sum == G) break;
        __builtin_amdgcn_s_sleep(1);
        if ((++sp & 255u) == 0u) { if (xb_ld(&bar[XB_TMO])) break; if (sp > XB_SPIN_CAP) { atomicAdd(&bar[XB_TMO], 1u); break; } }
    }
    nloc = mine > 0u ? mine : 1u; nx = cnt > 0u ? cnt : 1u;
}
__device__ __forceinline__ void xcd_barrier(const XcdBarrier& b) {
    asm volatile("s_waitcnt vmcnt(0)" ::: "memory");
    __syncthreads();
    if (threadIdx.x == 0) {
        unsigned* bar = b.bar;
        __builtin_amdgcn_s_waitcnt(0);
        unsigned nloc = b.st[0], nx = b.st[1];
        if (nloc == 0u) { xcd_barrier_complete(bar, b.x, nloc, nx); b.st[0] = nloc; b.st[1] = nx; }
        const unsigned old = xb_add(&bar[XB_XSUB(b.x)], 1u);
        const unsigned gen = old / nloc;
        if (old + 1u == (gen + 1u) * nloc) {
            __builtin_amdgcn_fence(__ATOMIC_RELEASE, "agent");
            asm volatile("s_waitcnt vmcnt(0)" ::: "memory");
            const unsigned og = xb_add(&bar[XB_TOP], 1u);
            const unsigned tg = og / nx;
            if (og + 1u == (tg + 1u) * nx) xb_add(&bar[XB_TOPGEN], 1u);
            else XB_SPIN(xb_ld(&bar[XB_TOPGEN]) == tg, bar);
            __builtin_amdgcn_fence(__ATOMIC_ACQUIRE, "agent");
            xb_add(&bar[XB_XGEN(b.x)], 1u);
            asm volatile("s_waitcnt vmcnt(0)" ::: "memory");
        } else {
            XB_SPIN(xb_ld(&bar[XB_XGEN(b.x)]) == gen, bar);
            __builtin_amdgcn_fence(__ATOMIC_ACQUIRE, "agent");
            asm volatile("s_waitcnt vmcnt(0)" ::: "memory");
        }
    }
    __syncthreads();
}

__device__ __forceinline__ float wave_sum(float v) {
#pragma unroll
    for (int o = 1; o < 64; o <<= 1) v += __shfl_xor(v, o);
    return v;
}
__device__ __forceinline__ float wave_max(float v) {
#pragma unroll
    for (int o = 1; o < 64; o <<= 1) v = fmaxf(v, __shfl_xor(v, o));
    return v;
}
__device__ __forceinline__ int opaque_tid() { int t = threadIdx.x; asm volatile("" : "+v"(t)); return t; }
__device__ __forceinline__ float siluf(float v) { return v / (1.f + expf(-v)); }
__device__ __forceinline__ float sigmoidf(float v) { return 1.f / (1.f + expf(-v)); }
__device__ __forceinline__ int modrow(int m) { return m < ML ? (m >> 11) : 8; }

struct Args { const float* in[27]; float* out; unsigned char* ws; int ph_lo, ph_hi; };

typedef const __attribute__((address_space(4))) Args* ArgsP;
struct Ctx {
    ArgsP a; float* lds;
    __device__ __forceinline__ const float* x() const { return a->in[0]; }
    __device__ __forceinline__ const float* c() const { return a->in[1]; }
    __device__ __forceinline__ const float* ctx() const { return a->in[2]; }
    __device__ __forceinline__ const float* c_ctx() const { return a->in[3]; }
    __device__ __forceinline__ const float* norm1_g() const { return a->in[4]; }
    __device__ __forceinline__ const float* norm2_g() const { return a->in[5]; }
    __device__ __forceinline__ const float* w_ada() const { return a->in[6]; }
    __device__ __forceinline__ const float* b_ada() const { return a->in[7]; }
    __device__ __forceinline__ const float* w_in() const { return a->in[8]; }
    __device__ __forceinline__ const float* na_rpb() const { return a->in[9]; }
    __device__ __forceinline__ const float* gb_qnorm() const { return a->in[10]; }
    __device__ __forceinline__ const float* gb_knorm() const { return a->in[11]; }
    __device__ __forceinline__ const float* wc_sink() const { return a->in[12]; }
    __device__ __forceinline__ const float* mla_qnorm() const { return a->in[13]; }
    __device__ __forceinline__ const float* mla_kvnorm() const { return a->in[14]; }
    __device__ __forceinline__ const float* mla_wqb() const { return a->in[15]; }
    __device__ __forceinline__ const float* mla_wkvb() const { return a->in[16]; }
    __device__ __forceinline__ const float* w_branch() const { return a->in[17]; }
    __device__ __forceinline__ const float* w_out() const { return a->in[18]; }
    __device__ __forceinline__ const float* ffn_w1() const { return a->in[19]; }
    __device__ __forceinline__ const float* ffn_w3() const { return a->in[20]; }
    __device__ __forceinline__ const float* ffn_w2() const { return a->in[21]; }
    __device__ __forceinline__ const float* moe_router() const { return a->in[22]; }
    __device__ __forceinline__ const float* moe_w1() const { return a->in[23]; }
    __device__ __forceinline__ const float* moe_w3() const { return a->in[24]; }
    __device__ __forceinline__ const float* moe_w2() const { return a->in[25]; }
    __device__ __forceinline__ const float* final_g() const { return a->in[26]; }
    __device__ __forceinline__ float* out() const { return a->out; }
    __device__ __forceinline__ float* MOD() const { return (float*)(a->ws + WS_MOD); }
    __device__ __forceinline__ float* ROPE() const { return (float*)(a->ws + WS_ROPE); }
    __device__ __forceinline__ unsigned short* X() const { return (unsigned short*)(a->ws + WS_X); }
    __device__ __forceinline__ float* TOPW() const { return (float*)(a->ws + WS_TOPW); }
    __device__ __forceinline__ unsigned short* ACT() const { return (unsigned short*)(a->ws + WS_ACT); }
    __device__ __forceinline__ unsigned short* Y() const { return (unsigned short*)(a->ws + WS_Y); }
    __device__ __forceinline__ unsigned short* Y2() const { return (unsigned short*)(a->ws + WS_Y2); }
    __device__ __forceinline__ unsigned short* HB() const { return (unsigned short*)(a->ws + WS_HB); }
    __device__ __forceinline__ unsigned short* AS() const { return (unsigned short*)(a->ws + WS_AS); }
    __device__ __forceinline__ unsigned short* W13D() const { return (unsigned short*)(a->ws + WS_W13D); }
    __device__ __forceinline__ unsigned short* W2D() const { return (unsigned short*)(a->ws + WS_W2D); }
    __device__ __forceinline__ unsigned short* W13M() const { return (unsigned short*)(a->ws + WS_W13M); }
    __device__ __forceinline__ unsigned short* W2M() const { return (unsigned short*)(a->ws + WS_W2M); }
    __device__ __forceinline__ unsigned short* QA() const { return (unsigned short*)(a->ws + WS_QA); }
    __device__ __forceinline__ unsigned short* KA() const { return (unsigned short*)(a->ws + WS_KA); }
    __device__ __forceinline__ unsigned short* VTA() const { return (unsigned short*)(a->ws + WS_VTA); }
    __device__ __forceinline__ unsigned short* QB() const { return (unsigned short*)(a->ws + WS_QB); }
    __device__ __forceinline__ unsigned short* KB() const { return (unsigned short*)(a->ws + WS_KB); }
    __device__ __forceinline__ unsigned short* VTB() const { return (unsigned short*)(a->ws + WS_VTB); }
    __device__ __forceinline__ unsigned short* QC() const { return (unsigned short*)(a->ws + WS_QC); }
    __device__ __forceinline__ unsigned short* KC() const { return (unsigned short*)(a->ws + WS_KC); }
    __device__ __forceinline__ unsigned short* VTC() const { return (unsigned short*)(a->ws + WS_VTC); }
    __device__ __forceinline__ unsigned short* QDN() const { return (unsigned short*)(a->ws + WS_QDN); }
    __device__ __forceinline__ unsigned short* QDP() const { return (unsigned short*)(a->ws + WS_QDP); }
    __device__ __forceinline__ unsigned short* KDN() const { return (unsigned short*)(a->ws + WS_KDN); }
    __device__ __forceinline__ unsigned short* KPE() const { return (unsigned short*)(a->ws + WS_KPE); }
    __device__ __forceinline__ unsigned short* VTD() const { return (unsigned short*)(a->ws + WS_VTD); }
    __device__ __forceinline__ unsigned short* DA() const { return (unsigned short*)(a->ws + WS_DA); }
    __device__ __forceinline__ unsigned short* GATE() const { return (unsigned short*)(a->ws + WS_GATE); }
    __device__ __forceinline__ unsigned short* O() const { return (unsigned short*)(a->ws + WS_O); }
    __device__ __forceinline__ unsigned short* MIX() const { return (unsigned short*)(a->ws + WS_MIX); }
    __device__ __forceinline__ unsigned short* WIN() const { return (unsigned short*)(a->ws + WS_WIN); }
    __device__ __forceinline__ unsigned short* WMLA() const { return (unsigned short*)(a->ws + WS_WMLA); }
    __device__ __forceinline__ unsigned short* WBR() const { return (unsigned short*)(a->ws + WS_WBR); }
    __device__ __forceinline__ unsigned short* WOUT() const { return (unsigned short*)(a->ws + WS_WOUT); }
    __device__ __forceinline__ float* RSQ() const { return (float*)(a->ws + WS_RSQ); }
    __device__ __forceinline__ float* RSKV() const { return (float*)(a->ws + WS_RSKV); }
    __device__ __forceinline__ unsigned short* PART() const { return (unsigned short*)(a->ws + WS_Y); }
    __device__ __forceinline__ unsigned char* ldsraw() const { return (unsigned char*)lds - 64; }
    __device__ __forceinline__ int* HIST() const { return (int*)(a->ws + WS_HIST); }
    __device__ __forceinline__ int* TOPE() const { return (int*)(a->ws + WS_TOPE); }
    __device__ __forceinline__ int* SLOT() const { return (int*)(a->ws + WS_SLOT); }
    __device__ __forceinline__ int* ROWOF() const { return (int*)(a->ws + WS_ROWOF); }
    __device__ __forceinline__ int* PEXP() const { return (int*)(a->ws + WS_PEXP); }
};

namespace pg8 {
#define PG8_LAS __attribute__((address_space(3)))
typedef unsigned short bf16_t;
typedef short bf16x8 __attribute__((ext_vector_type(8)));
typedef float f32x4 __attribute__((ext_vector_type(4)));
typedef unsigned u32x4 __attribute__((ext_vector_type(4)));
typedef unsigned u32x2 __attribute__((ext_vector_type(2)));
constexpr int BM = 256, BK = 64, HALF = 128, HTB = HALF * BK * 2, STAGE_BYTES = 8 * HTB, NXCD = 8, WGM = 4;
__host__ __device__ __forceinline__ int lds_byte(int r, int c) { const int st = (r >> 4) * 2 + (c >> 5), rr = r & 15, cc = c & 31, ob = rr * 64 + cc * 2; return st * 1024 + (ob ^ (((ob >> 9) & 1) << 5)); }
__host__ __device__ __forceinline__ void stage_rc(int b, int& R, int& C) { const int st = b / 1024, sb = b % 1024, swz = sb ^ (((sb >> 9) & 1) << 5); R = (st >> 1) * 16 + swz / 64; C = (st & 1) * 32 + (swz % 64) / 2; }
__host__ __device__ __forceinline__ int perm32(int rho) { const int n = rho >> 4, i = rho & 15; return 8 * (i >> 2) + 4 * n + (i & 3); }
struct Unit { int pm, pn, pc, koff, seg, nt; };
struct Gemm { const bf16_t* A; const bf16_t* Bt; int K, lda, ldb; };
struct StaticOrder {
    int nM, nN, nwg, G, c;
    __host__ __device__ void init(int M, int N, int G_, int c_) { nM = M / BM; nN = N / BM; nwg = nM * nN; G = G_; c = c_; }
    __host__ __device__ bool next(int i, Unit& u) const {
        const long L = (long)i * G + c; if (L >= nwg) return false;
        int wgid = (int)L; { const int q = nwg / NXCD, r = nwg % NXCD, xcd = wgid % NXCD, off = wgid / NXCD; wgid = (xcd < r ? xcd * (q + 1) : r * (q + 1) + (xcd - r) * q) + off; }
        const int nig = WGM * nN, gid = wgid / nig, fm = gid * WGM, gsz = (nM - fm) < WGM ? (nM - fm) : WGM;
        u.pm = fm + ((wgid % nig) % gsz); u.pn = (wgid % nig) / gsz; u.pc = u.pn; u.koff = 0; u.seg = 0; u.nt = 0; return true;
    }
    __device__ __forceinline__ void a_ready(const Unit&) const {}
    __device__ __forceinline__ void done(const Unit&) const {}
};
struct MoeOrder {
    int nM, nN, nwg, G, c; const PG8_LAS int* pexp;
    __device__ void init(int nP, int N, int G_, int c_, const PG8_LAS int* pexp_) { nM = nP; nN = N / BM; nwg = nM * nN; G = G_; c = c_; pexp = pexp_; }
    __device__ bool next(int i, Unit& u) const {
        const long L = (long)i * G + c; if (L >= nwg) return false;
        int wgid = (int)L; { const int q = nwg / NXCD, r = nwg % NXCD, xcd = wgid % NXCD, off = wgid / NXCD; wgid = (xcd < r ? xcd * (q + 1) : r * (q + 1) + (xcd - r) * q) + off; }
        const int nig = WGM * nN, gid = wgid / nig, fm = gid * WGM, gsz = (nM - fm) < WGM ? (nM - fm) : WGM;
        u.pm = fm + ((wgid % nig) % gsz); u.pc = (wgid % nig) / gsz; u.pn = pexp[u.pm] * nN + u.pc; u.koff = 0; u.seg = 0; u.nt = 0; return true;
    }
    __device__ __forceinline__ void a_ready(const Unit&) const {}
    __device__ __forceinline__ void done(const Unit&) const {}
};
typedef __bf16 bf16x2_t __attribute__((ext_vector_type(2)));
typedef float f32x2_t __attribute__((ext_vector_type(2)));
__device__ __forceinline__ unsigned cvt_pk_bf16(float lo, float hi) { f32x2_t f = {lo, hi}; bf16x2_t r = __builtin_convertvector(f, bf16x2_t); return __builtin_bit_cast(unsigned, r); }
__device__ __forceinline__ float silu_fast(float v) { return v * __builtin_amdgcn_rcpf(1.f + __builtin_amdgcn_exp2f(-1.4426950408889634f * v)); }
struct EpiSwiglu {
    static constexpr bool PERM = true, AFTER_DRAIN = false, KEEP = false;
    bf16_t* O; int ldc;
    __device__ __forceinline__ void operator()(const f32x4 (&acc)[2][2][4][2], const Unit& u, int wr, int wc, int fr, int fq) const {
        const int row0 = u.pm * BM + wr * 64 + fr, col0 = u.pc * 128 + wc * 32 + 8 * fq;
#pragma unroll
        for (int ai = 0; ai < 2; ++ai)
#pragma unroll
            for (int m = 0; m < 4; ++m) {
                bf16_t* rowp = O + (size_t)(row0 + ai * HALF + m * 16) * ldc + col0;
                float v[8];
#pragma unroll
                for (int n = 0; n < 2; ++n)
#pragma unroll
                    for (int j = 0; j < 4; ++j) v[n * 4 + j] = silu_fast(acc[ai][0][m][n][j]) * acc[ai][1][m][n][j];
                u32x4 w; w.x = cvt_pk_bf16(v[0], v[1]); w.y = cvt_pk_bf16(v[2], v[3]); w.z = cvt_pk_bf16(v[4], v[5]); w.w = cvt_pk_bf16(v[6], v[7]);
                *(u32x4*)rowp = w;
            }
    }
};
__device__ __forceinline__ f32x4 bf_lo4(unsigned a, unsigned b) { return (f32x4){__uint_as_float(a << 16), __uint_as_float(a & 0xffff0000u), __uint_as_float(b << 16), __uint_as_float(b & 0xffff0000u)}; }
__device__ __forceinline__ void resid_tile(const f32x4 (&acc)[2][2][4][2], bf16_t* X, unsigned ldx, const float* gate, int row0, int col0) {
    const float* g = gate + (unsigned)modrow(row0) * ADAW + col0;
    f32x4 gg[2][2];
#pragma unroll
    for (int bj = 0; bj < 2; ++bj) { gg[bj][0] = *(const f32x4*)(g + bj * HALF); gg[bj][1] = *(const f32x4*)(g + bj * HALF + 4); }
#pragma unroll
    for (int ai = 0; ai < 2; ++ai) {
        u32x4 xw[4][2];
        asm volatile("" ::: "memory");
#pragma unroll
        for (int m = 0; m < 4; ++m)
#pragma unroll
            for (int bj = 0; bj < 2; ++bj) xw[m][bj] = *(const u32x4*)(X + (unsigned)(row0 + ai * HALF + m * 16) * ldx + col0 + bj * HALF);
        asm volatile("" ::: "memory");
#pragma unroll
        for (int m = 0; m < 4; ++m)
#pragma unroll
            for (int bj = 0; bj < 2; ++bj) {
                const f32x4 r0 = bf_lo4(xw[m][bj].x, xw[m][bj].y) + gg[bj][0] * acc[ai][bj][m][0], r1 = bf_lo4(xw[m][bj].z, xw[m][bj].w) + gg[bj][1] * acc[ai][bj][m][1];
                u32x4 w; w.x = cvt_pk_bf16(r0[0], r0[1]); w.y = cvt_pk_bf16(r0[2], r0[3]); w.z = cvt_pk_bf16(r1[0], r1[1]); w.w = cvt_pk_bf16(r1[2], r1[3]);
                *(u32x4*)(X + (unsigned)(row0 + ai * HALF + m * 16) * ldx + col0 + bj * HALF) = w;
            }
    }
}
struct EpiResid {
    static constexpr bool PERM = true, AFTER_DRAIN = false, KEEP = false;
    bf16_t* X; int ldc; const float* gate;
    __device__ __forceinline__ void operator()(const f32x4 (&acc)[2][2][4][2], const Unit& u, int wr, int wc, int fr, int fq) const {
        resid_tile(acc, X, (unsigned)ldc, gate, u.pm * BM + wr * 64 + fr, u.pc * BM + wc * 32 + 8 * fq);
    }
};
struct EpiBf16Plain {
    static constexpr bool PERM = true, AFTER_DRAIN = false, KEEP = false;
    bf16_t* O; int ldc;
    __device__ __forceinline__ void operator()(const f32x4 (&acc)[2][2][4][2], const Unit& u, int wr, int wc, int fr, int fq) const {
        const int row0 = u.pm * BM + wr * 64 + fr, col0 = u.pc * BM + wc * 32 + 8 * fq;
#pragma unroll
        for (int ai = 0; ai < 2; ++ai)
#pragma unroll
            for (int m = 0; m < 4; ++m) {
                bf16_t* rowp = O + (size_t)(row0 + ai * HALF + m * 16) * ldc + col0;
#pragma unroll
                for (int bj = 0; bj < 2; ++bj) {
                    const f32x4 v0 = acc[ai][bj][m][0], v1 = acc[ai][bj][m][1];
                    u32x4 w; w.x = cvt_pk_bf16(v0[0], v0[1]); w.y = cvt_pk_bf16(v0[2], v0[3]); w.z = cvt_pk_bf16(v1[0], v1[1]); w.w = cvt_pk_bf16(v1[2], v1[3]);
                    *(u32x4*)(rowp + bj * HALF) = w;
                }
            }
    }
};
constexpr float C2A = 0.125f * 1.4426950408889634f;
constexpr float C2D = 0.10206207261596577f * 1.4426950408889634f;
__device__ __forceinline__ void st_bf16x8(bf16_t* p, const float (&v)[8]) {
    u32x4 w; w.x = cvt_pk_bf16(v[0], v[1]); w.y = cvt_pk_bf16(v[2], v[3]); w.z = cvt_pk_bf16(v[4], v[5]); w.w = cvt_pk_bf16(v[6], v[7]); *(u32x4*)p = w;
}
__device__ __forceinline__ void st_bf16x4(bf16_t* p, float a, float b, float c, float d) { u32x2 w; w.x = cvt_pk_bf16(a, b); w.y = cvt_pk_bf16(c, d); *(u32x2*)p = w; }
__device__ __forceinline__ bf16_t f2bf(float f) { return (bf16_t)(cvt_pk_bf16(f, 0.f) & 0xffffu); }

struct EpiInproj {
    static constexpr bool PERM = true, AFTER_DRAIN = false, KEEP = false;
    unsigned char* ws; const float *rope, *gq, *gk;
    __device__ __forceinline__ void operator()(const f32x4 (&acc)[2][2][4][2], const Unit& u, int wr, int wc, int fr_, int fq_) const {
        int fr = fr_, fq = fq_; asm volatile("" : "+v"(fr), "+v"(fq));
        bf16_t* const QA = (bf16_t*)(ws + WS_QA); bf16_t* const KA = (bf16_t*)(ws + WS_KA); bf16_t* const VTA = (bf16_t*)(ws + WS_VTA); bf16_t* const QB = (bf16_t*)(ws + WS_QB);
        bf16_t* const KB = (bf16_t*)(ws + WS_KB); bf16_t* const VTB = (bf16_t*)(ws + WS_VTB); bf16_t* const QC = (bf16_t*)(ws + WS_QC); bf16_t* const KC = (bf16_t*)(ws + WS_KC);
        bf16_t* const VTC = (bf16_t*)(ws + WS_VTC); bf16_t* const DA = (bf16_t*)(ws + WS_DA); bf16_t* const KPE = (bf16_t*)(ws + WS_KPE); bf16_t* const GATE = (bf16_t*)(ws + WS_GATE);
        float* const RSQ = (float*)(ws + WS_RSQ); float* const RSKV = (float*)(ws + WS_RSKV);
        const int pc = u.pc, row0 = u.pm * BM + wr * 64 + fr;
        const bool lat = u.pm < ML / BM;
        if (pc >= 9) {
#pragma unroll
            for (int ai = 0; ai < 2; ++ai)
#pragma unroll
                for (int m = 0; m < 4; ++m) {
                    unsigned char* rowp = (unsigned char*)GATE + (unsigned)(row0 + ai * HALF + m * 16) * 4096 + (pc - 9) * 256 + wc * 32 + 8 * fq;
#pragma unroll
                    for (int bj = 0; bj < 2; ++bj) {
                        u32x2 w = {0u, 0u};
#pragma unroll
                        for (int n = 0; n < 2; ++n)
#pragma unroll
                            for (int j = 0; j < 4; ++j) {
                                const float gte = __builtin_amdgcn_rcpf(1.f + __builtin_amdgcn_exp2f(-1.4426950408889634f * acc[ai][bj][m][n][j]));
                                w[n] = __builtin_amdgcn_cvt_pk_u8_f32(fmaf(gte, 256.f, -0.5f), j, w[n]);
                            }
                        *(u32x2*)(rowp + bj * HALF) = w;
                    }
                }
        } else if (pc == 7) {
#pragma unroll
            for (int ai = 0; ai < 2; ++ai)
#pragma unroll
                for (int m = 0; m < 4; ++m) {
                    const int row = row0 + ai * HALF + m * 16;
                    float ss = 0.f;
#pragma unroll
                    for (int bj = 0; bj < 2; ++bj) {
                        float v[8];
#pragma unroll
                        for (int n = 0; n < 2; ++n)
#pragma unroll
                            for (int j = 0; j < 4; ++j) { v[n * 4 + j] = acc[ai][bj][m][n][j]; ss += v[n * 4 + j] * v[n * 4 + j]; }
                        st_bf16x8(DA + (unsigned)row * 384 + bj * HALF + wc * 32 + 8 * fq, v);
                    }
                    ss += __shfl_xor(ss, 16); ss += __shfl_xor(ss, 32);
                    if (fq == 0) RSQ[row * 4 + wc] = ss;
                }
        } else if (pc == 8) {
            const float* cr = rope + SEQ * 64; const float* sr = cr + SEQ * 16;
            const bool rope8 = (wc == 0) && lat;
            f32x4 rc = {1.f, 1.f, 1.f, 1.f}, rsn = {0.f, 0.f, 0.f, 0.f}, rcn = rc, rsnn = rsn;
            if (rope8) { const int t0 = row0 & (SEQ - 1); rc = *(const f32x4*)(cr + t0 * 16 + 4 * fq); rsn = *(const f32x4*)(sr + t0 * 16 + 4 * fq); }
#pragma unroll
            for (int ai = 0; ai < 2; ++ai)
#pragma unroll
                for (int m = 0; m < 4; ++m) {
                    const int row = row0 + ai * HALF + m * 16;
                    if (rope8 && (ai * 4 + m) < 7) { const int k1 = ai * 4 + m + 1, tn = (row0 + (k1 >> 2) * HALF + (k1 & 3) * 16) & (SEQ - 1); rcn = *(const f32x4*)(cr + tn * 16 + 4 * fq); rsnn = *(const f32x4*)(sr + tn * 16 + 4 * fq); }
                    float ss = 0.f, v[8];
#pragma unroll
                    for (int n = 0; n < 2; ++n)
#pragma unroll
                        for (int j = 0; j < 4; ++j) { v[n * 4 + j] = acc[ai][0][m][n][j]; ss += v[n * 4 + j] * v[n * 4 + j]; }
                    st_bf16x8(DA + (unsigned)row * 384 + 256 + wc * 32 + 8 * fq, v);
                    ss += __shfl_xor(ss, 16); ss += __shfl_xor(ss, 32);
                    if (fq == 0) RSKV[row * 4 + wc] = ss;
                    if (wc == 0) {
                        f32x4 x1 = acc[ai][1][m][0], x2 = acc[ai][1][m][1];
                        if (lat) { const f32x4 o1 = x1 * rc - x2 * rsn, o2 = x1 * rsn + x2 * rc; x1 = o1; x2 = o2; }
                        st_bf16x4(KPE + (unsigned)row * 32 + 4 * fq, x1[0], x1[1], x1[2], x1[3]);
                        st_bf16x4(KPE + (unsigned)row * 32 + 16 + 4 * fq, x2[0], x2[1], x2[2], x2[3]);
                    }
                    rc = rcn; rsn = rsnn;
                }
        } else {
            const bool do_norm = (pc == 3) || (pc == 5 && wc < 2);
            const bool do_rope = (pc == 3 || pc == 4 || pc == 5) && lat;
            const float qs = (pc == 0 || pc == 3 || pc == 4) ? C2A : 1.f;
            const float* g = (pc == 3) ? gq : gk;
            const float* ch = rope; const float* sh = rope + SEQ * 32;
            unsigned dofs = 0, ld = 256; bool tr = false;
            if (pc == 0) dofs = (unsigned)(WS_QA / 2); else if (pc == 1) dofs = (unsigned)(WS_KA / 2); else if (pc == 3) dofs = (unsigned)(WS_QB / 2); else if (pc == 4) dofs = (unsigned)(WS_QC / 2);
            else if (pc == 5) { dofs = (unsigned)((wc < 2 ? WS_KB : WS_KC) / 2); ld = 128; }
            else if (pc == 2) { dofs = (unsigned)(WS_VTA / 2) + 64u * wc * MT; tr = true; }
            else { dofs = (unsigned)((wc < 2 ? WS_VTB : WS_VTC) / 2) + 64u * (wc & 1) * MT; tr = true; }
            if (!tr) dofs += (pc == 5 ? 64u * (wc & 1) : 64u * wc);
            bf16_t* const wsb = (bf16_t*)ws;
            f32x4 gA[2], gB[2];
#pragma unroll
            for (int n = 0; n < 2; ++n) { gA[n] = (f32x4){1.f, 1.f, 1.f, 1.f}; gB[n] = gA[n]; }
            if (do_norm) {
#pragma unroll
                for (int n = 0; n < 2; ++n) { gA[n] = *(const f32x4*)(g + 8 * fq + 4 * n); gB[n] = *(const f32x4*)(g + 32 + 8 * fq + 4 * n); }
            }
            f32x4 rc[2], rsn[2], rcn[2], rsnn[2];
#pragma unroll
            for (int n = 0; n < 2; ++n) { rc[n] = (f32x4){1.f, 1.f, 1.f, 1.f}; rsn[n] = (f32x4){0.f, 0.f, 0.f, 0.f}; rcn[n] = rc[n]; rsnn[n] = rsn[n]; }
            if (do_rope) {
                const int t0 = row0 & (SEQ - 1);
#pragma unroll
                for (int n = 0; n < 2; ++n) { rc[n] = *(const f32x4*)(ch + t0 * 32 + 8 * fq + 4 * n); rsn[n] = *(const f32x4*)(sh + t0 * 32 + 8 * fq + 4 * n); }
            }
#pragma unroll
            for (int ai = 0; ai < 2; ++ai)
#pragma unroll
                for (int m = 0; m < 4; ++m) {
                    asm volatile("" ::: "memory"); int row = row0 + ai * HALF + m * 16; asm volatile("" : "+v"(row));
                    if (do_rope && (ai * 4 + m) < 7) {
                        const int k1 = ai * 4 + m + 1, tn = (row0 + (k1 >> 2) * HALF + (k1 & 3) * 16) & (SEQ - 1);
#pragma unroll
                        for (int n = 0; n < 2; ++n) { rcn[n] = *(const f32x4*)(ch + tn * 32 + 8 * fq + 4 * n); rsnn[n] = *(const f32x4*)(sh + tn * 32 + 8 * fq + 4 * n); }
                    }
                    float rs = 1.f;
                    if (do_norm) {
                        float ss = 0.f;
#pragma unroll
                        for (int n = 0; n < 2; ++n)
#pragma unroll
                            for (int j = 0; j < 4; ++j) ss += acc[ai][0][m][n][j] * acc[ai][0][m][n][j] + acc[ai][1][m][n][j] * acc[ai][1][m][n][j];
                        ss += __shfl_xor(ss, 16); ss += __shfl_xor(ss, 32);
                        rs = rsqrtf(ss * (1.f / 64.f) + EPS);
                    }
#pragma unroll
                    for (int n = 0; n < 2; ++n) {
                        f32x4 x1 = acc[ai][0][m][n], x2 = acc[ai][1][m][n];
                        if (do_norm) { x1 = x1 * rs * gA[n]; x2 = x2 * rs * gB[n]; }
                        if (do_rope) { const f32x4 a = x1 * rc[n] - x2 * rsn[n], b = x1 * rsn[n] + x2 * rc[n]; x1 = a; x2 = b; }
                        x1 = x1 * qs; x2 = x2 * qs;
                        if (tr) {
#pragma unroll
                            for (int j = 0; j < 4; ++j) { wsb[dofs + (unsigned)(8 * fq + 4 * n + j) * MT + row] = f2bf(x1[j]); wsb[dofs + (unsigned)(32 + 8 * fq + 4 * n + j) * MT + row] = f2bf(x2[j]); }
                        } else {
                            st_bf16x4(wsb + dofs + (unsigned)row * ld + 8 * fq + 4 * n, x1[0], x1[1], x1[2], x1[3]);
                            st_bf16x4(wsb + dofs + (unsigned)row * ld + 32 + 8 * fq + 4 * n, x2[0], x2[1], x2[2], x2[3]);
                        }
                    }
#pragma unroll
                    for (int n = 0; n < 2; ++n) { rc[n] = rcn[n]; rsn[n] = rsnn[n]; }
                }
        }
    }
};

struct EpiMla {
    static constexpr bool PERM = true, AFTER_DRAIN = false, KEEP = false;
    unsigned char* ws; const float* rope;
    __device__ __forceinline__ void operator()(const f32x4 (&acc)[2][2][4][2], const Unit& u, int wr, int wc, int fr_, int fq_) const {
        int fr = fr_, fq = fq_; asm volatile("" : "+v"(fr), "+v"(fq));
        bf16_t* const QDN = (bf16_t*)(ws + WS_QDN); bf16_t* const QDP = (bf16_t*)(ws + WS_QDP); bf16_t* const KDN = (bf16_t*)(ws + WS_KDN); bf16_t* const VTD = (bf16_t*)(ws + WS_VTD);
        const float* const RSQ = (const float*)(ws + WS_RSQ); const float* const RSKV = (const float*)(ws + WS_RSKV);
        const int pc = u.pc, row0 = u.pm * BM + wr * 64 + fr;
        const bool lat = u.pm < ML / BM;
        const float* cr = rope + SEQ * 64; const float* sr = cr + SEQ * 16;
        float rs8[8];
        {
            f32x4 pq8[8];
#pragma unroll
            for (int k = 0; k < 8; ++k) pq8[k] = *(const f32x4*)((pc < 2 ? RSQ : RSKV) + (row0 + (k >> 2) * HALF + (k & 3) * 16) * 4);
#pragma unroll
            for (int k = 0; k < 8; ++k) rs8[k] = rsqrtf(((pq8[k][0] + pq8[k][1]) + (pq8[k][2] + pq8[k][3])) * (pc < 2 ? 1.f / 256.f : 1.f / 128.f) + EPS) * (pc < 2 ? C2D : 1.f);
        }
        const bool rope1 = (pc == 1) && lat;
        f32x4 rc = {1.f, 1.f, 1.f, 1.f}, rsn = {0.f, 0.f, 0.f, 0.f}, rcn = rc, rsnn = rsn;
        if (rope1) { const int t0 = row0 & (SEQ - 1); rc = *(const f32x4*)(cr + t0 * 16 + 4 * fq); rsn = *(const f32x4*)(sr + t0 * 16 + 4 * fq); }
#pragma unroll
        for (int ai = 0; ai < 2; ++ai)
#pragma unroll
            for (int m = 0; m < 4; ++m) {
                asm volatile("" ::: "memory"); int row = row0 + ai * HALF + m * 16; asm volatile("" : "+v"(row));
                if (rope1 && (ai * 4 + m) < 7) { const int k1 = ai * 4 + m + 1, tn = (row0 + (k1 >> 2) * HALF + (k1 & 3) * 16) & (SEQ - 1); rcn = *(const f32x4*)(cr + tn * 16 + 4 * fq); rsnn = *(const f32x4*)(sr + tn * 16 + 4 * fq); }
                const float rs = rs8[ai * 4 + m];
                if (pc == 1) {
                    float o1[4], o2[4];
#pragma unroll
                    for (int j = 0; j < 4; ++j) {
                        const float a = acc[ai][0][m][0][j] * rs, b = acc[ai][0][m][1][j] * rs;
                        const float c = rc[j], sn = rsn[j];
                        o1[j] = a * c - b * sn; o2[j] = a * sn + b * c;
                    }
                    rc = rcn; rsn = rsnn;
                    st_bf16x4(QDP + (unsigned)row * 128 + 32 * wc + 4 * fq, o1[0], o1[1], o1[2], o1[3]);
                    st_bf16x4(QDP + (unsigned)row * 128 + 32 * wc + 16 + 4 * fq, o2[0], o2[1], o2[2], o2[3]);
                } else {
                    float x1[8], x2[8];
#pragma unroll
                    for (int n = 0; n < 2; ++n)
#pragma unroll
                        for (int j = 0; j < 4; ++j) { x1[n * 4 + j] = acc[ai][0][m][n][j] * rs; x2[n * 4 + j] = acc[ai][1][m][n][j] * rs; }
                    if (pc == 3) {
                        bf16_t* vt = VTD + (unsigned)(64 * wc) * MT;
#pragma unroll
                        for (int i = 0; i < 8; ++i) { vt[(unsigned)(8 * fq + i) * MT + row] = f2bf(x1[i]); vt[(unsigned)(32 + 8 * fq + i) * MT + row] = f2bf(x2[i]); }
                    } else {
                        bf16_t* dst = (pc == 0 ? QDN : KDN) + (unsigned)row * 256 + 64 * wc;
                        st_bf16x8(dst + 8 * fq, x1); st_bf16x8(dst + 32 + 8 * fq, x2);
                    }
                }
            }
    }
};

struct EpiBranch {
    static constexpr bool PERM = true, AFTER_DRAIN = false, KEEP = true;
    bf16_t* MIX; const bf16_t* GATE;
    static __device__ __forceinline__ float gq(unsigned w, int b) { return fmaf((float)((w >> (8 * b)) & 0xffu), 1.f / 256.f, 1.f / 512.f); }
    __device__ __forceinline__ bool seg(f32x4 (&acc)[2][2][4][2], const Unit& u, int wr, int wc, int fr, int fq) const {
        const int row0 = u.pm * BM + wr * 64 + fr, col0 = u.pc * BM + wc * 32 + 8 * fq, s = u.seg;
        const unsigned char* gbase = (const unsigned char*)GATE + (unsigned)row0 * 4096 + s * 1024 + col0;
        const unsigned nxo = s < 3 ? 1024u : 0u;
        const bool notlast = s < 3;
#pragma unroll
        for (int ai = 0; ai < 2; ++ai)
#pragma unroll
            for (int mp = 0; mp < 2; ++mp) {
                u32x2 gc[2][2], gn[2][2];
                asm volatile("" ::: "memory");
#pragma unroll
                for (int mm = 0; mm < 2; ++mm)
#pragma unroll
                    for (int bj = 0; bj < 2; ++bj) { const unsigned char* gp = gbase + (unsigned)(ai * HALF + (2 * mp + mm) * 16) * 4096 + bj * HALF; gc[mm][bj] = *(const u32x2*)gp; gn[mm][bj] = *(const u32x2*)(gp + nxo); }
                asm volatile("" ::: "memory");
#pragma unroll
                for (int mm = 0; mm < 2; ++mm)
#pragma unroll
                    for (int bj = 0; bj < 2; ++bj) {
                        float v[8];
#pragma unroll
                        for (int n = 0; n < 2; ++n)
#pragma unroll
                            for (int j = 0; j < 4; ++j) {
                                const float gcv = gq(gc[mm][bj][n], j), rn = __builtin_amdgcn_rcpf(gq(gn[mm][bj][n], j));
                                acc[ai][bj][2 * mp + mm][n][j] *= notlast ? gcv * rn : gcv; v[n * 4 + j] = acc[ai][bj][2 * mp + mm][n][j];
                            }
                        if (!notlast) st_bf16x8(MIX + (unsigned)(row0 + ai * HALF + (2 * mp + mm) * 16) * D + col0 + bj * HALF, v);
                    }
            }
        return notlast;
    }
};
struct BranchOrder {
    StaticOrder T;
    __device__ void init(int M, int G_, int c_) { T.init(M, D, G_, c_); }
    __device__ bool next(int i, Unit& u) const { if (!T.next(i >> 2, u)) return false; u.seg = i & 3; u.koff = (i & 3) * 512; return true; }
    __device__ __forceinline__ void a_ready(const Unit&) const {}
    __device__ __forceinline__ void done(const Unit&) const {}
};
struct TailOrder {
    StaticOrder T; int c, nsplit, kpiece;
    __device__ void init(int G_, int c_, int nsplit_, int kpiece_) { T.init(ML, D, G_, c_); c = c_; nsplit = nsplit_; kpiece = kpiece_; }
    __device__ bool next(int i, Unit& u) const {
        if (i == 0) return T.next(0, u);
        if (i > 1 || c >= 32 * nsplit) return false;
        const int t = c / nsplit, p = c - t * nsplit;
        u.pm = ML / BM + (t >> 2); u.pn = t & 3; u.pc = u.pn; u.koff = p * kpiece * 2; u.seg = 1 + p; u.nt = kpiece / BK; return true;
    }
    __device__ __forceinline__ void a_ready(const Unit&) const {}
    __device__ __forceinline__ void done(const Unit&) const {}
};
struct EpiResidTail {
    static constexpr bool PERM = true, AFTER_DRAIN = false, KEEP = false;
    bf16_t* X; const float* gate; bf16_t* PART;
    __device__ __forceinline__ void operator()(const f32x4 (&acc)[2][2][4][2], const Unit& u, int wr, int wc, int fr, int fq) const {
        const int row0 = u.pm * BM + wr * 64 + fr, col0 = u.pc * BM + wc * 32 + 8 * fq;
        if (u.seg == 0) { resid_tile(acc, X, (unsigned)D, gate, row0, col0); return; }
        bf16_t* pp0 = PART + ((unsigned)(u.seg - 1) * MC + (unsigned)(row0 - ML)) * D + col0;
#pragma unroll
        for (int ai = 0; ai < 2; ++ai)
#pragma unroll
            for (int m = 0; m < 4; ++m)
#pragma unroll
                for (int bj = 0; bj < 2; ++bj) {
                    const f32x4 v0 = acc[ai][bj][m][0], v1 = acc[ai][bj][m][1];
                    u32x4 w; w.x = cvt_pk_bf16(v0[0], v0[1]); w.y = cvt_pk_bf16(v0[2], v0[3]); w.z = cvt_pk_bf16(v1[0], v1[1]); w.w = cvt_pk_bf16(v1[2], v1[3]);
                    *(u32x4*)(pp0 + (unsigned)(ai * HALF + m * 16) * D + bj * HALF) = w;
                }
    }
};
struct InprojLastOrder {
    StaticOrder T; int G, c;
    __device__ void init(int G_, int c_) { T.init(ML, INWP, G_, c_); G = G_; c = c_; }
    __device__ bool next(int i, Unit& u) const {
        const int L = i * G + c, nlat = (ML / BM) * (INWP / BM);
        if (L < nlat) return T.next(i, u);
        const int q = L - nlat; if (q >= (MC / BM) * 9) return false;
        u.pm = ML / BM + q / 9; u.pn = q % 9; u.pc = u.pn; u.koff = 0; u.seg = 0; u.nt = 0; return true;
    }
    __device__ __forceinline__ void a_ready(const Unit&) const {}
    __device__ __forceinline__ void done(const Unit&) const {}
};
struct MoeDownOrder {
    int nP, G, c, khalf; const PG8_LAS int* pexp;
    __device__ void init(int nP_, int G_, int c_, int khalf_, const PG8_LAS int* pexp_) { nP = nP_; G = G_; c = c_; khalf = khalf_; pexp = pexp_; }
    __device__ bool next(int i, Unit& u) const {
        const int nfull = YSPLIT_P0 * 4;
        int L, half = -1;
        if (i * G + c < nfull) {
            const int L0 = i * G + c, wgid = (L0 % NXCD) * (nfull / NXCD) + L0 / NXCD, gid = wgid / (WGM * 4), w = wgid % (WGM * 4);
            L = (gid * WGM + (w % WGM)) * 4 + w / WGM;
        } else { const int q = (i * G + c) - nfull; L = nfull + (q >> 1); half = q & 1; }
        if (L >= nP * 4) return false;
        u.pm = L >> 2; u.pc = L & 3; u.pn = pexp[u.pm] * 4 + u.pc; u.koff = half > 0 ? khalf * 2 : 0; u.seg = half + 1; u.nt = half >= 0 ? khalf / BK : 0; return true;
    }
    __device__ __forceinline__ void a_ready(const Unit&) const {}
    __device__ __forceinline__ void done(const Unit&) const {}
};
struct EpiY {
    static constexpr bool PERM = true, AFTER_DRAIN = false, KEEP = false;
    bf16_t *Y, *Y2;
    __device__ __forceinline__ void operator()(const f32x4 (&acc)[2][2][4][2], const Unit& u, int wr, int wc, int fr, int fq) const {
        const int row0 = u.pm * BM + wr * 64 + fr, col0 = u.pc * BM + wc * 32 + 8 * fq;
        bf16_t* base = (u.seg == 2) ? Y2 - (unsigned)(YSPLIT_P0 * BM) * D : Y;
#pragma unroll
        for (int ai = 0; ai < 2; ++ai)
#pragma unroll
            for (int m = 0; m < 4; ++m) {
                bf16_t* rowp = base + (unsigned)(row0 + ai * HALF + m * 16) * D + col0;
#pragma unroll
                for (int bj = 0; bj < 2; ++bj) {
                    const f32x4 v0 = acc[ai][bj][m][0], v1 = acc[ai][bj][m][1];
                    u32x4 w; w.x = cvt_pk_bf16(v0[0], v0[1]); w.y = cvt_pk_bf16(v0[2], v0[3]); w.z = cvt_pk_bf16(v1[0], v1[1]); w.w = cvt_pk_bf16(v1[2], v1[3]);
                    *(u32x4*)(rowp + bj * HALF) = w;
                }
            }
    }
};
template <class Epi, class Sched, bool ALIGN_EPI = false, bool SP2 = false>
__device__ __forceinline__ void gemm_phase(PG8_LAS unsigned char* lds, const Gemm g, const Sched& S, const Epi& E) {
    int tid_ = threadIdx.x; asm volatile("" : "+v"(tid_));
    const int tid = tid_, wid = __builtin_amdgcn_readfirstlane(tid >> 6), lane = tid & 63, wr = wid >> 2, wc = wid & 3, fr = lane & 15, fq = lane >> 4;
    const int K = g.K, ntdef = K / BK; const int lda = g.lda, ldb = g.ldb;
    unsigned voffA[2], voffB[2];
#pragma unroll
    for (int i = 0; i < 2; ++i) { int R, C; stage_rc(tid * 16 + i * 8192, R, C); const int Rb = Epi::PERM ? ((R & ~31) + perm32(R & 31)) : R;
        voffA[i] = (unsigned)(R * lda + C) * 2u; voffB[i] = (unsigned)(Rb * ldb + C) * 2u; }
    const size_t kstep = (size_t)(BK * 2);
    const size_t hstepA = (size_t)HALF * lda * 2, hstepB = (size_t)HALF * ldb * 2;
    const size_t tstepA = 2 * hstepA, tstepB = 2 * hstepB;
    const unsigned ldsw = (unsigned)wid * 1024u;
    const int aoff = lds_byte(wr * 64 + fr, fq * 8), boff = lds_byte(wc * 32 + fr, fq * 8);
#define PG8_SA(b, h) (((b) * 2 + (h)) * HTB)
#define PG8_SB(b, h) ((4 + (b) * 2 + (h)) * HTB)
#define PG8_STAGE(bufoff, gbase, voff) do { _Pragma("unroll") for (int _i = 0; _i < 2; ++_i) \
        __builtin_amdgcn_global_load_lds((const unsigned*)((const char*)(gbase) + (voff)[_i]), (PG8_LAS unsigned*)(lds + (bufoff) + ldsw + _i * 8192), 16, 0, 0); } while (0)
#define PG8_LDA(dst, b, h) do { _Pragma("unroll") for (int m = 0; m < 4; ++m) _Pragma("unroll") for (int k = 0; k < 2; ++k) dst[m][k] = *(const PG8_LAS bf16x8*)(lds + PG8_SA(b, h) + aoff + m * 2048 + k * 1024); } while (0)
#define PG8_LDB(dst, b, h) do { _Pragma("unroll") for (int n = 0; n < 2; ++n) _Pragma("unroll") for (int k = 0; k < 2; ++k) dst[n][k] = *(const PG8_LAS bf16x8*)(lds + PG8_SB(b, h) + boff + n * 2048 + k * 1024); } while (0)
#define PG8_MMA(ai, bj, At, Bt) do { __builtin_amdgcn_s_setprio(1); _Pragma("unroll") for (int m = 0; m < 4; ++m) _Pragma("unroll") for (int n = 0; n < 2; ++n) _Pragma("unroll") for (int k = 0; k < 2; ++k) \
        acc[ai][bj][m][n] = __builtin_amdgcn_mfma_f32_16x16x32_bf16(Bt[n][k], At[m][k], acc[ai][bj][m][n], 0, 0, 0); __builtin_amdgcn_s_setprio(0); } while (0)
#define PG8_WAIT_V(n) asm volatile("s_waitcnt vmcnt(" #n ")" ::: "memory")
#define PG8_WAIT_L(n) asm volatile("s_waitcnt lgkmcnt(" #n ")" ::: "memory")
#define PG8_BAR __builtin_amdgcn_s_barrier()
#define PG8_SCHED __builtin_amdgcn_sched_barrier(0)
    Unit cur, nxt; int ui = 0;
    if (!S.next(0, cur)) return;
    f32x4 acc[2][2][4][2];
#pragma unroll
    for (int a = 0; a < 2; ++a)
#pragma unroll
        for (int b = 0; b < 2; ++b)
#pragma unroll
            for (int m = 0; m < 4; ++m)
#pragma unroll
                for (int n = 0; n < 2; ++n) acc[a][b][m][n] = (f32x4){0.f, 0.f, 0.f, 0.f};
    bf16x8 At[4][2], B0[2][2], B1[2][2];
    const char* cA = (const char*)g.A + (size_t)cur.pm * tstepA + cur.koff; const char* cB = (const char*)g.Bt + (size_t)cur.pn * tstepB + cur.koff;
    S.a_ready(cur);
    if constexpr (SP2) {
        PG8_STAGE(PG8_SB(0, 0), cB, voffB); PG8_STAGE(PG8_SB(0, 1), cB + hstepB, voffB); PG8_STAGE(PG8_SA(0, 0), cA, voffA); PG8_STAGE(PG8_SA(0, 1), cA + hstepA, voffA);
        if (wr == 1) PG8_BAR;
        PG8_WAIT_V(2); PG8_BAR;
        PG8_STAGE(PG8_SB(1, 0), cB + kstep, voffB); PG8_STAGE(PG8_SA(1, 0), cA + kstep, voffA); PG8_STAGE(PG8_SB(1, 1), cB + hstepB + kstep, voffB);
        PG8_WAIT_V(6); PG8_BAR;
    } else {
        PG8_STAGE(PG8_SB(0, 0), cB, voffB); PG8_STAGE(PG8_SA(0, 0), cA, voffA); PG8_STAGE(PG8_SB(0, 1), cB + hstepB, voffB); PG8_STAGE(PG8_SA(0, 1), cA + hstepA, voffA);
        if (wr == 1) PG8_BAR;
        PG8_WAIT_V(4); PG8_BAR;
        PG8_STAGE(PG8_SB(1, 0), cB + kstep, voffB); PG8_STAGE(PG8_SA(1, 0), cA + kstep, voffA); PG8_STAGE(PG8_SB(1, 1), cB + hstepB + kstep, voffB);
        PG8_WAIT_V(6); PG8_BAR;
    }
    for (;;) {
        const int nt = cur.nt ? cur.nt : ntdef;
        const bool has_next = S.next(ui + 1, nxt);
        const char* nA = has_next ? (const char*)g.A + (size_t)nxt.pm * tstepA + nxt.koff : cA; const char* nB = has_next ? (const char*)g.Bt + (size_t)nxt.pn * tstepB + nxt.koff : cB;
#pragma nounroll
        for (int t = 0; t < nt; t += 2) {
            const bool last = (t == nt - 2);
            const char* a1 = cA + (size_t)(t + 1) * kstep;
            const char* a2 = last ? nA : cA + (size_t)(t + 2) * kstep; const char* b2 = last ? nB : cB + (size_t)(t + 2) * kstep;
            const char* a3 = a2 + kstep; const char* b3 = b2 + kstep;
            if (last && has_next) S.a_ready(nxt);
            if constexpr (SP2) {
            PG8_LDB(B0, 0, 0); PG8_LDB(B1, 0, 1); PG8_SCHED; PG8_LDA(At, 0, 0); PG8_STAGE(PG8_SA(1, 1), a1 + hstepA, voffA);
            PG8_WAIT_V(8); PG8_WAIT_L(0); PG8_BAR; PG8_MMA(0, 0, At, B0); PG8_MMA(0, 1, At, B1); PG8_BAR; PG8_SCHED;
            PG8_LDA(At, 0, 1); PG8_STAGE(PG8_SB(0, 0), b2, voffB); PG8_STAGE(PG8_SB(0, 1), b2 + hstepB, voffB); PG8_STAGE(PG8_SA(0, 0), a2, voffA);
            PG8_WAIT_V(8); PG8_WAIT_L(0); PG8_BAR; PG8_MMA(1, 0, At, B0); PG8_MMA(1, 1, At, B1); PG8_BAR; PG8_SCHED;
            PG8_LDB(B0, 1, 0); PG8_LDB(B1, 1, 1); PG8_SCHED; PG8_LDA(At, 1, 0); PG8_STAGE(PG8_SA(0, 1), a2 + hstepA, voffA);
            PG8_WAIT_V(8); PG8_WAIT_L(0); PG8_BAR; PG8_MMA(0, 0, At, B0); PG8_MMA(0, 1, At, B1); PG8_BAR; PG8_SCHED;
            PG8_LDA(At, 1, 1); PG8_STAGE(PG8_SB(1, 0), b3, voffB); PG8_STAGE(PG8_SB(1, 1), b3 + hstepB, voffB); PG8_STAGE(PG8_SA(1, 0), a3, voffA);
            PG8_WAIT_V(8); PG8_WAIT_L(0); PG8_BAR; PG8_MMA(1, 0, At, B0); PG8_MMA(1, 1, At, B1); PG8_BAR; PG8_SCHED;
            } else {
            PG8_LDB(B0, 0, 0); PG8_SCHED; PG8_LDA(At, 0, 0); PG8_STAGE(PG8_SA(1, 1), a1 + hstepA, voffA);
            PG8_WAIT_L(8); PG8_BAR; PG8_WAIT_L(0); PG8_MMA(0, 0, At, B0); PG8_BAR; PG8_SCHED;
            PG8_LDB(B1, 0, 1); PG8_STAGE(PG8_SB(0, 0), b2, voffB);
            PG8_BAR; PG8_WAIT_L(0); PG8_MMA(0, 1, At, B1); PG8_BAR;
            PG8_LDA(At, 0, 1); PG8_STAGE(PG8_SA(0, 0), a2, voffA);
            PG8_BAR; PG8_WAIT_L(0); PG8_MMA(1, 0, At, B0); PG8_BAR; PG8_SCHED;
            PG8_STAGE(PG8_SB(0, 1), b2 + hstepB, voffB);
            PG8_WAIT_V(6); PG8_BAR; PG8_MMA(1, 1, At, B1); PG8_BAR;
            PG8_LDB(B0, 1, 0); PG8_SCHED; PG8_LDA(At, 1, 0); PG8_STAGE(PG8_SA(0, 1), a2 + hstepA, voffA);
            PG8_WAIT_L(8); PG8_BAR; PG8_WAIT_L(0); PG8_MMA(0, 0, At, B0); PG8_BAR; PG8_SCHED;
            PG8_LDB(B1, 1, 1); PG8_STAGE(PG8_SB(1, 0), b3, voffB);
            PG8_BAR; PG8_WAIT_L(0); PG8_MMA(0, 1, At, B1); PG8_BAR;
            PG8_LDA(At, 1, 1); PG8_STAGE(PG8_SA(1, 0), a3, voffA);
            PG8_BAR; PG8_WAIT_L(0); PG8_MMA(1, 0, At, B0); PG8_BAR; PG8_SCHED;
            PG8_STAGE(PG8_SB(1, 1), b3 + hstepB, voffB);
            PG8_WAIT_V(6); PG8_BAR; PG8_MMA(1, 1, At, B1); PG8_BAR;
            }
        }
        if constexpr (ALIGN_EPI) { if (wr == 0) PG8_BAR; }
        bool keep = false;
        if constexpr (Epi::KEEP) keep = E.seg(acc, cur, wr, wc, fr, fq); else { E(acc, cur, wr, wc, fr, fq); }
        S.done(cur);
        if (!has_next) break;
        if (!keep) {
#pragma unroll
        for (int a = 0; a < 2; ++a)
#pragma unroll
            for (int b = 0; b < 2; ++b)
#pragma unroll
                for (int m = 0; m < 4; ++m)
#pragma unroll
                    for (int n = 0; n < 2; ++n) acc[a][b][m][n] = (f32x4){0.f, 0.f, 0.f, 0.f};
        }
        cur = nxt; cA = nA; cB = nB; ++ui;
        if constexpr (ALIGN_EPI) { if (wr == 1) PG8_BAR; }
    }
    PG8_WAIT_V(0);
    if constexpr (!ALIGN_EPI) { if (wr == 0) PG8_BAR; }
    PG8_BAR;
#undef PG8_SA
#undef PG8_SB
#undef PG8_STAGE
#undef PG8_LDA
#undef PG8_LDB
#undef PG8_MMA
#undef PG8_WAIT_V
#undef PG8_WAIT_L
#undef PG8_BAR
#undef PG8_SCHED
}
}

__device__ __forceinline__ float bf2f(unsigned short b) { return __uint_as_float(((unsigned)b) << 16); }

namespace at {
typedef short bf16x8 __attribute__((ext_vector_type(8)));
typedef float f32x16 __attribute__((ext_vector_type(16)));
typedef float f32x2v __attribute__((ext_vector_type(2)));
typedef unsigned short bf16_t;
constexpr int VST = 144;
constexpr int KBYTES = 64 * 208, VBYTES = 64 * VST, BUFB = KBYTES + VBYTES;
constexpr int RPB_OFF = 2 * BUFB;
constexpr float LOG2E = 1.4426950408889634f;
enum { PLAIN = 0, WINDOW = 1, NATTEN = 2 };
struct Unit {
    const bf16_t *Q, *Q2, *K, *K2, *VT; bf16_t* O;
    int ldq, ldq2, ldk;
    int qrow0;
    int ntile, nloc, krow_loc0, krow_ctx0;
    int t0, j0;
    int rr, c0, krlo;
    float sink2; int has_sink;
};
__device__ __forceinline__ int sig(int r) { return (r & ~12) | ((r & 4) << 1) | ((r & 8) >> 1); }
__device__ __forceinline__ bf16x8 pack8(const f32x16& p, int s) {
    pg8::u32x4 w;
    w.x = pg8::cvt_pk_bf16(p[8 * s + 0], p[8 * s + 1]); w.y = pg8::cvt_pk_bf16(p[8 * s + 2], p[8 * s + 3]);
    w.z = pg8::cvt_pk_bf16(p[8 * s + 4], p[8 * s + 5]); w.w = pg8::cvt_pk_bf16(p[8 * s + 6], p[8 * s + 7]);
    return __builtin_bit_cast(bf16x8, w);
}
template <int DQK, int MODE>
__device__ __forceinline__ void attn_unit(unsigned char* lds_, const Unit& U, int tid) {
    static_assert(DQK == 64 && MODE != PLAIN, "masked 64-dim units only");
    typedef __attribute__((address_space(3))) unsigned char* ldsp_t;
    constexpr int NKS = DQK / 16, TK = 8192, TILE = 16384;
    const ldsp_t ldsl = (ldsp_t)lds_;
    unsigned char* const lds = lds_;
    const int lane = tid & 63, r = lane & 31, h = lane >> 5;
    const int wave = __builtin_amdgcn_readfirstlane(tid >> 6);
    bf16x8 qf[NKS];
    {
        const bf16_t* qp = U.Q + (unsigned)(U.qrow0 + r) * U.ldq + 8 * h;
#pragma unroll
        for (int ks = 0; ks < 4; ++ks) qf[ks] = *(const bf16x8*)(qp + 16 * ks);
    }
    f32x16 o0, o1;
#pragma unroll
    for (int i = 0; i < 16; ++i) { o0[i] = 0.f; o1[i] = 0.f; }
    float m = 0.f, lsum = 0.f;
    f32x16 negm;
#pragma unroll
    for (int i = 0; i < 16; ++i) negm[i] = 0.f;
    asm volatile("" : "+v"(negm));
    unsigned vm0 = 0u, vm1 = 0u; int vb = 0;
    if (MODE == NATTEN) {
        const int qc = U.c0 + r;
        int cst = qc - 8; cst = cst < 0 ? 0 : (cst > 48 ? 48 : cst);
#pragma unroll
        for (int i = 0; i < 16; ++i) {
            const int kc = 8 * h + (i & 7) + 16 * (i >> 3), e0 = kc - cst, e1 = kc + 32 - cst;
            if (e0 >= 0 && e0 < 16) vm0 |= 1u << i;
            if (e1 >= 0 && e1 < 16) vm1 |= 1u << i;
        }
        vb = 8 * h - qc + 15;
    }
    constexpr float THR = 8.f;
    const int drow = 8 * wave + (lane >> 3), dch = (lane & 7) ^ ((drow >> 1) & 7);
    const int sr = sig(r);
    unsigned kx[4], vx[4];
#pragma unroll
    for (int j = 0; j < 4; ++j) { kx[j] = (unsigned)(sr * 128 + (((2 * j + h) ^ ((sr >> 1) & 7)) << 4)); vx[j] = (unsigned)(TK + r * 128 + (((2 * j + h) ^ ((r >> 1) & 7)) << 4)); }
    auto tile_krow = [&](int ti) { return ti < U.nloc ? U.krow_loc0 + 64 * ti : U.krow_ctx0 + 64 * (ti - U.nloc); };
    auto issue = [&](int ti) {
        const int kr0 = tile_krow(ti); const unsigned pa = (unsigned)((ti & 1) * TILE + wave * 1024);
        __builtin_amdgcn_global_load_lds((const unsigned*)(U.K + (unsigned)(kr0 + drow) * U.ldk + dch * 8), (__attribute__((address_space(3))) unsigned*)(ldsl + pa), 16, 0, 0);
        __builtin_amdgcn_global_load_lds((const unsigned*)(U.VT + (unsigned)drow * MT + kr0 + dch * 8), (__attribute__((address_space(3))) unsigned*)(ldsl + pa + TK), 16, 0, 0);
    };
    auto need_of = [&](int ti, bool& masked, int& jt, int& kr) -> bool {
        bool need = true; masked = false; jt = 0; kr = 0;
        if (MODE == WINDOW && ti < U.nloc) {
            jt = U.j0 + 64 * ti;
            need = (jt + 63 >= U.t0 - 128) && (jt <= U.t0 + 31 + 128);
            masked = !((jt >= U.t0 + 31 - 128) && (jt + 63 <= U.t0 + 128));
        }
        if (MODE == NATTEN && ti < U.nloc) {
            kr = U.krlo + ti;
            int s0 = U.rr - 4; s0 = s0 < 0 ? 0 : (s0 > 24 ? 24 : s0);
            need = (kr >= s0) && (kr < s0 + 8);
            masked = true;
        }
        return need;
    };
    f32x16 c0, c1;
    issue(0);
    for (int ti = 0; ti < U.ntile; ++ti) {
        asm volatile("s_waitcnt vmcnt(0)" ::: "memory");
        __syncthreads();
        if (ti + 1 < U.ntile) issue(ti + 1);
        bool mk_c; int jt_c, kr_c;
        if (need_of(ti, mk_c, jt_c, kr_c)) {
            const ldsp_t tb = ldsl + (ti & 1) * TILE;
            {
#pragma unroll
                for (int ks = 0; ks < NKS; ++ks) {
                    const bf16x8 a0 = *(const __attribute__((address_space(3))) bf16x8*)(tb + kx[ks]), a1 = *(const __attribute__((address_space(3))) bf16x8*)(tb + kx[ks] + 32 * 128);
                    c0 = __builtin_amdgcn_mfma_f32_32x32x16_bf16(a0, qf[ks], ks == 0 ? negm : c0, 0, 0, 0);
                    c1 = __builtin_amdgcn_mfma_f32_32x32x16_bf16(a1, qf[ks], ks == 0 ? negm : c1, 0, 0, 0);
                }
            }
            if (mk_c) {
                if (MODE == WINDOW) {
                    const int t = U.t0 + r;
#pragma unroll
                    for (int i = 0; i < 16; ++i) {
                        const int j = jt_c + 8 * h + (i & 7) + 16 * (i >> 3);
                        const int d0 = t - j, d1 = t - (j + 32);
                        if (d0 > 128 || d0 < -128) c0[i] = -INFINITY;
                        if (d1 > 128 || d1 < -128) c1[i] = -INFINITY;
                    }
                }
                if (MODE == NATTEN) {
                    const float* rp = (const float*)(lds + RPB_OFF) + (kr_c - U.rr + 7) * 31 + vb;
#pragma unroll
                    for (int i = 0; i < 16; ++i) {
                        const int ko = (i & 7) + 16 * (i >> 3);
                        c0[i] = ((vm0 >> i) & 1u) ? c0[i] + rp[ko] : -INFINITY;
                        c1[i] = ((vm1 >> i) & 1u) ? c1[i] + rp[ko + 32] : -INFINITY;
                    }
                }
            }
            float mx = fmaxf(c0[0], c1[0]);
#pragma unroll
            for (int i = 1; i < 16; ++i) mx = fmaxf(fmaxf(mx, c0[i]), c1[i]);
            mx = fmaxf(mx, __shfl_xor(mx, 32));
            const bool grow = mx > THR, init = (lsum == 0.f) && (mx < -THR) && (mx > -1e30f);
            if (__any(grow || init)) {
                const float d = (grow || init) ? mx : 0.f;
                const float alpha = init ? 1.f : __builtin_amdgcn_exp2f(-d);
                m += d; lsum *= alpha;
#pragma unroll
                for (int i = 0; i < 16; ++i) { o0[i] *= alpha; o1[i] *= alpha; c0[i] -= d; c1[i] -= d; negm[i] -= d; }
                asm volatile("" : "+v"(negm));
            }
            f32x2v ps2 = {0.f, 0.f};
#pragma unroll
            for (int i = 0; i < 8; ++i) {
                c0[2 * i] = __builtin_amdgcn_exp2f(c0[2 * i]); c0[2 * i + 1] = __builtin_amdgcn_exp2f(c0[2 * i + 1]);
                c1[2 * i] = __builtin_amdgcn_exp2f(c1[2 * i]); c1[2 * i + 1] = __builtin_amdgcn_exp2f(c1[2 * i + 1]);
                const f32x2v a = {c0[2 * i], c0[2 * i + 1]}, bq = {c1[2 * i], c1[2 * i + 1]}; ps2 += a; ps2 += bq;
            }
            lsum += ps2.x + ps2.y;
#pragma unroll
            for (int s = 0; s < 2; ++s) {
                const bf16x8 p0 = pack8(c0, s), p1 = pack8(c1, s);
                const bf16x8 v00 = *(const __attribute__((address_space(3))) bf16x8*)(tb + vx[s]), v01 = *(const __attribute__((address_space(3))) bf16x8*)(tb + vx[s] + 32 * 128);
                const bf16x8 v10 = *(const __attribute__((address_space(3))) bf16x8*)(tb + vx[2 + s]), v11 = *(const __attribute__((address_space(3))) bf16x8*)(tb + vx[2 + s] + 32 * 128);
                o0 = __builtin_amdgcn_mfma_f32_32x32x16_bf16(v00, p0, o0, 0, 0, 0);
                o1 = __builtin_amdgcn_mfma_f32_32x32x16_bf16(v01, p0, o1, 0, 0, 0);
                o0 = __builtin_amdgcn_mfma_f32_32x32x16_bf16(v10, p1, o0, 0, 0, 0);
                o1 = __builtin_amdgcn_mfma_f32_32x32x16_bf16(v11, p1, o1, 0, 0, 0);
            }
        }
    }
    float l = lsum + __shfl_xor(lsum, 32);
    if (U.has_sink) l += __builtin_amdgcn_exp2f(U.sink2 - m);
    const float inv = 1.f / l;
    bf16_t* op = U.O + (unsigned)(U.qrow0 + r) * D + 4 * h;
#pragma unroll
    for (int g = 0; g < 4; ++g) {
        pg8::st_bf16x4(op + 8 * g, o0[4 * g] * inv, o0[4 * g + 1] * inv, o0[4 * g + 2] * inv, o0[4 * g + 3] * inv);
        pg8::st_bf16x4(op + 32 + 8 * g, o1[4 * g] * inv, o1[4 * g + 1] * inv, o1[4 * g + 2] * inv, o1[4 * g + 3] * inv);
    }
    __syncthreads();
}
template <int DQK>
__device__ __forceinline__ void attn_plain2(unsigned char* lds_, const Unit& U, int tid) {
    typedef __attribute__((address_space(3))) unsigned char* ldsp_t;
    constexpr int NKS = DQK / 16;
    constexpr int TK = 8192, TK2 = (DQK == 96 ? 4096 : 0), TV = 8192, TILE = TK + TK2 + TV, B2 = 2 * TILE;
    constexpr float THR = 8.f;
    const ldsp_t lds = (ldsp_t)lds_;
    const int lane = tid & 63, r = lane & 31, h = lane >> 5;
    const int wave = __builtin_amdgcn_readfirstlane(tid >> 6);
    bf16x8 qf[NKS];
    {
        const bf16_t* qp = U.Q + (unsigned)(U.qrow0 + r) * U.ldq + 8 * h;
#pragma unroll
        for (int ks = 0; ks < 4; ++ks) qf[ks] = *(const bf16x8*)(qp + 16 * ks);
        if (DQK == 96) {
            const bf16_t* qp2 = U.Q2 + (unsigned)(U.qrow0 + r) * U.ldq2 + 8 * h;
#pragma unroll
            for (int ks = 4; ks < NKS; ++ks) qf[ks] = *(const bf16x8*)(qp2 + 16 * (ks - 4));
        }
    }
    f32x16 o0, o1;
#pragma unroll
    for (int i = 0; i < 16; ++i) { o0[i] = 0.f; o1[i] = 0.f; }
    float m = 0.f, lsum = 0.f;
    f32x16 negm;
#pragma unroll
    for (int i = 0; i < 16; ++i) negm[i] = 0.f;
    asm volatile("" : "+v"(negm));
    const int drow = 8 * wave + (lane >> 3), dch = (lane & 7) ^ ((drow >> 1) & 7);
    const int d2row = 16 * wave + (lane >> 2), d2ch = (lane & 3) ^ ((d2row >> 2) & 3);
    const int sr = sig(r);
    unsigned kx[4], vx[4], k2x[2];
#pragma unroll
    for (int j = 0; j < 4; ++j) { kx[j] = (unsigned)(sr * 128 + (((2 * j + h) ^ ((sr >> 1) & 7)) << 4)); vx[j] = (unsigned)(TK + TK2 + r * 128 + (((2 * j + h) ^ ((r >> 1) & 7)) << 4)); }
#pragma unroll
    for (int j = 0; j < 2; ++j) k2x[j] = (unsigned)(TK + sr * 64 + (((2 * j + h) ^ ((sr >> 2) & 3)) << 4));
    auto tile_krow = [&](int ti) { return ti < U.nloc ? U.krow_loc0 + 64 * ti : U.krow_ctx0 + 64 * (ti - U.nloc); };
#define AT_DMA(src, dstoff) __builtin_amdgcn_global_load_lds((const unsigned*)(src), (__attribute__((address_space(3))) unsigned*)(lds + (dstoff)), 16, 0, 0)
    auto issue = [&](int si, const int buf) {
        const int ka0 = tile_krow(2 * si), kb0 = tile_krow(2 * si + 1);
        const unsigned pa = (unsigned)(buf * B2 + wave * 1024), pb = pa + TILE;
        AT_DMA(U.K + (unsigned)(ka0 + drow) * U.ldk + dch * 8, pa);
        AT_DMA(U.K + (unsigned)(kb0 + drow) * U.ldk + dch * 8, pb);
        if (DQK == 96) { if (wave < 4) { AT_DMA(U.K2 + (unsigned)(ka0 + d2row) * 32 + d2ch * 8, pa + TK); AT_DMA(U.K2 + (unsigned)(kb0 + d2row) * 32 + d2ch * 8, pb + TK); } }
        AT_DMA(U.VT + (unsigned)drow * MT + ka0 + dch * 8, pa + TK + TK2);
        AT_DMA(U.VT + (unsigned)drow * MT + kb0 + dch * 8, pb + TK + TK2);
    };
    const int nstep = U.ntile >> 1;
    auto step = [&](int si, const int buf) {
        asm volatile("s_waitcnt vmcnt(0)" ::: "memory");
        __syncthreads();
        if (si + 1 < nstep) issue(si + 1, buf ^ 1);
        const ldsp_t ba = lds + buf * B2; const ldsp_t bb = ba + TILE;
        f32x16 a0, a1, b0, b1;
        {
#pragma unroll
            for (int ks = 0; ks < NKS; ++ks) {
                const unsigned ko = ks < 4 ? kx[ks & 3] : k2x[(ks - 4) & 1]; const int hs = ks < 4 ? 32 * 128 : 32 * 64;
                const bf16x8 fa0 = *(const __attribute__((address_space(3))) bf16x8*)(ba + ko), fa1 = *(const __attribute__((address_space(3))) bf16x8*)(ba + ko + hs);
                const bf16x8 fb0 = *(const __attribute__((address_space(3))) bf16x8*)(bb + ko), fb1 = *(const __attribute__((address_space(3))) bf16x8*)(bb + ko + hs);
                a0 = __builtin_amdgcn_mfma_f32_32x32x16_bf16(fa0, qf[ks], ks == 0 ? negm : a0, 0, 0, 0);
                b0 = __builtin_amdgcn_mfma_f32_32x32x16_bf16(fb0, qf[ks], ks == 0 ? negm : b0, 0, 0, 0);
                a1 = __builtin_amdgcn_mfma_f32_32x32x16_bf16(fa1, qf[ks], ks == 0 ? negm : a1, 0, 0, 0);
                b1 = __builtin_amdgcn_mfma_f32_32x32x16_bf16(fb1, qf[ks], ks == 0 ? negm : b1, 0, 0, 0);
            }
        }
        float mx = fmaxf(a0[0], a1[0]), my = fmaxf(b0[0], b1[0]);
#pragma unroll
        for (int i = 1; i < 16; ++i) { mx = fmaxf(fmaxf(mx, a0[i]), a1[i]); my = fmaxf(fmaxf(my, b0[i]), b1[i]); }
        mx = fmaxf(mx, my);
        mx = fmaxf(mx, __shfl_xor(mx, 32));
        const bool grow = mx > THR, init = (lsum == 0.f) && (mx < -THR) && (mx > -1e30f);
        if (__any(grow || init)) {
            const float d = (grow || init) ? mx : 0.f;
            const float alpha = init ? 1.f : __builtin_amdgcn_exp2f(-d);
            m += d; lsum *= alpha;
#pragma unroll
            for (int i = 0; i < 16; ++i) { o0[i] *= alpha; o1[i] *= alpha; a0[i] -= d; a1[i] -= d; b0[i] -= d; b1[i] -= d; negm[i] -= d; }
            asm volatile("" : "+v"(negm));
        }
        f32x2v ps2 = {0.f, 0.f}, pt2 = {0.f, 0.f};
#pragma unroll
        for (int i = 0; i < 8; ++i) {
            a0[2 * i] = __builtin_amdgcn_exp2f(a0[2 * i]); a0[2 * i + 1] = __builtin_amdgcn_exp2f(a0[2 * i + 1]);
            a1[2 * i] = __builtin_amdgcn_exp2f(a1[2 * i]); a1[2 * i + 1] = __builtin_amdgcn_exp2f(a1[2 * i + 1]);
            const f32x2v x = {a0[2 * i], a0[2 * i + 1]}, y = {a1[2 * i], a1[2 * i + 1]}; ps2 += x; ps2 += y;
        }
#pragma unroll
        for (int st = 0; st < 2; ++st) {
            const bf16x8 p0 = pack8(a0, st), p1 = pack8(a1, st);
            const bf16x8 v00 = *(const __attribute__((address_space(3))) bf16x8*)(ba + vx[st]), v01 = *(const __attribute__((address_space(3))) bf16x8*)(ba + vx[st] + 32 * 128);
            const bf16x8 v10 = *(const __attribute__((address_space(3))) bf16x8*)(ba + vx[2 + st]), v11 = *(const __attribute__((address_space(3))) bf16x8*)(ba + vx[2 + st] + 32 * 128);
            o0 = __builtin_amdgcn_mfma_f32_32x32x16_bf16(v00, p0, o0, 0, 0, 0);
            o1 = __builtin_amdgcn_mfma_f32_32x32x16_bf16(v01, p0, o1, 0, 0, 0);
            o0 = __builtin_amdgcn_mfma_f32_32x32x16_bf16(v10, p1, o0, 0, 0, 0);
            o1 = __builtin_amdgcn_mfma_f32_32x32x16_bf16(v11, p1, o1, 0, 0, 0);
        }
#pragma unroll
        for (int i = 0; i < 8; ++i) {
            b0[2 * i] = __builtin_amdgcn_exp2f(b0[2 * i]); b0[2 * i + 1] = __builtin_amdgcn_exp2f(b0[2 * i + 1]);
            b1[2 * i] = __builtin_amdgcn_exp2f(b1[2 * i]); b1[2 * i + 1] = __builtin_amdgcn_exp2f(b1[2 * i + 1]);
            const f32x2v x = {b0[2 * i], b0[2 * i + 1]}, y = {b1[2 * i], b1[2 * i + 1]}; pt2 += x; pt2 += y;
        }
        lsum += (ps2.x + ps2.y) + (pt2.x + pt2.y);
#pragma unroll
        for (int st = 0; st < 2; ++st) {
            const bf16x8 p0 = pack8(b0, st), p1 = pack8(b1, st);
            const bf16x8 v00 = *(const __attribute__((address_space(3))) bf16x8*)(bb + vx[st]), v01 = *(const __attribute__((address_space(3))) bf16x8*)(bb + vx[st] + 32 * 128);
            const bf16x8 v10 = *(const __attribute__((address_space(3))) bf16x8*)(bb + vx[2 + st]), v11 = *(const __attribute__((address_space(3))) bf16x8*)(bb + vx[2 + st] + 32 * 128);
            o0 = __builtin_amdgcn_mfma_f32_32x32x16_bf16(v00, p0, o0, 0, 0, 0);
            o1 = __builtin_amdgcn_mfma_f32_32x32x16_bf16(v01, p0, o1, 0, 0, 0);
            o0 = __builtin_amdgcn_mfma_f32_32x32x16_bf16(v10, p1, o0, 0, 0, 0);
            o1 = __builtin_amdgcn_mfma_f32_32x32x16_bf16(v11, p1, o1, 0, 0, 0);
        }
    };
    issue(0, 0);
    for (int si = 0; si < nstep; si += 2) {
        step(si, 0);
        if (si + 1 < nstep) step(si + 1, 1);
    }
#undef AT_DMA
    float l = lsum + __shfl_xor(lsum, 32);
    if (U.has_sink) l += __builtin_amdgcn_exp2f(U.sink2 - m);
    const float inv = 1.f / l;
    bf16_t* op = U.O + (unsigned)(U.qrow0 + r) * D + 4 * h;
#pragma unroll
    for (int g = 0; g < 4; ++g) {
        pg8::st_bf16x4(op + 8 * g, o0[4 * g] * inv, o0[4 * g + 1] * inv, o0[4 * g + 2] * inv, o0[4 * g + 3] * inv);
        pg8::st_bf16x4(op + 32 + 8 * g, o1[4 * g] * inv, o1[4 * g + 1] * inv, o1[4 * g + 2] * inv, o1[4 * g + 3] * inv);
    }
    __syncthreads();
}
}

struct ConvDesc { const float* src; size_t ldn; unsigned short* dst; size_t ldd; int mode; };
__device__ __forceinline__ void conv_issue(const ConvDesc& d, float4 (&v)[4]) {
    const int tid = opaque_tid();
    const int rq = tid & 7, kk0 = tid >> 3;
    const int cq = d.mode == 1 ? (16 * (rq & 1) + 4 * (rq >> 1)) : rq * 4;
#pragma unroll
    for (int i = 0; i < 4; ++i) v[i] = d.mode == 2 ? make_float4(0.f, 0.f, 0.f, 0.f) : *(const float4*)(d.src + (size_t)(kk0 + 64 * i) * d.ldn + cq);
}
__device__ __forceinline__ void conv_finish(const ConvDesc& d, const float4 (&v)[4], float* t  ) {
    const int tid = opaque_tid();
    {
        const int rq = tid & 7, kk0 = tid >> 3;
        __syncthreads();
#pragma unroll
        for (int i = 0; i < 4; ++i) { float* p = t + (kk0 + 64 * i) * 33 + rq * 4; p[0] = v[i].x; p[1] = v[i].y; p[2] = v[i].z; p[3] = v[i].w; }
    }
    __syncthreads();
    {
        const int rr = tid >> 4, kq = tid & 15;
#pragma unroll
        for (int i = 0; i < 2; ++i) {
            const int k = i * 128 + kq * 8;
            float f[8];
#pragma unroll
            for (int j = 0; j < 8; ++j) f[j] = t[(k + j) * 33 + rr];
            pg8::u32x4 w; w.x = pg8::cvt_pk_bf16(f[0], f[1]); w.y = pg8::cvt_pk_bf16(f[2], f[3]); w.z = pg8::cvt_pk_bf16(f[4], f[5]); w.w = pg8::cvt_pk_bf16(f[6], f[7]);
            *(pg8::u32x4*)(d.dst + (size_t)rr * d.ldd + k) = w;
        }
    }
}
__device__ __forceinline__ ConvDesc conv_item(const float* src, size_t ldn, unsigned short* dst, size_t ldd, int mode = 0) {
    ConvDesc d; d.src = src; d.ldn = ldn; d.dst = dst; d.ldd = ldd; d.mode = mode; return d;
}
constexpr int FFN_CONV_ITEMS = 896 + 448;
__device__ __forceinline__ ConvDesc conv_ffn_item(int it, const float* w1, const float* w3, const float* w2, unsigned short* w13t, unsigned short* w2t) {
    if (it < 896) {
        const int rb = it >> 2, kb = it & 3, R0 = rb * 32, pn = R0 >> 8, cc = R0 & 255;
        const float* src = (cc < 128 ? w1 : w3) + (size_t)(kb * 256) * DFF + pn * 128 + (cc & 127);
        return conv_item(src, DFF, w13t + (size_t)R0 * D + kb * 256, D);
    } else {
        const int it2 = it - 896, rb = it2 / 14, kb = it2 % 14;
        return conv_item(w2 + (size_t)(kb * 256) * D + rb * 32, D, w2t + (size_t)(rb * 32) * DFF + kb * 256, DFF);
    }
}
__device__ __forceinline__ ConvDesc conv_win_item(const Ctx C, int l, int r) {
    const int rb = r >> 2, kb = r & 3, R0 = rb * 32, pc = R0 >> 8, cc = R0 & 255, wc = (cc >> 5) & 3, bj = cc >> 7;
    int col0, mode = 0;
    if (pc <= 4) col0 = (pc == 0 ? P_AQ : pc == 1 ? P_AK : pc == 2 ? P_AV : pc == 3 ? P_BQ : P_CQ) + 64 * wc + 32 * bj;
    else if (pc == 5) col0 = (wc < 2 ? P_BK + 64 * wc : P_CK + 64 * (wc - 2)) + 32 * bj;
    else if (pc == 6) col0 = (wc < 2 ? P_BV + 64 * wc : P_CV + 64 * (wc - 2)) + 32 * bj;
    else if (pc == 7) col0 = P_DQA + cc;
    else if (pc == 8) { if (cc < 128) col0 = P_DKVA + cc; else if (cc == 128) { col0 = P_DKVA + 128; mode = 1; } else { col0 = 0; mode = 2; } }
    else col0 = P_GATE + (pc - 9) * 256 + cc;
    return conv_item(C.w_in() + ((size_t)l * D + kb * 256) * INW + col0, INW, C.WIN() + ((size_t)l * INWP + R0) * D + kb * 256, D, mode);
}
__device__ __forceinline__ ConvDesc conv_brout_item(const Ctx C, int l, int r) {
    if (r < 128) { const int nb = (r >> 5) & 3, rb = r & 31;
        return conv_item(C.w_branch() + ((size_t)(l * 4 + nb) * 256) * D + rb * 32, D, C.WBR() + ((size_t)l * D + rb * 32) * D + nb * 256, D); }
    else { const int q = r - 128, rb = (q >> 2) & 31, kb = q & 3;
        return conv_item(C.w_out() + ((size_t)l * D + kb * 256) * D + rb * 32, D, C.WOUT() + ((size_t)l * D + rb * 32) * D + kb * 256, D); }
}
__device__ __forceinline__ ConvDesc conv_dense_item(const Ctx C, int l2, int r) {
    return conv_ffn_item(r, C.ffn_w1() + (size_t)l2 * D * DFF, C.ffn_w3() + (size_t)l2 * D * DFF, C.ffn_w2() + (size_t)l2 * DFF * D, C.W13D() + (size_t)l2 * 2 * DFF * D, C.W2D() + (size_t)l2 * D * DFF);
}
__device__ __forceinline__ ConvDesc conv_moe_item(const Ctx C, int l2, int it) {
    const int e = it / FFN_CONV_ITEMS, r = it % FFN_CONV_ITEMS; const size_t le = (size_t)l2 * NE + e;
    return conv_ffn_item(r, C.moe_w1() + le * D * DFF, C.moe_w3() + le * D * DFF, C.moe_w2() + le * DFF * D, C.W13M() + (size_t)e * 2 * DFF * D, C.W2M() + (size_t)e * D * DFF);
}
constexpr int MOE_CONV_ITEMS = NE * FFN_CONV_ITEMS;
constexpr int BG_J0 = 0, BG_J1 = BG_J0 + FFN_CONV_ITEMS  , BG_J2 = BG_J1 + 800  , BG_J3 = BG_J2 + 256  , BG_J4 = BG_J3 + MOE_CONV_ITEMS  ,
              BG_J5 = BG_J4 + 800  , BG_J6 = BG_J5 + 256  , BG_J7 = BG_J6 + FFN_CONV_ITEMS  , BG_J8 = BG_J7 + 800  ,
              BG_J9 = BG_J8 + 256  , BG_END = BG_J9 + MOE_CONV_ITEMS  ;
__device__ __forceinline__ ConvDesc bg_item(const Ctx C, int g) {
    if (g < BG_J1) return conv_dense_item(C, 0, g - BG_J0);
    if (g < BG_J2) return conv_win_item(C, 1, g - BG_J1);
    if (g < BG_J3) return conv_brout_item(C, 1, g - BG_J2);
    if (g < BG_J4) return conv_moe_item(C, 0, g - BG_J3);
    if (g < BG_J5) return conv_win_item(C, 2, g - BG_J4);
    if (g < BG_J6) return conv_brout_item(C, 2, g - BG_J5);
    if (g < BG_J7) return conv_dense_item(C, 1, g - BG_J6);
    if (g < BG_J8) return conv_win_item(C, 3, g - BG_J7);
    if (g < BG_J9) return conv_brout_item(C, 3, g - BG_J8);
    return conv_moe_item(C, 1, g - BG_J9);
}
__device__ __forceinline__ void bg_run(const Ctx C, int first, int limit, int per_wg, int rank, int nwg) {
    const int g0 = first + rank;
    if (per_wg > 0 && g0 < limit) {
        ConvDesc d0, d1; float4 v0[4], v1[4];
        d0 = bg_item(C, g0); conv_issue(d0, v0);
        for (int j = 0; j < per_wg; ++j) {
            const int gn = first + rank + (j + 1) * nwg; const bool hn = (j + 1 < per_wg) && (gn < limit);
            if (hn) { d1 = bg_item(C, gn); conv_issue(d1, v1); }
            conv_finish(d0, v0, C.lds);
            if (!hn) break;
            d0 = d1;
#pragma unroll
            for (int i = 0; i < 4; ++i) v0[i] = v1[i];
        }
    }
    __syncthreads();
}
constexpr int BGW_IN = 248 * 11, BGW_MLA = 224 * 7, BGW_BR = 224 * 18, BGW_LAYER = BGW_IN + BGW_MLA + BGW_BR;
static_assert(BGW_LAYER + BGW_IN + BGW_MLA + BGW_BR >= BG_J9 && BGW_LAYER + BGW_IN + BGW_MLA <= BG_J9, "layer 1's windows must end exactly at the start of MoE layer 3's items");
__device__ __forceinline__ int bg_layer_base(int l) { return l == 0 ? 0 : (l == 1 ? BGW_LAYER : (l == 2 ? BG_J9 : BG_J9 + BGW_LAYER)); }
static_assert(BG_J9 + BGW_LAYER + 120 * 11 + BGW_MLA >= BG_END, "the background list must be finished by the end of layer 3's MLA phase");

__device__ __forceinline__ void conv_prologue(const Ctx C) {
    const int tidx_ = opaque_tid();
    {
        auto desc = [&](int it, ConvDesc& d) { if (it < 800) d = conv_win_item(C, 0, it); else d = conv_brout_item(C, 0, it - 800); };
        int it = blockIdx.x;
        if (it < 800 + 256) {
            ConvDesc d0, d1; float4 v0[4], v1[4];
            desc(it, d0); conv_issue(d0, v0);
            for (;;) {
                const int itn = it + (int)gridDim.x; const bool hn = itn < 800 + 256;
                if (hn) { desc(itn, d1); conv_issue(d1, v1); }
                conv_finish(d0, v0, C.lds);
                if (!hn) break;
                d0 = d1; it = itn;
#pragma unroll
                for (int i = 0; i < 4; ++i) v0[i] = v1[i];
            }
        }
    }
    __syncthreads();
    for (int it = (int)blockIdx.x - (int)(gridDim.x / 2); it >= 0 && it < DEPTH * 32; it += (int)gridDim.x) {
        const int l = it >> 5, rb = it & 31;
        float* t = C.lds;
        {
            const int tc = tidx_ & 31, tr = tidx_ >> 5, R = rb * 32 + tc;
            const int pc = R >> 8, cc = R & 255, bj = cc >> 7, wc = (cc >> 5) & 3, sl = cc & 31;
            const bool qpart = pc < 2;
            int col = -1;
            if (pc == 0) col = wc * 96 + 32 * bj + sl;
            else if (pc == 1) { if (bj == 0) col = wc * 96 + 64 + 16 * ((sl >> 2) & 1) + 4 * (sl >> 3) + (sl & 3); }
            else if (pc == 2) col = wc * 128 + 32 * bj + sl;
            else col = wc * 128 + 64 + 32 * bj + sl;
            const float* wsrc = qpart ? C.mla_wqb() + (size_t)l * 256 * 384 : C.mla_wkvb() + (size_t)l * 128 * 512;
            const float* gsrc = qpart ? C.mla_qnorm() + l * 256 : C.mla_kvnorm() + l * 128;
            const int wst = qpart ? 384 : 512, kb = qpart ? 0 : 256, zb = qpart ? 256 : 0, nz = qpart ? 8 : 16;
            const int cl = col < 0 ? 0 : col;
            float wv[16], gv[16];
            if (qpart) {
#pragma unroll
                for (int j = 0; j < 16; ++j) { wv[j] = wsrc[(size_t)(tr + 16 * j) * wst + cl]; gv[j] = gsrc[tr + 16 * j]; }
#pragma unroll
                for (int j = 0; j < 16; ++j) t[(kb + tr + 16 * j) * 33 + tc] = col < 0 ? 0.f : wv[j] * gv[j];
            } else {
#pragma unroll
                for (int j = 0; j < 8; ++j) { wv[j] = wsrc[(size_t)(tr + 16 * j) * wst + cl]; gv[j] = gsrc[tr + 16 * j]; }
#pragma unroll
                for (int j = 0; j < 8; ++j) t[(kb + tr + 16 * j) * 33 + tc] = wv[j] * gv[j];
            }
            for (int j = 0; j < nz; ++j) t[(zb + tr + 16 * j) * 33 + tc] = 0.f;
        }
        __syncthreads();
        {
            const int rr = tidx_ >> 4, kq = tidx_ & 15;
#pragma unroll
            for (int j = 0; j < 3; ++j) {
                const int k = (j * 16 + kq) * 8;
                float f[8];
#pragma unroll
                for (int q = 0; q < 8; ++q) f[q] = t[(k + q) * 33 + rr];
                pg8::u32x4 w; w.x = pg8::cvt_pk_bf16(f[0], f[1]); w.y = pg8::cvt_pk_bf16(f[2], f[3]); w.z = pg8::cvt_pk_bf16(f[4], f[5]); w.w = pg8::cvt_pk_bf16(f[6], f[7]);
                *(pg8::u32x4*)(C.WMLA() + ((size_t)l * 1024 + rb * 32 + rr) * 384 + k) = w;
            }
        }
        __syncthreads();
    }
}
__device__ __forceinline__ void ph_prologue(const Ctx C) {
    const int tidx_ = opaque_tid();
    const int lane = tidx_ & 63, wave = tidx_ >> 6;
    {
        float* sc = C.lds;
        float* part = C.lds + 9 * D;
        for (int i = tidx_; i < 9 * D; i += NTHREADS) { const int r = i >> 10, d = i & (D - 1); sc[i] = siluf(r < 8 ? C.c()[r * D + d] : C.c_ctx()[d]); }
        __syncthreads();
        for (int it = blockIdx.x; it < DEPTH * (ADAW / 64); it += gridDim.x) {
            const int l = it / (ADAW / 64), e = (it % (ADAW / 64)) * 64 + lane;
            float acc[9];
#pragma unroll
            for (int r = 0; r < 9; ++r) acc[r] = 0.f;
            const float* w = C.w_ada() + ((size_t)l * D + wave * 128) * ADAW + e;
            for (int d0 = 0; d0 < 128; d0 += 8) {
                float wv[8];
#pragma unroll
                for (int q = 0; q < 8; ++q) wv[q] = w[(size_t)(d0 + q) * ADAW];
#pragma unroll
                for (int r = 0; r < 9; ++r) {
                    const float4 s0 = *(const float4*)(sc + r * D + wave * 128 + d0), s1 = *(const float4*)(sc + r * D + wave * 128 + d0 + 4);
                    acc[r] = fmaf(s0.x, wv[0], acc[r]); acc[r] = fmaf(s0.y, wv[1], acc[r]); acc[r] = fmaf(s0.z, wv[2], acc[r]); acc[r] = fmaf(s0.w, wv[3], acc[r]);
                    acc[r] = fmaf(s1.x, wv[4], acc[r]); acc[r] = fmaf(s1.y, wv[5], acc[r]); acc[r] = fmaf(s1.z, wv[6], acc[r]); acc[r] = fmaf(s1.w, wv[7], acc[r]);
                }
            }
#pragma unroll
            for (int r = 0; r < 9; ++r) part[(wave * 9 + r) * 64 + lane] = acc[r];
            __syncthreads();
            for (int i = tidx_; i < 9 * 64; i += NTHREADS) {
                float t = 0.f;
#pragma unroll
                for (int w8 = 0; w8 < 8; ++w8) t += part[w8 * 576 + i];
                const int r = i >> 6, ee = (it % (ADAW / 64)) * 64 + (i & 63);
                C.MOD()[((size_t)l * 9 + r) * ADAW + ee] = t + C.b_ada()[l * ADAW + ee];
            }
            __syncthreads();
        }
    }
    for (int i = blockIdx.x * NTHREADS + tidx_; i < SEQ * 32; i += gridDim.x * NTHREADS) {
        const int t = i >> 5, j = i & 31;
        const int pos = j < 16 ? (t / GW) : (t % GW);
        const float inv = powf(10000.f, -(float)(j & 15) / 16.f);
        const float ang = (float)pos * inv;
        C.ROPE()[t * 32 + j] = cosf(ang); C.ROPE()[SEQ * 32 + t * 32 + j] = sinf(ang);
        if (j < 16) {
            const int pos2 = j < 8 ? (t / GW) : (t % GW);
            const float inv2 = powf(10000.f, -(float)(j & 7) / 8.f);
            const float a2 = (float)pos2 * inv2;
            C.ROPE()[SEQ * 64 + t * 16 + j] = cosf(a2); C.ROPE()[SEQ * 64 + SEQ * 16 + t * 16 + j] = sinf(a2);
        }
    }
}

__device__ __forceinline__ int block_row(int b, int i, int nrows) { return (nrows == MT && i >= 64) ? ML + b * 8 + (i - 64) : b * 64 + i; }
__device__ __forceinline__ void ph_norm(const Ctx C, int l, int mode) {
    const int tidx_ = opaque_tid();
    const int lane = tidx_ & 63, wave = tidx_ >> 6;
#define CB(i) ((((i) >> 1) << 9) + lane * 8 + (((i) & 1) << 2))
    const bool moe_prev = (mode == 0 && l > 0 && ((l - 1) & 1)) || mode == 2;
    const int lp = (mode == 2) ? DEPTH - 1 : l - 1;
    const int nrows = (mode == 2) ? ML : ((mode == 1 && l == DEPTH - 1) ? ML : MT);
    const bool route = (mode == 1) && (l & 1);
    int* hist = (int*)C.lds;
    float* const Rl = C.lds + 64;
    if (route) {
        if (tidx_ < NE) hist[tidx_] = 0;
        const float* R = C.moe_router() + (size_t)(l >> 1) * D * NE;
        for (int q = tidx_; q < D * 2; q += NTHREADS) { const int d = q >> 1; *(float4*)(Rl + d * 8 + (d >> 3) * 4 + (q & 1) * 4) = *(const float4*)(R + q * 4); }
        __syncthreads();
    }
    const int rows_per_block = nrows / gridDim.x;
    const bool src_f32 = (mode == 0 && l == 0);
    auto ldrow = [&](int row, float4 (&dst)[4]) {
        if (src_f32) {
            const float* s0 = row < ML ? C.x() + (size_t)row * D : C.ctx() + (size_t)(row - ML) * D;
#pragma unroll
            for (int i = 0; i < 4; ++i) dst[i] = *(const float4*)(s0 + CB(i));
        } else {
            const unsigned short* s0 = C.X() + (size_t)row * D;
#pragma unroll
            for (int i = 0; i < 4; i += 2) { const uint4 t = *(const uint4*)(s0 + CB(i)); dst[i].x = __uint_as_float(t.x); dst[i].y = __uint_as_float(t.y); dst[i + 1].x = __uint_as_float(t.z); dst[i + 1].y = __uint_as_float(t.w); }
        }
    };
    float4 hA0, hA1, hA2, hA3, hB0, hB1, hB2, hB3;
    {
        const float* gn0 = mode == 2 ? C.final_g() : (mode == 0 ? C.norm1_g() : C.norm2_g()) + l * D;
        const float* md0 = C.MOD() + ((size_t)l * 9 + (blockIdx.x >> 5)) * ADAW + (mode == 0 ? 0 : 3 * D);
        auto ld = [&](int i, float4& a, float4& b) {
            const float4 g = *(const float4*)(gn0 + CB(i));
            float4 sh = make_float4(0.f, 0.f, 0.f, 0.f), sc = sh;
            if (mode != 2) { sh = *(const float4*)(md0 + CB(i)); sc = *(const float4*)(md0 + D + CB(i)); }
            a = make_float4(g.x * (1.f + sc.x), g.y * (1.f + sc.y), g.z * (1.f + sc.z), g.w * (1.f + sc.w)); b = sh;
        };
        ld(0, hA0, hB0); ld(1, hA1, hB1); ld(2, hA2, hB2); ld(3, hA3, hB3);
    }
    float4 gM0 = make_float4(0.f, 0.f, 0.f, 0.f), gM1 = gM0, gM2 = gM0, gM3 = gM0;
    if (moe_prev) { const float* g2 = C.MOD() + ((size_t)lp * 9 + (blockIdx.x >> 5)) * ADAW + 5 * D; gM0 = *(const float4*)(g2 + CB(0)); gM1 = *(const float4*)(g2 + CB(1)); gM2 = *(const float4*)(g2 + CB(2)); gM3 = *(const float4*)(g2 + CB(3)); }
    float4 vn[4], vm[4];
#pragma unroll
    for (int i = 0; i < 4; ++i) { vn[i] = make_float4(0.f, 0.f, 0.f, 0.f); vm[i] = vn[i]; }
    if (wave < rows_per_block) ldrow(block_row(blockIdx.x, wave, nrows), vn);
    if (wave + NWAVES < rows_per_block) ldrow(block_row(blockIdx.x, wave + NWAVES, nrows), vm);
    int ps0 = 0, ps1 = 0; float pw0 = 0.f, pw1 = 0.f;
    if (moe_prev && wave < rows_per_block) { const int r0_ = block_row(blockIdx.x, wave, nrows); ps0 = C.SLOT()[r0_ * 2]; ps1 = C.SLOT()[r0_ * 2 + 1]; pw0 = C.TOPW()[r0_ * 2]; pw1 = C.TOPW()[r0_ * 2 + 1]; }
    for (int ri = wave; ri < rows_per_block; ri += NWAVES) {
        const int row = block_row(blockIdx.x, ri, nrows);
        const int mr = modrow(row);
        const int s0 = ps0, s1 = ps1; const float w0 = pw0, w1 = pw1;
        uint4 yr0[2] = {make_uint4(0, 0, 0, 0), make_uint4(0, 0, 0, 0)}, yr1[2] = {make_uint4(0, 0, 0, 0), make_uint4(0, 0, 0, 0)};
        if (moe_prev) {
#pragma unroll
            for (int q = 0; q < 2; ++q) { yr0[q] = *(const uint4*)(C.Y() + (size_t)s0 * D + CB(2 * q)); yr1[q] = *(const uint4*)(C.Y() + (size_t)s1 * D + CB(2 * q)); }
            if (ri + NWAVES < rows_per_block) { const int rn = block_row(blockIdx.x, ri + NWAVES, nrows); ps0 = C.SLOT()[rn * 2]; ps1 = C.SLOT()[rn * 2 + 1]; pw0 = C.TOPW()[rn * 2]; pw1 = C.TOPW()[rn * 2 + 1]; }
        }
        float4 v[4];
#pragma unroll
        for (int i = 0; i < 4; ++i) {
            if (src_f32) v[i] = vn[i];
            else { const unsigned a = __float_as_uint(vn[i].x), b = __float_as_uint(vn[i].y); v[i] = make_float4(__uint_as_float(a << 16), __uint_as_float(a & 0xffff0000u), __uint_as_float(b << 16), __uint_as_float(b & 0xffff0000u)); }
            vn[i] = vm[i];
        }
        if (ri + 2 * NWAVES < rows_per_block) ldrow(block_row(blockIdx.x, ri + 2 * NWAVES, nrows), vm);
        bool wr_x = (mode == 0 && l == 0);
        {
            const int np = (mode == 1 && l < DEPTH - 1) ? 4 : ((mode == 0 && l > 0 && !((l - 1) & 1)) ? 7 : 0);
            if (np && row >= ML) {
                const float* gt = (mode == 1) ? C.MOD() + ((size_t)l * 9 + 8) * ADAW + 2 * D : C.MOD() + ((size_t)(l - 1) * 9 + 8) * ADAW + 5 * D;
                const unsigned short* pb = C.PART() + (size_t)(row - ML) * D;
                float4 g4[4], sm[4];
#pragma unroll
                for (int i = 0; i < 4; ++i) { g4[i] = *(const float4*)(gt + CB(i)); sm[i] = make_float4(0.f, 0.f, 0.f, 0.f); }
                auto addp = [&](const uint4 t, int q) {
                    sm[2 * q].x += __uint_as_float(t.x << 16); sm[2 * q].y += __uint_as_float(t.x & 0xffff0000u); sm[2 * q].z += __uint_as_float(t.y << 16); sm[2 * q].w += __uint_as_float(t.y & 0xffff0000u);
                    sm[2 * q + 1].x += __uint_as_float(t.z << 16); sm[2 * q + 1].y += __uint_as_float(t.z & 0xffff0000u); sm[2 * q + 1].z += __uint_as_float(t.w << 16); sm[2 * q + 1].w += __uint_as_float(t.w & 0xffff0000u);
                };
                if (np == 4) {
                    uint4 t[4][2];
#pragma unroll
                    for (int p = 0; p < 4; ++p) { t[p][0] = *(const uint4*)(pb + (size_t)p * MC * D + CB(0)); t[p][1] = *(const uint4*)(pb + (size_t)p * MC * D + CB(2)); }
#pragma unroll
                    for (int p = 0; p < 4; ++p) { addp(t[p][0], 0); addp(t[p][1], 1); }
                } else {
                    uint4 t[7][2];
#pragma unroll
                    for (int p = 0; p < 7; ++p) { t[p][0] = *(const uint4*)(pb + (size_t)p * MC * D + CB(0)); t[p][1] = *(const uint4*)(pb + (size_t)p * MC * D + CB(2)); }
#pragma unroll
                    for (int p = 0; p < 7; ++p) { addp(t[p][0], 0); addp(t[p][1], 1); }
                }
#pragma unroll
                for (int i = 0; i < 4; ++i) { v[i].x += g4[i].x * sm[i].x; v[i].y += g4[i].y * sm[i].y; v[i].z += g4[i].z * sm[i].z; v[i].w += g4[i].w * sm[i].w; }
                wr_x = true;
            }
        }
        if (moe_prev && (row < ML || lp != DEPTH - 1)) {
            auto unp = [&](const uint4 t, float4& a, float4& b) {
                a = make_float4(__uint_as_float(t.x << 16), __uint_as_float(t.x & 0xffff0000u), __uint_as_float(t.y << 16), __uint_as_float(t.y & 0xffff0000u));
                b = make_float4(__uint_as_float(t.z << 16), __uint_as_float(t.z & 0xffff0000u), __uint_as_float(t.w << 16), __uint_as_float(t.w & 0xffff0000u));
            };
#pragma unroll
            for (int i = 0; i < 4; i += 2) {
                float4 y0a, y0b, y1a, y1b; unp(yr0[i >> 1], y0a, y0b); unp(yr1[i >> 1], y1a, y1b);
                if (s0 >= YSPLIT_P0 * 256) { float4 ta, tb; unp(*(const uint4*)(C.Y2() + (size_t)(s0 - YSPLIT_P0 * 256) * D + CB(i)), ta, tb); y0a.x += ta.x; y0a.y += ta.y; y0a.z += ta.z; y0a.w += ta.w; y0b.x += tb.x; y0b.y += tb.y; y0b.z += tb.z; y0b.w += tb.w; }
                if (s1 >= YSPLIT_P0 * 256) { float4 ta, tb; unp(*(const uint4*)(C.Y2() + (size_t)(s1 - YSPLIT_P0 * 256) * D + CB(i)), ta, tb); y1a.x += ta.x; y1a.y += ta.y; y1a.z += ta.z; y1a.w += ta.w; y1b.x += tb.x; y1b.y += tb.y; y1b.z += tb.z; y1b.w += tb.w; }
                float4 ga = i == 0 ? gM0 : gM2, gb = i == 0 ? gM1 : gM3;
                if (row >= ML) { const float* g2 = C.MOD() + ((size_t)lp * 9 + 8) * ADAW + 5 * D; ga = *(const float4*)(g2 + CB(i)); gb = *(const float4*)(g2 + CB(i + 1)); }
                v[i].x += ga.x * (w0 * y0a.x + w1 * y1a.x); v[i].y += ga.y * (w0 * y0a.y + w1 * y1a.y);
                v[i].z += ga.z * (w0 * y0a.z + w1 * y1a.z); v[i].w += ga.w * (w0 * y0a.w + w1 * y1a.w);
                v[i + 1].x += gb.x * (w0 * y0b.x + w1 * y1b.x); v[i + 1].y += gb.y * (w0 * y0b.y + w1 * y1b.y);
                v[i + 1].z += gb.z * (w0 * y0b.z + w1 * y1b.z); v[i + 1].w += gb.w * (w0 * y0b.w + w1 * y1b.w);
            }
            wr_x = true;
        }
        if (wr_x && mode != 2) {
#pragma unroll
            for (int i = 0; i < 4; i += 2) { pg8::u32x4 w; w.x = pg8::cvt_pk_bf16(v[i].x, v[i].y); w.y = pg8::cvt_pk_bf16(v[i].z, v[i].w); w.z = pg8::cvt_pk_bf16(v[i + 1].x, v[i + 1].y); w.w = pg8::cvt_pk_bf16(v[i + 1].z, v[i + 1].w); *(pg8::u32x4*)(C.X() + (size_t)row * D + CB(i)) = w; }
        }
        float ss = 0.f;
#pragma unroll
        for (int i = 0; i < 4; ++i) ss += v[i].x * v[i].x + v[i].y * v[i].y + v[i].z * v[i].z + v[i].w * v[i].w;
        ss = wave_sum(ss);
        const float rs = rsqrtf(ss * (1.0f / D) + EPS);
        float4 a0 = hA0, a1 = hA1, a2 = hA2, a3 = hA3, b0 = hB0, b1 = hB1, b2 = hB2, b3 = hB3;
        if (mode != 2 && row >= ML) {
            const float* gn = (mode == 0 ? C.norm1_g() : C.norm2_g()) + l * D;
            const float* md = C.MOD() + ((size_t)l * 9 + 8) * ADAW + (mode == 0 ? 0 : 3 * D);
            float4 cg[4], csc[4];
#pragma unroll
            for (int i = 0; i < 4; ++i) { cg[i] = *(const float4*)(gn + CB(i)); csc[i] = *(const float4*)(md + D + CB(i)); }
            b0 = *(const float4*)(md + CB(0)); b1 = *(const float4*)(md + CB(1)); b2 = *(const float4*)(md + CB(2)); b3 = *(const float4*)(md + CB(3));
            auto mk = [&](int i) { return make_float4(cg[i].x * (1.f + csc[i].x), cg[i].y * (1.f + csc[i].y), cg[i].z * (1.f + csc[i].z), cg[i].w * (1.f + csc[i].w)); };
            a0 = mk(0); a1 = mk(1); a2 = mk(2); a3 = mk(3);
        }
        float4 h[4];
#pragma unroll
        for (int i = 0; i < 4; ++i) {
            const float4 a = i == 0 ? a0 : i == 1 ? a1 : i == 2 ? a2 : a3, bsh = i == 0 ? b0 : i == 1 ? b1 : i == 2 ? b2 : b3;
            h[i].x = v[i].x * rs * a.x + bsh.x; h[i].y = v[i].y * rs * a.y + bsh.y;
            h[i].z = v[i].z * rs * a.z + bsh.z; h[i].w = v[i].w * rs * a.w + bsh.w;
            if (mode == 2) *(float4*)(C.out() + (size_t)row * D + CB(i)) = h[i];
            else { pg8::u32x2 w; w.x = pg8::cvt_pk_bf16(h[i].x, h[i].y); w.y = pg8::cvt_pk_bf16(h[i].z, h[i].w); *(pg8::u32x2*)(C.HB() + (size_t)row * D + CB(i)) = w; }
        }
        if (route) {
            float lg[NE];
#pragma unroll
            for (int e = 0; e < NE; ++e) lg[e] = 0.f;
#pragma unroll
            for (int i = 0; i < 4; ++i) {
                const float hv[4] = {h[i].x, h[i].y, h[i].z, h[i].w};
#pragma unroll
                for (int j = 0; j < 4; ++j) {
                    const int d = CB(i) + j;
                    const float4 ra = *(const float4*)(Rl + d * 8 + (d >> 3) * 4), rb = *(const float4*)(Rl + d * 8 + (d >> 3) * 4 + 4);
                    lg[0] = fmaf(hv[j], ra.x, lg[0]); lg[1] = fmaf(hv[j], ra.y, lg[1]); lg[2] = fmaf(hv[j], ra.z, lg[2]); lg[3] = fmaf(hv[j], ra.w, lg[3]);
                    lg[4] = fmaf(hv[j], rb.x, lg[4]); lg[5] = fmaf(hv[j], rb.y, lg[5]); lg[6] = fmaf(hv[j], rb.z, lg[6]); lg[7] = fmaf(hv[j], rb.w, lg[7]);
                }
            }
#pragma unroll
            for (int e = 0; e < NE; ++e) lg[e] = wave_sum(lg[e]);
            int e0 = 0; float v0 = lg[0];
#pragma unroll
            for (int e = 1; e < NE; ++e) if (lg[e] > v0) { v0 = lg[e]; e0 = e; }
            int e1 = -1; float v1 = -3.0e38f;
#pragma unroll
            for (int e = 0; e < NE; ++e) if (e != e0 && lg[e] > v1) { v1 = lg[e]; e1 = e; }
            const float p1 = expf(v1 - v0), w0 = 1.f / (1.f + p1), w1 = p1 / (1.f + p1);
            if (lane == 0) {
                C.TOPE()[row * 2] = e0; C.TOPE()[row * 2 + 1] = e1; C.TOPW()[row * 2] = w0; C.TOPW()[row * 2 + 1] = w1;
                atomicAdd(&hist[e0], 1); atomicAdd(&hist[e1], 1);
            }
        }
    }
    if (route) { __syncthreads(); if (tidx_ < NE) C.HIST()[blockIdx.x * NE + tidx_] = hist[tidx_]; __syncthreads(); }
}

#undef CB
__device__ __forceinline__ void ph_assign(const Ctx C, int l) {
    const int tidx_ = opaque_tid();
    const int tid = tidx_, lane = tid & 63, wave = tid >> 6;
    const int nrows = (l == DEPTH - 1) ? ML : MT;
    const int rpb = nrows / gridDim.x;
    int* sh = (int*)C.lds;
    int ev[3] = {-1, -1, -1};
    if (wave == 0) {
#pragma unroll
        for (int q = 0; q < 3; ++q) { const int idx = 64 * q + lane; if (idx < 2 * rpb) ev[q] = C.TOPE()[block_row(blockIdx.x, idx >> 1, nrows) * 2 + (idx & 1)]; }
    }
    {
        const int e = wave;
        int tot = 0, base = 0;
#pragma unroll
        for (int k = 0; k < 4; ++k) { const int b = lane + 64 * k; const int hh = (b < (int)gridDim.x) ? C.HIST()[b * NE + e] : 0; tot += hh; base += (b < (int)blockIdx.x) ? hh : 0; }
#pragma unroll
        for (int o = 1; o < 64; o <<= 1) { tot += __shfl_xor(tot, o); base += __shfl_xor(base, o); }
        if (lane == 0) { sh[e] = tot; sh[8 + e] = base; }
    }
    __syncthreads();
    if (tid == 0) { int sacc = 0; for (int e = 0; e < NE; ++e) { sh[16 + e] = sacc; sacc += (sh[e] + 255) / 256 * 256; } sh[24] = sacc; }
    __syncthreads();
    if (wave == 0) {
        int cur[NE];
#pragma unroll
        for (int e = 0; e < NE; ++e) cur[e] = sh[16 + e] + sh[8 + e];
#pragma unroll
        for (int q = 0; q < 3; ++q) {
            const int cb = 64 * q; if (cb >= 2 * rpb) break;
            const int idx = cb + lane; const bool valid = idx < 2 * rpb;
            const int erow = block_row(blockIdx.x, (valid ? idx : 0) >> 1, nrows);
            const int e = ev[q];
            int slot = 0;
#pragma unroll
            for (int ex = 0; ex < NE; ++ex) {
                const unsigned long long mask = __ballot(e == ex);
                const int rank = __popcll(mask & ((1ull << lane) - 1ull));
                if (e == ex) slot = cur[ex] + rank;
                cur[ex] += __popcll(mask);
            }
            if (valid) { C.SLOT()[erow * 2 + (idx & 1)] = slot; sh[64 + idx] = slot; }
        }
    }
    __syncthreads();
    for (int idx0 = wave; idx0 < 2 * rpb; idx0 += 6 * NWAVES) {
        const int last = 2 * rpb - 1;
#define AS_IDX(q) (idx0 + (q) * NWAVES > last ? idx0 : idx0 + (q) * NWAVES)
#define AS_SRC(q) ((const uint4*)(C.HB() + (size_t)block_row(blockIdx.x, AS_IDX(q) >> 1, nrows) * D))
#define AS_DST(q) ((uint4*)(C.AS() + (size_t)sh[64 + AS_IDX(q)] * D))
        const uint4 a0 = AS_SRC(0)[lane], a1 = AS_SRC(0)[lane + 64], b0 = AS_SRC(1)[lane], b1 = AS_SRC(1)[lane + 64], c0 = AS_SRC(2)[lane], c1 = AS_SRC(2)[lane + 64];
        const uint4 d0 = AS_SRC(3)[lane], d1 = AS_SRC(3)[lane + 64], e0 = AS_SRC(4)[lane], e1 = AS_SRC(4)[lane + 64], f0 = AS_SRC(5)[lane], f1 = AS_SRC(5)[lane + 64];
        AS_DST(0)[lane] = a0; AS_DST(0)[lane + 64] = a1; AS_DST(1)[lane] = b0; AS_DST(1)[lane + 64] = b1; AS_DST(2)[lane] = c0; AS_DST(2)[lane + 64] = c1;
        AS_DST(3)[lane] = d0; AS_DST(3)[lane + 64] = d1; AS_DST(4)[lane] = e0; AS_DST(4)[lane + 64] = e1; AS_DST(5)[lane] = f0; AS_DST(5)[lane + 64] = f1;
#undef AS_IDX
#undef AS_SRC
#undef AS_DST
    }
    for (int e = 0; e < NE; ++e) {
        const int beg = sh[16 + e] + sh[e], end = sh[16 + e + 1];
        for (int sl = beg + (int)blockIdx.x + wave * (int)gridDim.x; sl < end; sl += NWAVES * (int)gridDim.x) { uint4* dst = (uint4*)(C.AS() + (size_t)sl * D); dst[lane] = make_uint4(0, 0, 0, 0); dst[lane + 64] = make_uint4(0, 0, 0, 0); }
    }
    if (blockIdx.x == 0) {
        for (int e = 0; e < NE; ++e) for (int p = sh[16 + e] / 256 + tid; p < sh[16 + e + 1] / 256; p += NTHREADS) C.PEXP()[p] = e;
        if (tid == 0) C.PEXP()[MAXSLOT / 128] = sh[24] / 256;
    }
    __syncthreads();
}

__device__ __forceinline__ void ph_inproj(const Ctx C, int l) {
    PG8_LAS unsigned char* glds = (PG8_LAS unsigned char*)(C.ldsraw() + GEMM_LDS_OFF);
    pg8::Gemm g; g.A = C.HB(); g.Bt = C.WIN() + (size_t)l * INWP * D; g.K = D; g.lda = D; g.ldb = D;
    pg8::StaticOrder S; S.init(MT, INWP, gridDim.x, blockIdx.x);
    pg8::EpiInproj E; E.ws = C.a->ws; E.rope = C.ROPE(); E.gq = C.gb_qnorm() + l * 64; E.gk = C.gb_knorm() + l * 64;
    if (l == DEPTH - 1) { pg8::InprojLastOrder S2; S2.init(gridDim.x, blockIdx.x); pg8::gemm_phase<pg8::EpiInproj, pg8::InprojLastOrder, true, true>(glds, g, S2, E); }
    else pg8::gemm_phase<pg8::EpiInproj, pg8::StaticOrder, true, true>(glds, g, S, E);
    {
        const int c = blockIdx.x, base = bg_layer_base(l);
        if (l == DEPTH - 1) { if (c >= 136) bg_run(C, base, base + 120 * 11, 11, c - 136, 120); }
        else if (c >= 8) bg_run(C, base, base + BGW_IN, 11, c - 8, 248);
    }
}
__device__ __forceinline__ void ph_mla(const Ctx C, int l) {
    PG8_LAS unsigned char* glds = (PG8_LAS unsigned char*)(C.ldsraw() + GEMM_LDS_OFF);
    pg8::Gemm g; g.A = C.DA(); g.Bt = C.WMLA() + (size_t)l * 1024 * 384; g.K = 384; g.lda = 384; g.ldb = 384;
    pg8::StaticOrder S; S.init(MT, 1024, gridDim.x, blockIdx.x);
    pg8::EpiMla E; E.ws = C.a->ws; E.rope = C.ROPE();
    pg8::gemm_phase<pg8::EpiMla, pg8::StaticOrder, true, false>(glds, g, S, E);
    if (blockIdx.x >= 32) {
        const int base = bg_layer_base(l) + (l == DEPTH - 1 ? 120 * 11 : BGW_IN);
        bg_run(C, base, (l == DEPTH - 1) ? BG_END : base + BGW_MLA, 7, blockIdx.x - 32, 224);
    }
}

__device__ __forceinline__ void ph_attn(const Ctx C, int l) {
    const int tid = opaque_tid();
    const int wave = __builtin_amdgcn_readfirstlane(tid >> 6);
    unsigned char* lds = C.ldsraw() + GEMM_LDS_OFF;
    const int u = ((int)blockIdx.x & 7) * ((int)gridDim.x >> 3) + ((int)blockIdx.x >> 3);
    const bool has_ctx = (l < DEPTH - 1) && (u < 128);
    const int cb = u >> 4, cmx = (u >> 2) & 3, ch = u & 3, ckvh = ch >> 1;
    for (int pass = 0; pass < 2; ++pass) {
        if (pass == 1 && !(has_ctx && cmx < 3)) break;
        at::Unit U{}; U.Q2 = nullptr; U.ldq2 = 0; U.K2 = nullptr; U.ldq = 256;
        if (pass == 0) {
            const int b = u >> 5, kvh = (u >> 4) & 1, tb = u & 15, hq = 2 * kvh + (wave >> 2), t0 = tb * 128 + 32 * (wave & 3);
            U.Q = C.QB() + hq * 64; U.K = C.KB() + kvh * 64; U.ldk = 128; U.VT = C.VTB() + (size_t)(kvh * 64) * MT;
            U.O = C.O() + 256 + hq * 64; U.qrow0 = b * SEQ + t0; U.nloc = 32; U.ntile = 36; U.krow_loc0 = b * SEQ; U.krow_ctx0 = ML + b * CTX;
        } else {
            U.qrow0 = ML + cb * CTX + 32 * wave; U.nloc = 0; U.ntile = 4; U.krow_loc0 = 0; U.krow_ctx0 = ML + cb * CTX; U.O = C.O() + cmx * 256 + ch * 64;
            if (cmx == 0) { U.Q = C.QA() + ch * 64; U.K = C.KA() + ch * 64; U.ldk = 256; U.VT = C.VTA() + (size_t)(ch * 64) * MT; }
            else if (cmx == 1) { U.Q = C.QB() + ch * 64; U.K = C.KB() + ckvh * 64; U.ldk = 128; U.VT = C.VTB() + (size_t)(ckvh * 64) * MT; }
            else { U.Q = C.QC() + ch * 64; U.K = C.KC() + ckvh * 64; U.ldk = 128; U.VT = C.VTC() + (size_t)(ckvh * 64) * MT; U.sink2 = C.wc_sink()[l * 4 + ch] * at::LOG2E; U.has_sink = 1; }
        }
        at::attn_plain2<64>(lds, U, tid);
    }
    for (int pass = 0; pass < 2; ++pass) {
        if (pass == 1 && !(has_ctx && cmx == 3)) break;
        at::Unit U{}; U.ldq = 256; U.ldq2 = 128; U.ldk = 256; U.K2 = C.KPE();
        if (pass == 0) {
            const int b = u >> 5, h = (u >> 3) & 3, tb = u & 7, t0 = tb * 256 + 32 * wave;
            U.Q = C.QDN() + h * 64; U.Q2 = C.QDP() + h * 32; U.K = C.KDN() + h * 64; U.VT = C.VTD() + (size_t)(h * 64) * MT;
            U.O = C.O() + 768 + h * 64; U.qrow0 = b * SEQ + t0; U.nloc = 32; U.ntile = 36; U.krow_loc0 = b * SEQ; U.krow_ctx0 = ML + b * CTX;
        } else {
            U.Q = C.QDN() + ch * 64; U.Q2 = C.QDP() + ch * 32; U.K = C.KDN() + ch * 64; U.VT = C.VTD() + (size_t)(ch * 64) * MT;
            U.O = C.O() + 768 + ch * 64; U.qrow0 = ML + cb * CTX + 32 * wave; U.nloc = 0; U.ntile = 4; U.krow_loc0 = 0; U.krow_ctx0 = ML + cb * CTX;
        }
        at::attn_plain2<96>(lds, U, tid);
    }
    {
        const int b = u >> 5, kvh = (u >> 4) & 1, tb = u & 15, hq = 2 * kvh + (wave >> 2), t0 = tb * 128 + 32 * (wave & 3);
        const int jlo = tb * 128 - 128 < 0 ? 0 : tb * 128 - 128, jhi = tb * 128 + 256 > SEQ ? SEQ : tb * 128 + 256;
        at::Unit U{}; U.Q = C.QC() + hq * 64; U.ldq = 256; U.Q2 = nullptr; U.ldq2 = 0; U.K = C.KC() + kvh * 64; U.ldk = 128; U.K2 = nullptr; U.VT = C.VTC() + (size_t)(kvh * 64) * MT;
        U.O = C.O() + 512 + hq * 64; U.qrow0 = b * SEQ + t0; U.nloc = (jhi - jlo) >> 6; U.ntile = U.nloc + 4; U.krow_loc0 = b * SEQ + jlo; U.krow_ctx0 = ML + b * CTX;
        U.t0 = t0; U.j0 = jlo; U.sink2 = C.wc_sink()[l * 4 + hq] * at::LOG2E; U.has_sink = 1;
        at::attn_unit<64, at::WINDOW>(lds, U, tid);
    }
    {
        const int b = u >> 5, h = (u >> 3) & 3, rb = u & 7, r0 = 4 * rb, rr = r0 + (wave >> 1), c0 = 32 * (wave & 1);
        int krlo = r0 - 4; krlo = krlo < 0 ? 0 : (krlo > 24 ? 24 : krlo);
        int krhi = r0 + 3 - 4; krhi = (krhi < 0 ? 0 : (krhi > 24 ? 24 : krhi)) + 8;
        float* rpb = (float*)(lds + at::RPB_OFF);
        for (int i = tid; i < 465; i += NTHREADS) rpb[i] = C.na_rpb()[(l * 4 + h) * 465 + i] * at::LOG2E;
        at::Unit U{}; U.Q = C.QA() + h * 64; U.ldq = 256; U.Q2 = nullptr; U.ldq2 = 0; U.K = C.KA() + h * 64; U.ldk = 256; U.K2 = nullptr; U.VT = C.VTA() + (size_t)(h * 64) * MT;
        U.O = C.O() + h * 64; U.qrow0 = b * SEQ + rr * 64 + c0; U.nloc = krhi - krlo; U.ntile = U.nloc + 4; U.krow_loc0 = b * SEQ + 64 * krlo; U.krow_ctx0 = ML + b * CTX;
        U.rr = rr; U.c0 = c0; U.krlo = krlo;
        at::attn_unit<64, at::NATTEN>(lds, U, tid);
    }
}

__device__ __forceinline__ void ph_branch(const Ctx C, int l) {
    PG8_LAS unsigned char* glds = (PG8_LAS unsigned char*)(C.ldsraw() + GEMM_LDS_OFF);
    pg8::Gemm g; g.A = C.O(); g.Bt = C.WBR() + (size_t)l * D * D; g.K = 256; g.lda = D; g.ldb = D;
    pg8::BranchOrder S; S.init((l == DEPTH - 1) ? ML : MT, gridDim.x, blockIdx.x);
    pg8::EpiBranch E; E.MIX = C.MIX(); E.GATE = C.GATE();
    pg8::gemm_phase<pg8::EpiBranch, pg8::BranchOrder, true, true>(glds, g, S, E);
    if (l < DEPTH - 1 && blockIdx.x >= 32) {
        const int base = bg_layer_base(l) + BGW_IN + BGW_MLA;
        bg_run(C, base, (l == 1) ? BG_J9 : base + BGW_BR, 18, blockIdx.x - 32, 224);
    }
}
__device__ __forceinline__ void ph_out(const Ctx C, int l) {
    PG8_LAS unsigned char* glds = (PG8_LAS unsigned char*)(C.ldsraw() + GEMM_LDS_OFF);
    pg8::Gemm g; g.A = C.MIX(); g.Bt = C.WOUT() + (size_t)l * D * D; g.K = D; g.lda = D; g.ldb = D;
    if (l == DEPTH - 1) {
        pg8::StaticOrder S; S.init(ML, D, gridDim.x, blockIdx.x);
        pg8::EpiResid E; E.X = C.X(); E.ldc = D; E.gate = C.MOD() + (size_t)l * 9 * ADAW + 2 * D;
        pg8::gemm_phase<pg8::EpiResid, pg8::StaticOrder, true, true>(glds, g, S, E);
    } else {
        pg8::TailOrder S; S.init(gridDim.x, blockIdx.x, 4, 256);
        pg8::EpiResidTail E; E.X = C.X(); E.gate = C.MOD() + (size_t)l * 9 * ADAW + 2 * D; E.PART = C.PART();
        pg8::gemm_phase<pg8::EpiResidTail, pg8::TailOrder, true, false>(glds, g, S, E);
    }
}

__device__ __forceinline__ void ph_up(const Ctx C, int l) {
    PG8_LAS unsigned char* glds = (PG8_LAS unsigned char*)(C.ldsraw() + GEMM_LDS_OFF);
    pg8::EpiSwiglu E; E.O = C.ACT(); E.ldc = DFF;
    if (l & 1) {
        pg8::Gemm g; g.A = C.AS(); g.Bt = C.W13M(); g.K = D; g.lda = D; g.ldb = D;
        const int np_ = __builtin_amdgcn_readfirstlane(C.PEXP()[MAXSLOT / 128]);
        {
            PG8_LAS int* pt = (PG8_LAS int*)(glds + pg8::STAGE_BYTES);
            const int t_ = opaque_tid(); if (t_ < np_) pt[t_] = C.PEXP()[t_];
            __syncthreads();
        }
        pg8::MoeOrder S; S.init(np_, 2 * DFF, gridDim.x, blockIdx.x, (const PG8_LAS int*)(glds + pg8::STAGE_BYTES));
        pg8::gemm_phase<pg8::EpiSwiglu, pg8::MoeOrder, true, true>(glds, g, S, E);
    } else {
        pg8::Gemm g; g.A = C.HB(); g.Bt = C.W13D() + (size_t)(l >> 1) * 2 * DFF * D; g.K = D; g.lda = D; g.ldb = D;
        pg8::StaticOrder S; S.init(MT, 2 * DFF, gridDim.x, blockIdx.x);
        pg8::gemm_phase<pg8::EpiSwiglu, pg8::StaticOrder, true, true>(glds, g, S, E);
    }
}

__device__ __forceinline__ void ph_down(const Ctx C, int l) {
    PG8_LAS unsigned char* glds = (PG8_LAS unsigned char*)(C.ldsraw() + GEMM_LDS_OFF);
    if (l & 1) {
        pg8::Gemm g; g.A = C.ACT(); g.Bt = C.W2M(); g.K = DFF; g.lda = DFF; g.ldb = DFF;
        const int np_ = __builtin_amdgcn_readfirstlane(C.PEXP()[MAXSLOT / 128]);
        {
            PG8_LAS int* pt = (PG8_LAS int*)(glds + pg8::STAGE_BYTES);
            const int t_ = opaque_tid(); if (t_ < np_) pt[t_] = C.PEXP()[t_];
            __syncthreads();
        }
        pg8::MoeDownOrder S; S.init(np_, gridDim.x, blockIdx.x, DFF / 2, (const PG8_LAS int*)(glds + pg8::STAGE_BYTES));
        pg8::EpiY E; E.Y = C.Y(); E.Y2 = C.Y2();
        pg8::gemm_phase<pg8::EpiY, pg8::MoeDownOrder, true, true>(glds, g, S, E);
    } else {
        pg8::Gemm g; g.A = C.ACT(); g.Bt = C.W2D() + (size_t)(l >> 1) * D * DFF; g.K = DFF; g.lda = DFF; g.ldb = DFF;
        pg8::TailOrder S; S.init(gridDim.x, blockIdx.x, 7, 512);
        pg8::EpiResidTail E; E.X = C.X(); E.gate = C.MOD() + (size_t)l * 9 * ADAW + 5 * D; E.PART = C.PART();
        pg8::gemm_phase<pg8::EpiResidTail, pg8::TailOrder, true, true>(glds, g, S, E);
    }
}

template <int KMASK>
__global__ void __launch_bounds__(NTHREADS, 2) fwd_kernel(Args args) {
    extern __shared__ __attribute__((aligned(16))) unsigned char lds_raw[];
    Ctx C; C.a = (ArgsP)__builtin_amdgcn_kernarg_segment_ptr(); C.lds = (float*)(lds_raw + 64);
    volatile LAS unsigned* stw = (volatile LAS unsigned*)(LAS unsigned char*)lds_raw;
    if (threadIdx.x < 4) stw[threadIdx.x] = 0u;
    __syncthreads();
    const int lo = args.ph_lo, hi = args.ph_hi;
    XcdBarrier bar; bar.bar = (unsigned*)(args.ws + WS_CTL); bar.x = 0; bar.st = stw;
    if (hi - lo > 1) bar = xcd_barrier_post((unsigned*)(args.ws + WS_CTL), stw);
    int ph = 0;
#ifndef ONLY
#define ONLY -1
#endif
#ifndef PHMASK
#define PHMASK 0xFFFF
#endif
#ifndef DBL_ID
#define DBL_ID -1
#endif
#define PHASE(id, body) do { if ((ONLY < 0 || ONLY == (id)) && ((PHMASK >> (id)) & 1) && ((KMASK >> (id)) & 1) && ph >= lo && ph < hi) { body; if ((id) == DBL_ID && (((id) != 1 && (id) != 10) || (l & 1))) { xcd_barrier(bar); body; } if (ph + 1 < hi) xcd_barrier(bar); } ++ph; } while (0)
    { const int l = 0; PHASE(0, (ph_prologue(C), conv_prologue(C))); }
    for (int l = 0; l < DEPTH; ++l) {
        PHASE(1, ph_norm(C, l, 0));
        PHASE(2, ph_inproj(C, l));
        PHASE(3, ph_mla(C, l));
        PHASE(4, ph_attn(C, l));
        PHASE(5, ph_branch(C, l));
        PHASE(6, ph_out(C, l));
        PHASE(7, ph_norm(C, l, 1));
        if (l & 1) PHASE(8, ph_assign(C, l));
        PHASE(9, ph_up(C, l));
        PHASE(10, ph_down(C, l));
    }
    { const int l = 0; PHASE(11, ph_norm(C, DEPTH - 1, 2)); }
#undef PHASE
}
constexpr int N_PHASES = 1 + DEPTH * 9 + (DEPTH / 2) + 1;

extern "C" void kernel_launch(void* const* d_in, const int* in_sizes, int n_in, void* d_out, int out_size, void* d_ws, size_t ws_size, hipStream_t stream) {
    static int grid = 0;
    if (grid == 0) {
        if (n_in != 27 || out_size != ML * D || ws_size < WS_END) {
            fprintf(stderr, "kernel_launch: unexpected shapes: n_in %d out %d ws %zu (need %zu)\n", n_in, out_size, ws_size, (size_t)WS_END); grid = -1; return; }
        int dev = 0, cus = 0, per_cu = 0;
        if (hipGetDevice(&dev) != hipSuccess || hipDeviceGetAttribute(&cus, hipDeviceAttributeMultiprocessorCount, dev) != hipSuccess) { grid = -1; return; }
#if ONE_LAUNCH
        if (hipFuncSetAttribute((const void*)fwd_kernel<0xFFFF>, hipFuncAttributeMaxDynamicSharedMemorySize, LDS_BYTES) != hipSuccess) { fprintf(stderr, "kernel_launch: hipFuncSetAttribute failed\n"); grid = -1; return; }
        if (hipOccupancyMaxActiveBlocksPerMultiprocessor(&per_cu, (const void*)fwd_kernel<0xFFFF>, NTHREADS, LDS_BYTES) != hipSuccess || per_cu < 1)
            fprintf(stderr, "kernel_launch: occupancy query reports %d blocks per CU\n", per_cu);
#else
        if (hipFuncSetAttribute((const void*)fwd_kernel<0xFFEF>, hipFuncAttributeMaxDynamicSharedMemorySize, LDS_BYTES) != hipSuccess ||
            hipFuncSetAttribute((const void*)fwd_kernel<0x0010>, hipFuncAttributeMaxDynamicSharedMemorySize, LDS_BYTES) != hipSuccess) { fprintf(stderr, "kernel_launch: hipFuncSetAttribute failed\n"); grid = -1; return; }
#endif
        (void)hipGetLastError();
        grid = cus;
        if (grid != 256) fprintf(stderr, "kernel_launch: %d CUs (built for 256)\n", grid);
        if (grid > 256 || (ML % grid) || (MT % grid)) grid = 256;
    }
    if (grid < 0) return;
    (void)hipMemsetAsync((char*)d_ws + WS_CTL, 0, CTL_BYTES, stream);
#ifdef NAN_POISON
    (void)hipMemsetAsync((char*)d_ws + CTL_BYTES, 0xFF, WS_END - CTL_BYTES, stream);
#endif
    Args a{};
    for (int i = 0; i < 27; ++i) a.in[i] = (const float*)d_in[i];
    a.out = (float*)d_out; a.ws = (unsigned char*)d_ws;
#if ONE_LAUNCH
    a.ph_lo = 0; a.ph_hi = N_PHASES;
    hipLaunchKernelGGL(fwd_kernel<0xFFFF>, dim3(grid), dim3(NTHREADS), LDS_BYTES, stream, a);
#else
    {
        int p = 0;
        auto launch = [&](int id) { a.ph_lo = p; a.ph_hi = p + 1; ++p;
            if (id == 4) hipLaunchKernelGGL(fwd_kernel<0x0010>, dim3(grid), dim3(NTHREADS), LDS_BYTES, stream, a);
            else hipLaunchKernelGGL(fwd_kernel<0xFFEF>, dim3(grid), dim3(NTHREADS), LDS_BYTES, stream, a); };
        launch(0);
        for (int l = 0; l < DEPTH; ++l) { for (int id = 1; id <= 7; ++id) launch(id); if (l & 1) launch(8); launch(9); launch(10); }
        launch(11);
    }
#endif
}
```

```cpp
#include <hip/hip_runtime.h>
#include <cstdio>
#include <cstdint>

#ifndef ONE_LAUNCH
#define ONE_LAUNCH 1
#endif

constexpr int D = 1024, BATCH = 8, SEQ = 2048, DEPTH = 4, CTX = 256, GW = 64;
constexpr int ML = BATCH * SEQ, MC = BATCH * CTX, MT = ML + MC;
constexpr int INW = 6304, DFF = 3584, NE = 8, ADAW = 6144;
constexpr int P_AQ = 0, P_AK = 256, P_AV = 512, P_BQ = 768, P_BK = 1024, P_BV = 1152, P_CQ = 1280, P_CK = 1536, P_CV = 1664,
              P_DQA = 1792, P_DKVA = 2048, P_GATE = 2208;
constexpr float EPS = 1e-6f;
constexpr int NTHREADS = 512, NWAVES = 8;
constexpr int MAXSLOT = 2 * MT + NE * 256;
constexpr int LDS_BYTES = 144 * 1024;

constexpr size_t al256(size_t x) { return (x + 255) & ~(size_t)255; }
constexpr size_t WS_CTL = 0;
constexpr size_t CTL_BYTES = 64 * 1024;
constexpr size_t WS_MOD = WS_CTL + CTL_BYTES;
constexpr size_t WS_ROPE = WS_MOD + al256((size_t)DEPTH * 9 * ADAW * 4);
constexpr size_t WS_HIST = WS_ROPE + al256((size_t)SEQ * 96 * 4);
constexpr size_t WS_TOPE = WS_HIST + al256(256 * 8 * 4);
constexpr size_t WS_TOPW = WS_TOPE + al256((size_t)MT * 2 * 4);
constexpr size_t WS_SLOT = WS_TOPW + al256((size_t)MT * 2 * 4);
constexpr size_t WS_ROWOF = WS_SLOT + al256((size_t)MT * 2 * 4);
constexpr size_t WS_PEXP = WS_ROWOF + al256((size_t)MAXSLOT * 4);
constexpr size_t WS_X = WS_PEXP + al256((size_t)(MAXSLOT / 128 + 64) * 4);
constexpr size_t WS_HB = WS_X + (size_t)MT * D * 4;
constexpr int INWP = 6400;
constexpr size_t WS_WIN = WS_HB + (size_t)MT * D * 2;
constexpr size_t WS_WMLA = WS_WIN + (size_t)DEPTH * INWP * D * 2;
constexpr size_t WS_WBR = WS_WMLA + (size_t)DEPTH * 1024 * 384 * 2;
constexpr size_t WS_WOUT = WS_WBR + (size_t)DEPTH * D * D * 2;
constexpr size_t WS_W13D = WS_WOUT + (size_t)DEPTH * D * D * 2;
constexpr size_t WS_W2D = WS_W13D + (size_t)2 * 2 * DFF * D * 2;
constexpr size_t WS_W13M = WS_W2D + (size_t)2 * D * DFF * 2;
constexpr size_t WS_W2M = WS_W13M + (size_t)NE * 2 * DFF * D * 2;
constexpr size_t WS_BIG = WS_W2M + (size_t)NE * D * DFF * 2;
constexpr size_t WS_QA = WS_BIG;
constexpr size_t WS_KA = WS_QA + (size_t)MT * 256 * 2;
constexpr size_t WS_VTA = WS_KA + (size_t)MT * 256 * 2;
constexpr size_t WS_QB = WS_VTA + (size_t)MT * 256 * 2;
constexpr size_t WS_KB = WS_QB + (size_t)MT * 256 * 2;
constexpr size_t WS_VTB = WS_KB + (size_t)MT * 128 * 2;
constexpr size_t WS_QC = WS_VTB + (size_t)MT * 128 * 2;
constexpr size_t WS_KC = WS_QC + (size_t)MT * 256 * 2;
constexpr size_t WS_VTC = WS_KC + (size_t)MT * 128 * 2;
constexpr size_t WS_QDN = WS_VTC + (size_t)MT * 128 * 2;
constexpr size_t WS_QDP = WS_QDN + (size_t)MT * 256 * 2;
constexpr size_t WS_KDN = WS_QDP + (size_t)MT * 128 * 2;
constexpr size_t WS_KPE = WS_KDN + (size_t)MT * 256 * 2;
constexpr size_t WS_VTD = WS_KPE + (size_t)MT * 32 * 2;
constexpr size_t WS_DA = WS_VTD + (size_t)MT * 256 * 2;
constexpr size_t WS_RSQ = WS_DA + (size_t)MT * 384 * 2;
constexpr size_t WS_RSKV = WS_RSQ + (size_t)MT * 4 * 4;
constexpr size_t WS_GATE = WS_RSKV + (size_t)MT * 4 * 4;
constexpr size_t WS_O = WS_GATE + (size_t)MT * 4096 * 2;
constexpr size_t WS_MIX = WS_O + (size_t)MT * D * 2;
constexpr size_t WS_END_A = WS_MIX + (size_t)MT * D * 2;
constexpr size_t WS_AS = WS_BIG;
constexpr size_t WS_ACT = WS_AS + (size_t)MAXSLOT * D * 2;
constexpr size_t WS_Y = WS_ACT + (size_t)MAXSLOT * DFF * 2;
constexpr int YSPLIT_P0 = 128;
constexpr size_t WS_Y2 = WS_Y + (size_t)MAXSLOT * D * 2;
constexpr size_t WS_END_F = WS_Y2 + (size_t)(MAXSLOT / 256 - YSPLIT_P0) * 256 * D * 2;
constexpr size_t WS_END = WS_END_A > WS_END_F ? WS_END_A : WS_END_F;
constexpr int GEMM_LDS_OFF = 1024;

#define XB_TMO      128
#define XB_XCNT(j)  (256  + 64 * (j))
#define XB_XSUB(j)  (1280 + 64 * (j))
#define XB_XGEN(j)  (2304 + 64 * (j))
#define XB_TOP      3328
#define XB_TOPGEN   3392
#define XCD_BAR_WORDS 3456
#define XB_SPIN_CAP (1u << 25)
#define LAS __attribute__((address_space(3)))

__device__ __forceinline__ unsigned xb_ld(unsigned* p)              { return __hip_atomic_load(p, __ATOMIC_RELAXED, __HIP_MEMORY_SCOPE_AGENT); }
__device__ __forceinline__ unsigned xb_add(unsigned* p, unsigned v) { return __hip_atomic_fetch_add(p, v, __ATOMIC_RELAXED, __HIP_MEMORY_SCOPE_AGENT); }
__device__ __forceinline__ unsigned xb_xcc_id() { return (unsigned)__builtin_amdgcn_s_getreg((3 << 11) | 20) & 0xFu; }
#define XB_SPIN(cond, bar) do { unsigned _sp = 0; while (cond) { __builtin_amdgcn_s_sleep(1); \
    if ((++_sp & 255u) == 0u) { if (xb_ld(&(bar)[XB_TMO])) break; if (_sp > XB_SPIN_CAP) { atomicAdd(&(bar)[XB_TMO], 1u); break; } } } } while (0)

struct XcdBarrier { unsigned* bar; unsigned x; volatile LAS unsigned* st; };

__device__ __forceinline__ XcdBarrier xcd_barrier_post(unsigned* bar, volatile LAS unsigned* st) {
    XcdBarrier b; b.bar = bar; b.x = xb_xcc_id(); b.st = st;
    if (threadIdx.x == 0) (void)xb_add(&bar[XB_XCNT(b.x)], 1u);
    return b;
}
__device__ __forceinline__ void xcd_barrier_complete(unsigned* bar, unsigned x, unsigned& nloc, unsigned& nx) {
    const unsigned G = gridDim.x * gridDim.y * gridDim.z;
    unsigned sum, cnt, mine, sp = 0u;
    for (;;) {
        sum = 0u; cnt = 0u; mine = 0u;
#pragma unroll
        for (unsigned j = 0; j < 16; ++j) { const unsigned c = xb_ld(&bar[XB_XCNT(j)]); sum += c; cnt += (c > 0u) ? 1u : 0u; mine = (j == x) ? c : mine; }
        if (sum == G) break;
        __builtin_amdgcn_s_sleep(1);
        if ((++sp & 255u) == 0u) { if (xb_ld(&bar[XB_TMO])) break; if (sp > XB_SPIN_CAP) { atomicAdd(&bar[XB_TMO], 1u); break; } }
    }
    nloc = mine > 0u ? mine : 1u; nx = cnt > 0u ? cnt : 1u;
}
__device__ __forceinline__ void xcd_barrier(const XcdBarrier& b) {
    asm volatile("s_waitcnt vmcnt(0)" ::: "memory");
    __syncthreads();
    if (threadIdx.x == 0) {
        unsigned* bar = b.bar;
        __builtin_amdgcn_s_waitcnt(0);
        unsigned nloc = b.st[0], nx = b.st[1];
        if (nloc == 0u) { xcd_barrier_complete(bar, b.x, nloc, nx); b.st[0] = nloc; b.st[1] = nx; }
        const unsigned old = xb_add(&bar[XB_XSUB(b.x)], 1u);
        const unsigned gen = old / nloc;
        if (old + 1u == (gen + 1u) * nloc) {
            __builtin_amdgcn_fence(__ATOMIC_RELEASE, "agent");
            asm volatile("s_waitcnt vmcnt(0)" ::: "memory");
            const unsigned og = xb_add(&bar[XB_TOP], 1u);
            const unsigned tg = og / nx;
            if (og + 1u == (tg + 1u) * nx) xb_add(&bar[XB_TOPGEN], 1u);
            else XB_SPIN(xb_ld(&bar[XB_TOPGEN]) == tg, bar);
            __builtin_amdgcn_fence(__ATOMIC_ACQUIRE, "agent");
            xb_add(&bar[XB_XGEN(b.x)], 1u);
            asm volatile("s_waitcnt vmcnt(0)" ::: "memory");
        } else {
            XB_SPIN(xb_ld(&bar[XB_XGEN(b.x)]) == gen, bar);
            __builtin_amdgcn_fence(__ATOMIC_ACQUIRE, "agent");
            asm volatile("s_waitcnt vmcnt(0)" ::: "memory");
        }
    }
    __syncthreads();
}

__device__ __forceinline__ float wave_sum(float v) {
#pragma unroll
    for (int o = 1; o < 64; o <<= 1) v += __shfl_xor(v, o);
    return v;
}
__device__ __forceinline__ float wave_max(float v) {
#pragma unroll
    for (int o = 1; o < 64; o <<= 1) v = fmaxf(v, __shfl_xor(v, o));
    return v;
}
__device__ __forceinline__ int opaque_tid() { int t = threadIdx.x; asm volatile("" : "+v"(t)); return t; }
__device__ __forceinline__ float siluf(float v) { return v / (1.f + expf(-v)); }
__device__ __forceinline__ float sigmoidf(float v) { return 1.f / (1.f + expf(-v)); }
__device__ __forceinline__ int modrow(int m) { return m < ML ? (m >> 11) : 8; }

struct Args { const float* in[27]; float* out; unsigned char* ws; int ph_lo, ph_hi; };

typedef const __attribute__((address_space(4))) Args* ArgsP;
struct Ctx {
    ArgsP a; float* lds;
    __device__ __forceinline__ const float* x() const { return a->in[0]; }
    __device__ __forceinline__ const float* c() const { return a->in[1]; }
    __device__ __forceinline__ const float* ctx() const { return a->in[2]; }
    __device__ __forceinline__ const float* c_ctx() const { return a->in[3]; }
    __device__ __forceinline__ const float* norm1_g() const { return a->in[4]; }
    __device__ __forceinline__ const float* norm2_g() const { return a->in[5]; }
    __device__ __forceinline__ const float* w_ada() const { return a->in[6]; }
    __device__ __forceinline__ const float* b_ada() const { return a->in[7]; }
    __device__ __forceinline__ const float* w_in() const { return a->in[8]; }
    __device__ __forceinline__ const float* na_rpb() const { return a->in[9]; }
    __device__ __forceinline__ const float* gb_qnorm() const { return a->in[10]; }
    __device__ __forceinline__ const float* gb_knorm() const { return a->in[11]; }
    __device__ __forceinline__ const float* wc_sink() const { return a->in[12]; }
    __device__ __forceinline__ const float* mla_qnorm() const { return a->in[13]; }
    __device__ __forceinline__ const float* mla_kvnorm() const { return a->in[14]; }
    __device__ __forceinline__ const float* mla_wqb() const { return a->in[15]; }
    __device__ __forceinline__ const float* mla_wkvb() const { return a->in[16]; }
    __device__ __forceinline__ const float* w_branch() const { return a->in[17]; }
    __device__ __forceinline__ const float* w_out() const { return a->in[18]; }
    __device__ __forceinline__ const float* ffn_w1() const { return a->in[19]; }
    __device__ __forceinline__ const float* ffn_w3() const { return a->in[20]; }
    __device__ __forceinline__ const float* ffn_w2() const { return a->in[21]; }
    __device__ __forceinline__ const float* moe_router() const { return a->in[22]; }
    __device__ __forceinline__ const float* moe_w1() const { return a->in[23]; }
    __device__ __forceinline__ const float* moe_w3() const { return a->in[24]; }
    __device__ __forceinline__ const float* moe_w2() const { return a->in[25]; }
    __device__ __forceinline__ const float* final_g() const { return a->in[26]; }
    __device__ __forceinline__ float* out() const { return a->out; }
    __device__ __forceinline__ float* MOD() const { return (float*)(a->ws + WS_MOD); }
    __device__ __forceinline__ float* ROPE() const { return (float*)(a->ws + WS_ROPE); }
    __device__ __forceinline__ unsigned short* X() const { return (unsigned short*)(a->ws + WS_X); }
    __device__ __forceinline__ float* TOPW() const { return (float*)(a->ws + WS_TOPW); }
    __device__ __forceinline__ unsigned short* ACT() const { return (unsigned short*)(a->ws + WS_ACT); }
    __device__ __forceinline__ unsigned short* Y() const { return (unsigned short*)(a->ws + WS_Y); }
    __device__ __forceinline__ unsigned short* Y2() const { return (unsigned short*)(a->ws + WS_Y2); }
    __device__ __forceinline__ unsigned short* HB() const { return (unsigned short*)(a->ws + WS_HB); }
    __device__ __forceinline__ unsigned short* AS() const { return (unsigned short*)(a->ws + WS_AS); }
    __device__ __forceinline__ unsigned short* W13D() const { return (unsigned short*)(a->ws + WS_W13D); }
    __device__ __forceinline__ unsigned short* W2D() const { return (unsigned short*)(a->ws + WS_W2D); }
    __device__ __forceinline__ unsigned short* W13M() const { return (unsigned short*)(a->ws + WS_W13M); }
    __device__ __forceinline__ unsigned short* W2M() const { return (unsigned short*)(a->ws + WS_W2M); }
    __device__ __forceinline__ unsigned short* QA() const { return (unsigned short*)(a->ws + WS_QA); }
    __device__ __forceinline__ unsigned short* KA() const { return (unsigned short*)(a->ws + WS_KA); }
    __device__ __forceinline__ unsigned short* VTA() const { return (unsigned short*)(a->ws + WS_VTA); }
    __device__ __forceinline__ unsigned short* QB() const { return (unsigned short*)(a->ws + WS_QB); }
    __device__ __forceinline__ unsigned short* KB() const { return (unsigned short*)(a->ws + WS_KB); }
    __device__ __forceinline__ unsigned short* VTB() const { return (unsigned short*)(a->ws + WS_VTB); }
    __device__ __forceinline__ unsigned short* QC() const { return (unsigned short*)(a->ws + WS_QC); }
    __device__ __forceinline__ unsigned short* KC() const { return (unsigned short*)(a->ws + WS_KC); }
    __device__ __forceinline__ unsigned short* VTC() const { return (unsigned short*)(a->ws + WS_VTC); }
    __device__ __forceinline__ unsigned short* QDN() const { return (unsigned short*)(a->ws + WS_QDN); }
    __device__ __forceinline__ unsigned short* QDP() const { return (unsigned short*)(a->ws + WS_QDP); }
    __device__ __forceinline__ unsigned short* KDN() const { return (unsigned short*)(a->ws + WS_KDN); }
    __device__ __forceinline__ unsigned short* KPE() const { return (unsigned short*)(a->ws + WS_KPE); }
    __device__ __forceinline__ unsigned short* VTD() const { return (unsigned short*)(a->ws + WS_VTD); }
    __device__ __forceinline__ unsigned short* DA() const { return (unsigned short*)(a->ws + WS_DA); }
    __device__ __forceinline__ unsigned short* GATE() const { return (unsigned short*)(a->ws + WS_GATE); }
    __device__ __forceinline__ unsigned short* O() const { return (unsigned short*)(a->ws + WS_O); }
    __device__ __forceinline__ unsigned short* MIX() const { return (unsigned short*)(a->ws + WS_MIX); }
    __device__ __forceinline__ unsigned short* WIN() const { return (unsigned short*)(a->ws + WS_WIN); }
    __device__ __forceinline__ unsigned short* WMLA() const { return (unsigned short*)(a->ws + WS_WMLA); }
    __device__ __forceinline__ unsigned short* WBR() const { return (unsigned short*)(a->ws + WS_WBR); }
    __device__ __forceinline__ unsigned short* WOUT() const { return (unsigned short*)(a->ws + WS_WOUT); }
    __device__ __forceinline__ float* RSQ() const { return (float*)(a->ws + WS_RSQ); }
    __device__ __forceinline__ float* RSKV() const { return (float*)(a->ws + WS_RSKV); }
    __device__ __forceinline__ unsigned short* PART() const { return (unsigned short*)(a->ws + WS_Y); }
    __device__ __forceinline__ unsigned char* ldsraw() const { return (unsigned char*)lds - 64; }
    __device__ __forceinline__ int* HIST() const { return (int*)(a->ws + WS_HIST); }
    __device__ __forceinline__ int* TOPE() const { return (int*)(a->ws + WS_TOPE); }
    __device__ __forceinline__ int* SLOT() const { return (int*)(a->ws + WS_SLOT); }
    __device__ __forceinline__ int* ROWOF() const { return (int*)(a->ws + WS_ROWOF); }
    __device__ __forceinline__ int* PEXP() const { return (int*)(a->ws + WS_PEXP); }
};

namespace pg8 {
#define PG8_LAS __attribute__((address_space(3)))
typedef unsigned short bf16_t;
typedef short bf16x8 __attribute__((ext_vector_type(8)));
typedef float f32x4 __attribute__((ext_vector_type(4)));
typedef unsigned u32x4 __attribute__((ext_vector_type(4)));
typedef unsigned u32x2 __attribute__((ext_vector_type(2)));
constexpr int BM = 256, BK = 64, HALF = 128, HTB = HALF * BK * 2, STAGE_BYTES = 8 * HTB, NXCD = 8, WGM = 4;
__host__ __device__ __forceinline__ int lds_byte(int r, int c) { const int st = (r >> 4) * 2 + (c >> 5), rr = r & 15, cc = c & 31, ob = rr * 64 + cc * 2; return st * 1024 + (ob ^ (((ob >> 9) & 1) << 5)); }
__host__ __device__ __forceinline__ void stage_rc(int b, int& R, int& C) { const int st = b / 1024, sb = b % 1024, swz = sb ^ (((sb >> 9) & 1) << 5); R = (st >> 1) * 16 + swz / 64; C = (st & 1) * 32 + (swz % 64) / 2; }
__host__ __device__ __forceinline__ int perm32(int rho) { const int n = rho >> 4, i = rho & 15; return 8 * (i >> 2) + 4 * n + (i & 3); }
struct Unit { int pm, pn, pc, koff, seg, nt; };
struct Gemm { const bf16_t* A; const bf16_t* Bt; int K, lda, ldb; };
struct StaticOrder {
    int nM, nN, nwg, G, c;
    __host__ __device__ void init(int M, int N, int G_, int c_) { nM = M / BM; nN = N / BM; nwg = nM * nN; G = G_; c = c_; }
    __host__ __device__ bool next(int i, Unit& u) const {
        const long L = (long)i * G + c; if (L >= nwg) return false;
        int wgid = (int)L; { const int q = nwg / NXCD, r = nwg % NXCD, xcd = wgid % NXCD, off = wgid / NXCD; wgid = (xcd < r ? xcd * (q + 1) : r * (q + 1) + (xcd - r) * q) + off; }
        const int nig = WGM * nN, gid = wgid / nig, fm = gid * WGM, gsz = (nM - fm) < WGM ? (nM - fm) : WGM;
        u.pm = fm + ((wgid % nig) % gsz); u.pn = (wgid % nig) / gsz; u.pc = u.pn; u.koff = 0; u.seg = 0; u.nt = 0; return true;
    }
    __device__ __forceinline__ void a_ready(const Unit&) const {}
    __device__ __forceinline__ void done(const Unit&) const {}
};
struct MoeOrder {
    int nM, nN, nwg, G, c; const PG8_LAS int* pexp;
    __device__ void init(int nP, int N, int G_, int c_, const PG8_LAS int* pexp_) { nM = nP; nN = N / BM; nwg = nM * nN; G = G_; c = c_; pexp = pexp_; }
    __device__ bool next(int i, Unit& u) const {
        const long L = (long)i * G + c; if (L >= nwg) return false;
        int wgid = (int)L; { const int q = nwg / NXCD, r = nwg % NXCD, xcd = wgid % NXCD, off = wgid / NXCD; wgid = (xcd < r ? xcd * (q + 1) : r * (q + 1) + (xcd - r) * q) + off; }
        const int nig = WGM * nN, gid = wgid / nig, fm = gid * WGM, gsz = (nM - fm) < WGM ? (nM - fm) : WGM;
        u.pm = fm + ((wgid % nig) % gsz); u.pc = (wgid % nig) / gsz; u.pn = pexp[u.pm] * nN + u.pc; u.koff = 0; u.seg = 0; u.nt = 0; return true;
    }
    __device__ __forceinline__ void a_ready(const Unit&) const {}
    __device__ __forceinline__ void done(const Unit&) const {}
};
typedef __bf16 bf16x2_t __attribute__((ext_vector_type(2)));
typedef float f32x2_t __attribute__((ext_vector_type(2)));
__device__ __forceinline__ unsigned cvt_pk_bf16(float lo, float hi) { f32x2_t f = {lo, hi}; bf16x2_t r = __builtin_convertvector(f, bf16x2_t); return __builtin_bit_cast(unsigned, r); }
__device__ __forceinline__ float silu_fast(float v) { return v * __builtin_amdgcn_rcpf(1.f + __builtin_amdgcn_exp2f(-1.4426950408889634f * v)); }
struct EpiSwiglu {
    static constexpr bool PERM = true, AFTER_DRAIN = false, KEEP = false;
    bf16_t* O; int ldc;
    __device__ __forceinline__ void operator()(const f32x4 (&acc)[2][2][4][2], const Unit& u, int wr, int wc, int fr, int fq) const {
        const int row0 = u.pm * BM + wr * 64 + fr, col0 = u.pc * 128 + wc * 32 + 8 * fq;
#pragma unroll
        for (int ai = 0; ai < 2; ++ai)
#pragma unroll
            for (int m = 0; m < 4; ++m) {
                bf16_t* rowp = O + (size_t)(row0 + ai * HALF + m * 16) * ldc + col0;
                float v[8];
#pragma unroll
                for (int n = 0; n < 2; ++n)
#pragma unroll
                    for (int j = 0; j < 4; ++j) v[n * 4 + j] = silu_fast(acc[ai][0][m][n][j]) * acc[ai][1][m][n][j];
                u32x4 w; w.x = cvt_pk_bf16(v[0], v[1]); w.y = cvt_pk_bf16(v[2], v[3]); w.z = cvt_pk_bf16(v[4], v[5]); w.w = cvt_pk_bf16(v[6], v[7]);
                *(u32x4*)rowp = w;
            }
    }
};
__device__ __forceinline__ f32x4 bf_lo4(unsigned a, unsigned b) { return (f32x4){__uint_as_float(a << 16), __uint_as_float(a & 0xffff0000u), __uint_as_float(b << 16), __uint_as_float(b & 0xffff0000u)}; }
__device__ __forceinline__ void resid_tile(const f32x4 (&acc)[2][2][4][2], bf16_t* X, unsigned ldx, const float* gate, int row0, int col0) {
    const float* g = gate + (unsigned)modrow(row0) * ADAW + col0;
    f32x4 gg[2][2];
#pragma unroll
    for (int bj = 0; bj < 2; ++bj) { gg[bj][0] = *(const f32x4*)(g + bj * HALF); gg[bj][1] = *(const f32x4*)(g + bj * HALF + 4); }
#pragma unroll
    for (int ai = 0; ai < 2; ++ai) {
        u32x4 xw[4][2];
        asm volatile("" ::: "memory");
#pragma unroll
        for (int m = 0; m < 4; ++m)
#pragma unroll
            for (int bj = 0; bj < 2; ++bj) xw[m][bj] = *(const u32x4*)(X + (unsigned)(row0 + ai * HALF + m * 16) * ldx + col0 + bj * HALF);
        asm volatile("" ::: "memory");
#pragma unroll
        for (int m = 0; m < 4; ++m)
#pragma unroll
            for (int bj = 0; bj < 2; ++bj) {
                const f32x4 r0 = bf_lo4(xw[m][bj].x, xw[m][bj].y) + gg[bj][0] * acc[ai][bj][m][0], r1 = bf_lo4(xw[m][bj].z, xw[m][bj].w) + gg[bj][1] * acc[ai][bj][m][1];
                u32x4 w; w.x = cvt_pk_bf16(r0[0], r0[1]); w.y = cvt_pk_bf16(r0[2], r0[3]); w.z = cvt_pk_bf16(r1[0], r1[1]); w.w = cvt_pk_bf16(r1[2], r1[3]);
                *(u32x4*)(X + (unsigned)(row0 + ai * HALF + m * 16) * ldx + col0 + bj * HALF) = w;
            }
    }
}
struct EpiResid {
    static constexpr bool PERM = true, AFTER_DRAIN = false, KEEP = false;
    bf16_t* X; int ldc; const float* gate;
    __device__ __forceinline__ void operator()(const f32x4 (&acc)[2][2][4][2], const Unit& u, int wr, int wc, int fr, int fq) const {
        resid_tile(acc, X, (unsigned)ldc, gate, u.pm * BM + wr * 64 + fr, u.pc * BM + wc * 32 + 8 * fq);
    }
};
struct EpiBf16Plain {
    static constexpr bool PERM = true, AFTER_DRAIN = false, KEEP = false;
    bf16_t* O; int ldc;
    __device__ __forceinline__ void operator()(const f32x4 (&acc)[2][2][4][2], const Unit& u, int wr, int wc, int fr, int fq) const {
        const int row0 = u.pm * BM + wr * 64 + fr, col0 = u.pc * BM + wc * 32 + 8 * fq;
#pragma unroll
        for (int ai = 0; ai < 2; ++ai)
#pragma unroll
            for (int m = 0; m < 4; ++m) {
                bf16_t* rowp = O + (size_t)(row0 + ai * HALF + m * 16) * ldc + col0;
#pragma unroll
                for (int bj = 0; bj < 2; ++bj) {
                    const f32x4 v0 = acc[ai][bj][m][0], v1 = acc[ai][bj][m][1];
                    u32x4 w; w.x = cvt_pk_bf16(v0[0], v0[1]); w.y = cvt_pk_bf16(v0[2], v0[3]); w.z = cvt_pk_bf16(v1[0], v1[1]); w.w = cvt_pk_bf16(v1[2], v1[3]);
                    *(u32x4*)(rowp + bj * HALF) = w;
                }
            }
    }
};
constexpr float C2A = 0.125f * 1.4426950408889634f;
constexpr float C2D = 0.10206207261596577f * 1.4426950408889634f;
__device__ __forceinline__ void st_bf16x8(bf16_t* p, const float (&v)[8]) {
    u32x4 w; w.x = cvt_pk_bf16(v[0], v[1]); w.y = cvt_pk_bf16(v[2], v[3]); w.z = cvt_pk_bf16(v[4], v[5]); w.w = cvt_pk_bf16(v[6], v[7]); *(u32x4*)p = w;
}
__device__ __forceinline__ void st_bf16x4(bf16_t* p, float a, float b, float c, float d) { u32x2 w; w.x = cvt_pk_bf16(a, b); w.y = cvt_pk_bf16(c, d); *(u32x2*)p = w; }
__device__ __forceinline__ bf16_t f2bf(float f) { return (bf16_t)(cvt_pk_bf16(f, 0.f) & 0xffffu); }

struct EpiInproj {
    static constexpr bool PERM = true, AFTER_DRAIN = false, KEEP = false;
    unsigned char* ws; const float *rope, *gq, *gk;
    __device__ __forceinline__ void operator()(const f32x4 (&acc)[2][2][4][2], const Unit& u, int wr, int wc, int fr_, int fq_) const {
        int fr = fr_, fq = fq_; asm volatile("" : "+v"(fr), "+v"(fq));
        bf16_t* const QA = (bf16_t*)(ws + WS_QA); bf16_t* const KA = (bf16_t*)(ws + WS_KA); bf16_t* const VTA = (bf16_t*)(ws + WS_VTA); bf16_t* const QB = (bf16_t*)(ws + WS_QB);
        bf16_t* const KB = (bf16_t*)(ws + WS_KB); bf16_t* const VTB = (bf16_t*)(ws + WS_VTB); bf16_t* const QC = (bf16_t*)(ws + WS_QC); bf16_t* const KC = (bf16_t*)(ws + WS_KC);
        bf16_t* const VTC = (bf16_t*)(ws + WS_VTC); bf16_t* const DA = (bf16_t*)(ws + WS_DA); bf16_t* const KPE = (bf16_t*)(ws + WS_KPE); bf16_t* const GATE = (bf16_t*)(ws + WS_GATE);
        float* const RSQ = (float*)(ws + WS_RSQ); float* const RSKV = (float*)(ws + WS_RSKV);
        const int pc = u.pc, row0 = u.pm * BM + wr * 64 + fr;
        const bool lat = u.pm < ML / BM;
        if (pc >= 9) {
#pragma unroll
            for (int ai = 0; ai < 2; ++ai)
#pragma unroll
                for (int m = 0; m < 4; ++m) {
                    unsigned char* rowp = (unsigned char*)GATE + (unsigned)(row0 + ai * HALF + m * 16) * 4096 + (pc - 9) * 256 + wc * 32 + 8 * fq;
#pragma unroll
                    for (int bj = 0; bj < 2; ++bj) {
                        u32x2 w = {0u, 0u};
#pragma unroll
                        for (int n = 0; n < 2; ++n)
#pragma unroll
                            for (int j = 0; j < 4; ++j) {
                                const float gte = __builtin_amdgcn_rcpf(1.f + __builtin_amdgcn_exp2f(-1.4426950408889634f * acc[ai][bj][m][n][j]));
                                w[n] = __builtin_amdgcn_cvt_pk_u8_f32(fmaf(gte, 256.f, -0.5f), j, w[n]);
                            }
                        *(u32x2*)(rowp + bj * HALF) = w;
                    }
                }
        } else if (pc == 7) {
#pragma unroll
            for (int ai = 0; ai < 2; ++ai)
#pragma unroll
                for (int m = 0; m < 4; ++m) {
                    const int row = row0 + ai * HALF + m * 16;
                    float ss = 0.f;
#pragma unroll
                    for (int bj = 0; bj < 2; ++bj) {
                        float v[8];
#pragma unroll
                        for (int n = 0; n < 2; ++n)
#pragma unroll
                            for (int j = 0; j < 4; ++j) { v[n * 4 + j] = acc[ai][bj][m][n][j]; ss += v[n * 4 + j] * v[n * 4 + j]; }
                        st_bf16x8(DA + (unsigned)row * 384 + bj * HALF + wc * 32 + 8 * fq, v);
                    }
                    ss += __shfl_xor(ss, 16); ss += __shfl_xor(ss, 32);
                    if (fq == 0) RSQ[row * 4 + wc] = ss;
                }
        } else if (pc == 8) {
            const float* cr = rope + SEQ * 64; const float* sr = cr + SEQ * 16;
            const bool rope8 = (wc == 0) && lat;
            f32x4 rc = {1.f, 1.f, 1.f, 1.f}, rsn = {0.f, 0.f, 0.f, 0.f}, rcn = rc, rsnn = rsn;
            if (rope8) { const int t0 = row0 & (SEQ - 1); rc = *(const f32x4*)(cr + t0 * 16 + 4 * fq); rsn = *(const f32x4*)(sr + t0 * 16 + 4 * fq); }
#pragma unroll
            for (int ai = 0; ai < 2; ++ai)
#pragma unroll
                for (int m = 0; m < 4; ++m) {
                    const int row = row0 + ai * HALF + m * 16;
                    if (rope8 && (ai * 4 + m) < 7) { const int k1 = ai * 4 + m + 1, tn = (row0 + (k1 >> 2) * HALF + (k1 & 3) * 16) & (SEQ - 1); rcn = *(const f32x4*)(cr + tn * 16 + 4 * fq); rsnn = *(const f32x4*)(sr + tn * 16 + 4 * fq); }
                    float ss = 0.f, v[8];
#pragma unroll
                    for (int n = 0; n < 2; ++n)
#pragma unroll
                        for (int j = 0; j < 4; ++j) { v[n * 4 + j] = acc[ai][0][m][n][j]; ss += v[n * 4 + j] * v[n * 4 + j]; }
                    st_bf16x8(DA + (unsigned)row * 384 + 256 + wc * 32 + 8 * fq, v);
                    ss += __shfl_xor(ss, 16); ss += __shfl_xor(ss, 32);
                    if (fq == 0) RSKV[row * 4 + wc] = ss;
                    if (wc == 0) {
                        f32x4 x1 = acc[ai][1][m][0], x2 = acc[ai][1][m][1];
                        if (lat) { const f32x4 o1 = x1 * rc - x2 * rsn, o2 = x1 * rsn + x2 * rc; x1 = o1; x2 = o2; }
                        st_bf16x4(KPE + (unsigned)row * 32 + 4 * fq, x1[0], x1[1], x1[2], x1[3]);
                        st_bf16x4(KPE + (unsigned)row * 32 + 16 + 4 * fq, x2[0], x2[1], x2[2], x2[3]);
                    }
                    rc = rcn; rsn = rsnn;
                }
        } else {
            const bool do_norm = (pc == 3) || (pc == 5 && wc < 2);
            const bool do_rope = (pc == 3 || pc == 4 || pc == 5) && lat;
            const float qs = (pc == 0 || pc == 3 || pc == 4) ? C2A : 1.f;
            const float* g = (pc == 3) ? gq : gk;
            const float* ch = rope; const float* sh = rope + SEQ * 32;
            unsigned dofs = 0, ld = 256; bool tr = false;
            if (pc == 0) dofs = (unsigned)(WS_QA / 2); else if (pc == 1) dofs = (unsigned)(WS_KA / 2); else if (pc == 3) dofs = (unsigned)(WS_QB / 2); else if (pc == 4) dofs = (unsigned)(WS_QC / 2);
            else if (pc == 5) { dofs = (unsigned)((wc < 2 ? WS_KB : WS_KC) / 2); ld = 128; }
            else if (pc == 2) { dofs = (unsigned)(WS_VTA / 2) + 64u * wc * MT; tr = true; }
            else { dofs = (unsigned)((wc < 2 ? WS_VTB : WS_VTC) / 2) + 64u * (wc & 1) * MT; tr = true; }
            if (!tr) dofs += (pc == 5 ? 64u * (wc & 1) : 64u * wc);
            bf16_t* const wsb = (bf16_t*)ws;
            f32x4 gA[2], gB[2];
#pragma unroll
            for (int n = 0; n < 2; ++n) { gA[n] = (f32x4){1.f, 1.f, 1.f, 1.f}; gB[n] = gA[n]; }
            if (do_norm) {
#pragma unroll
                for (int n = 0; n < 2; ++n) { gA[n] = *(const f32x4*)(g + 8 * fq + 4 * n); gB[n] = *(const f32x4*)(g + 32 + 8 * fq + 4 * n); }
            }
            f32x4 rc[2], rsn[2], rcn[2], rsnn[2];
#pragma unroll
            for (int n = 0; n < 2; ++n) { rc[n] = (f32x4){1.f, 1.f, 1.f, 1.f}; rsn[n] = (f32x4){0.f, 0.f, 0.f, 0.f}; rcn[n] = rc[n]; rsnn[n] = rsn[n]; }
            if (do_rope) {
                const int t0 = row0 & (SEQ - 1);
#pragma unroll
                for (int n = 0; n < 2; ++n) { rc[n] = *(const f32x4*)(ch + t0 * 32 + 8 * fq + 4 * n); rsn[n] = *(const f32x4*)(sh + t0 * 32 + 8 * fq + 4 * n); }
            }
#pragma unroll
            for (int ai = 0; ai < 2; ++ai)
#pragma unroll
                for (int m = 0; m < 4; ++m) {
                    asm volatile("" ::: "memory"); int row = row0 + ai * HALF + m * 16; asm volatile("" : "+v"(row));
                    if (do_rope && (ai * 4 + m) < 7) {
                        const int k1 = ai * 4 + m + 1, tn = (row0 + (k1 >> 2) * HALF + (k1 & 3) * 16) & (SEQ - 1);
#pragma unroll
                        for (int n = 0; n < 2; ++n) { rcn[n] = *(const f32x4*)(ch + tn * 32 + 8 * fq + 4 * n); rsnn[n] = *(const f32x4*)(sh + tn * 32 + 8 * fq + 4 * n); }
                    }
                    float rs = 1.f;
                    if (do_norm) {
                        float ss = 0.f;
#pragma unroll
                        for (int n = 0; n < 2; ++n)
#pragma unroll
                            for (int j = 0; j < 4; ++j) ss += acc[ai][0][m][n][j] * acc[ai][0][m][n][j] + acc[ai][1][m][n][j] * acc[ai][1][m][n][j];
                        ss += __shfl_xor(ss, 16); ss += __shfl_xor(ss, 32);
                        rs = rsqrtf(ss * (1.f / 64.f) + EPS);
                    }
#pragma unroll
                    for (int n = 0; n < 2; ++n) {
                        f32x4 x1 = acc[ai][0][m][n], x2 = acc[ai][1][m][n];
                        if (do_norm) { x1 = x1 * rs * gA[n]; x2 = x2 * rs * gB[n]; }
                        if (do_rope) { const f32x4 a = x1 * rc[n] - x2 * rsn[n], b = x1 * rsn[n] + x2 * rc[n]; x1 = a; x2 = b; }
                        x1 = x1 * qs; x2 = x2 * qs;
                        if (tr) {
#pragma unroll
                            for (int j = 0; j < 4; ++j) { wsb[dofs + (unsigned)(8 * fq + 4 * n + j) * MT + row] = f2bf(x1[j]); wsb[dofs + (unsigned)(32 + 8 * fq + 4 * n + j) * MT + row] = f2bf(x2[j]); }
                        } else {
                            st_bf16x4(wsb + dofs + (unsigned)row * ld + 8 * fq + 4 * n, x1[0], x1[1], x1[2], x1[3]);
                            st_bf16x4(wsb + dofs + (unsigned)row * ld + 32 + 8 * fq + 4 * n, x2[0], x2[1], x2[2], x2[3]);
                        }
                    }
#pragma unroll
                    for (int n = 0; n < 2; ++n) { rc[n] = rcn[n]; rsn[n] = rsnn[n]; }
                }
        }
    }
};

struct EpiMla {
    static constexpr bool PERM = true, AFTER_DRAIN = false, KEEP = false;
    unsigned char* ws; const float* rope;
    __device__ __forceinline__ void operator()(const f32x4 (&acc)[2][2][4][2], const Unit& u, int wr, int wc, int fr_, int fq_) const {
        int fr = fr_, fq = fq_; asm volatile("" : "+v"(fr), "+v"(fq));
        bf16_t* const QDN = (bf16_t*)(ws + WS_QDN); bf16_t* const QDP = (bf16_t*)(ws + WS_QDP); bf16_t* const KDN = (bf16_t*)(ws + WS_KDN); bf16_t* const VTD = (bf16_t*)(ws + WS_VTD);
        const float* const RSQ = (const float*)(ws + WS_RSQ); const float* const RSKV = (const float*)(ws + WS_RSKV);
        const int pc = u.pc, row0 = u.pm * BM + wr * 64 + fr;
        const bool lat = u.pm < ML / BM;
        const float* cr = rope + SEQ * 64; const float* sr = cr + SEQ * 16;
        float rs8[8];
        {
            f32x4 pq8[8];
#pragma unroll
            for (int k = 0; k < 8; ++k) pq8[k] = *(const f32x4*)((pc < 2 ? RSQ : RSKV) + (row0 + (k >> 2) * HALF + (k & 3) * 16) * 4);
#pragma unroll
            for (int k = 0; k < 8; ++k) rs8[k] = rsqrtf(((pq8[k][0] + pq8[k][1]) + (pq8[k][2] + pq8[k][3])) * (pc < 2 ? 1.f / 256.f : 1.f / 128.f) + EPS) * (pc < 2 ? C2D : 1.f);
        }
        const bool rope1 = (pc == 1) && lat;
        f32x4 rc = {1.f, 1.f, 1.f, 1.f}, rsn = {0.f, 0.f, 0.f, 0.f}, rcn = rc, rsnn = rsn;
        if (rope1) { const int t0 = row0 & (SEQ - 1); rc = *(const f32x4*)(cr + t0 * 16 + 4 * fq); rsn = *(const f32x4*)(sr + t0 * 16 + 4 * fq); }
#pragma unroll
        for (int ai = 0; ai < 2; ++ai)
#pragma unroll
            for (int m = 0; m < 4; ++m) {
                asm volatile("" ::: "memory"); int row = row0 + ai * HALF + m * 16; asm volatile("" : "+v"(row));
                if (rope1 && (ai * 4 + m) < 7) { const int k1 = ai * 4 + m + 1, tn = (row0 + (k1 >> 2) * HALF + (k1 & 3) * 16) & (SEQ - 1); rcn = *(const f32x4*)(cr + tn * 16 + 4 * fq); rsnn = *(const f32x4*)(sr + tn * 16 + 4 * fq); }
                const float rs = rs8[ai * 4 + m];
                if (pc == 1) {
                    float o1[4], o2[4];
#pragma unroll
                    for (int j = 0; j < 4; ++j) {
                        const float a = acc[ai][0][m][0][j] * rs, b = acc[ai][0][m][1][j] * rs;
                        const float c = rc[j], sn = rsn[j];
                        o1[j] = a * c - b * sn; o2[j] = a * sn + b * c;
                    }
                    rc = rcn; rsn = rsnn;
                    st_bf16x4(QDP + (unsigned)row * 128 + 32 * wc + 4 * fq, o1[0], o1[1], o1[2], o1[3]);
                    st_bf16x4(QDP + (unsigned)row * 128 + 32 * wc + 16 + 4 * fq, o2[0], o2[1], o2[2], o2[3]);
                } else {
                    float x1[8], x2[8];
#pragma unroll
                    for (int n = 0; n < 2; ++n)
#pragma unroll
                        for (int j = 0; j < 4; ++j) { x1[n * 4 + j] = acc[ai][0][m][n][j] * rs; x2[n * 4 + j] = acc[ai][1][m][n][j] * rs; }
                    if (pc == 3) {
                        bf16_t* vt = VTD + (unsigned)(64 * wc) * MT;
#pragma unroll
                        for (int i = 0; i < 8; ++i) { vt[(unsigned)(8 * fq + i) * MT + row] = f2bf(x1[i]); vt[(unsigned)(32 + 8 * fq + i) * MT + row] = f2bf(x2[i]); }
                    } else {
                        bf16_t* dst = (pc == 0 ? QDN : KDN) + (unsigned)row * 256 + 64 * wc;
                        st_bf16x8(dst + 8 * fq, x1); st_bf16x8(dst + 32 + 8 * fq, x2);
                    }
                }
            }
    }
};

struct EpiBranch {
    static constexpr bool PERM = true, AFTER_DRAIN = false, KEEP = true;
    bf16_t* MIX; const bf16_t* GATE;
    static __device__ __forceinline__ float gq(unsigned w, int b) { return fmaf((float)((w >> (8 * b)) & 0xffu), 1.f / 256.f, 1.f / 512.f); }
    __device__ __forceinline__ bool seg(f32x4 (&acc)[2][2][4][2], const Unit& u, int wr, int wc, int fr, int fq) const {
        const int row0 = u.pm * BM + wr * 64 + fr, col0 = u.pc * BM + wc * 32 + 8 * fq, s = u.seg;
        const unsigned char* gbase = (const unsigned char*)GATE + (unsigned)row0 * 4096 + s * 1024 + col0;
        const unsigned nxo = s < 3 ? 1024u : 0u;
        const bool notlast = s < 3;
#pragma unroll
        for (int ai = 0; ai < 2; ++ai)
#pragma unroll
            for (int mp = 0; mp < 2; ++mp) {
                u32x2 gc[2][2], gn[2][2];
                asm volatile("" ::: "memory");
#pragma unroll
                for (int mm = 0; mm < 2; ++mm)
#pragma unroll
                    for (int bj = 0; bj < 2; ++bj) { const unsigned char* gp = gbase + (unsigned)(ai * HALF + (2 * mp + mm) * 16) * 4096 + bj * HALF; gc[mm][bj] = *(const u32x2*)gp; gn[mm][bj] = *(const u32x2*)(gp + nxo); }
                asm volatile("" ::: "memory");
#pragma unroll
                for (int mm = 0; mm < 2; ++mm)
#pragma unroll
                    for (int bj = 0; bj < 2; ++bj) {
                        float v[8];
#pragma unroll
                        for (int n = 0; n < 2; ++n)
#pragma unroll
                            for (int j = 0; j < 4; ++j) {
                                const float gcv = gq(gc[mm][bj][n], j), rn = __builtin_amdgcn_rcpf(gq(gn[mm][bj][n], j));
                                acc[ai][bj][2 * mp + mm][n][j] *= notlast ? gcv * rn : gcv; v[n * 4 + j] = acc[ai][bj][2 * mp + mm][n][j];
                            }
                        if (!notlast) st_bf16x8(MIX + (unsigned)(row0 + ai * HALF + (2 * mp + mm) * 16) * D + col0 + bj * HALF, v);
                    }
            }
        return notlast;
    }
};
struct BranchOrder {
    StaticOrder T;
    __device__ void init(int M, int G_, int c_) { T.init(M, D, G_, c_); }
    __device__ bool next(int i, Unit& u) const { if (!T.next(i >> 2, u)) return false; u.seg = i & 3; u.koff = (i & 3) * 512; return true; }
    __device__ __forceinline__ void a_ready(const Unit&) const {}
    __device__ __forceinline__ void done(const Unit&) const {}
};
struct TailOrder {
    StaticOrder T; int c, nsplit, kpiece;
    __device__ void init(int G_, int c_, int nsplit_, int kpiece_) { T.init(ML, D, G_, c_); c = c_; nsplit = nsplit_; kpiece = kpiece_; }
    __device__ bool next(int i, Unit& u) const {
        if (i == 0) return T.next(0, u);
        if (i > 1 || c >= 32 * nsplit) return false;
        const int t = c / nsplit, p = c - t * nsplit;
        u.pm = ML / BM + (t >> 2); u.pn = t & 3; u.pc = u.pn; u.koff = p * kpiece * 2; u.seg = 1 + p; u.nt = kpiece / BK; return true;
    }
    __device__ __forceinline__ void a_ready(const Unit&) const {}
    __device__ __forceinline__ void done(const Unit&) const {}
};
struct EpiResidTail {
    static constexpr bool PERM = true, AFTER_DRAIN = false, KEEP = false;
    bf16_t* X; const float* gate; bf16_t* PART;
    __device__ __forceinline__ void operator()(const f32x4 (&acc)[2][2][4][2], const Unit& u, int wr, int wc, int fr, int fq) const {
        const int row0 = u.pm * BM + wr * 64 + fr, col0 = u.pc * BM + wc * 32 + 8 * fq;
        if (u.seg == 0) { resid_tile(acc, X, (unsigned)D, gate, row0, col0); return; }
        bf16_t* pp0 = PART + ((unsigned)(u.seg - 1) * MC + (unsigned)(row0 - ML)) * D + col0;
#pragma unroll
        for (int ai = 0; ai < 2; ++ai)
#pragma unroll
            for (int m = 0; m < 4; ++m)
#pragma unroll
                for (int bj = 0; bj < 2; ++bj) {
                    const f32x4 v0 = acc[ai][bj][m][0], v1 = acc[ai][bj][m][1];
                    u32x4 w; w.x = cvt_pk_bf16(v0[0], v0[1]); w.y = cvt_pk_bf16(v0[2], v0[3]); w.z = cvt_pk_bf16(v1[0], v1[1]); w.w = cvt_pk_bf16(v1[2], v1[3]);
                    *(u32x4*)(pp0 + (unsigned)(ai * HALF + m * 16) * D + bj * HALF) = w;
                }
    }
};
struct InprojLastOrder {
    StaticOrder T; int G, c;
    __device__ void init(int G_, int c_) { T.init(ML, INWP, G_, c_); G = G_; c = c_; }
    __device__ bool next(int i, Unit& u) const {
        const int L = i * G + c, nlat = (ML / BM) * (INWP / BM);
        if (L < nlat) return T.next(i, u);
        const int q = L - nlat; if (q >= (MC / BM) * 9) return false;
        u.pm = ML / BM + q / 9; u.pn = q % 9; u.pc = u.pn; u.koff = 0; u.seg = 0; u.nt = 0; return true;
    }
    __device__ __forceinline__ void a_ready(const Unit&) const {}
    __device__ __forceinline__ void done(const Unit&) const {}
};
struct MoeDownOrder {
    int nP, G, c, khalf; const PG8_LAS int* pexp;
    __device__ void init(int nP_, int G_, int c_, int khalf_, const PG8_LAS int* pexp_) { nP = nP_; G = G_; c = c_; khalf = khalf_; pexp = pexp_; }
    __device__ bool next(int i, Unit& u) const {
        const int nfull = YSPLIT_P0 * 4;
        int L, half = -1;
        if (i * G + c < nfull) {
            const int L0 = i * G + c, wgid = (L0 % NXCD) * (nfull / NXCD) + L0 / NXCD, gid = wgid / (WGM * 4), w = wgid % (WGM * 4);
            L = (gid * WGM + (w % WGM)) * 4 + w / WGM;
        } else { const int q = (i * G + c) - nfull; L = nfull + (q >> 1); half = q & 1; }
        if (L >= nP * 4) return false;
        u.pm = L >> 2; u.pc = L & 3; u.pn = pexp[u.pm] * 4 + u.pc; u.koff = half > 0 ? khalf * 2 : 0; u.seg = half + 1; u.nt = half >= 0 ? khalf / BK : 0; return true;
    }
    __device__ __forceinline__ void a_ready(const Unit&) const {}
    __device__ __forceinline__ void done(const Unit&) const {}
};
struct EpiY {
    static constexpr bool PERM = true, AFTER_DRAIN = false, KEEP = false;
    bf16_t *Y, *Y2;
    __device__ __forceinline__ void operator()(const f32x4 (&acc)[2][2][4][2], const Unit& u, int wr, int wc, int fr, int fq) const {
        const int row0 = u.pm * BM + wr * 64 + fr, col0 = u.pc * BM + wc * 32 + 8 * fq;
        bf16_t* base = (u.seg == 2) ? Y2 - (unsigned)(YSPLIT_P0 * BM) * D : Y;
#pragma unroll
        for (int ai = 0; ai < 2; ++ai)
#pragma unroll
            for (int m = 0; m < 4; ++m) {
                bf16_t* rowp = base + (unsigned)(row0 + ai * HALF + m * 16) * D + col0;
#pragma unroll
                for (int bj = 0; bj < 2; ++bj) {
                    const f32x4 v0 = acc[ai][bj][m][0], v1 = acc[ai][bj][m][1];
                    u32x4 w; w.x = cvt_pk_bf16(v0[0], v0[1]); w.y = cvt_pk_bf16(v0[2], v0[3]); w.z = cvt_pk_bf16(v1[0], v1[1]); w.w = cvt_pk_bf16(v1[2], v1[3]);
                    *(u32x4*)(rowp + bj * HALF) = w;
                }
            }
    }
};
template <class Epi, class Sched, bool ALIGN_EPI = false, bool SP2 = false>
__device__ __forceinline__ void gemm_phase(PG8_LAS unsigned char* lds, const Gemm g, const Sched& S, const Epi& E) {
    int tid_ = threadIdx.x; asm volatile("" : "+v"(tid_));
    const int tid = tid_, wid = __builtin_amdgcn_readfirstlane(tid >> 6), lane = tid & 63, wr = wid >> 2, wc = wid & 3, fr = lane & 15, fq = lane >> 4;
    const int K = g.K, ntdef = K / BK; const int lda = g.lda, ldb = g.ldb;
    unsigned voffA[2], voffB[2];
#pragma unroll
    for (int i = 0; i < 2; ++i) { int R, C; stage_rc(tid * 16 + i * 8192, R, C); const int Rb = Epi::PERM ? ((R & ~31) + perm32(R & 31)) : R;
        voffA[i] = (unsigned)(R * lda + C) * 2u; voffB[i] = (unsigned)(Rb * ldb + C) * 2u; }
    const size_t kstep = (size_t)(BK * 2);
    const size_t hstepA = (size_t)HALF * lda * 2, hstepB = (size_t)HALF * ldb * 2;
    const size_t tstepA = 2 * hstepA, tstepB = 2 * hstepB;
    const unsigned ldsw = (unsigned)wid * 1024u;
    const int aoff = lds_byte(wr * 64 + fr, fq * 8), boff = lds_byte(wc * 32 + fr, fq * 8);
#define PG8_SA(b, h) (((b) * 2 + (h)) * HTB)
#define PG8_SB(b, h) ((4 + (b) * 2 + (h)) * HTB)
#define PG8_STAGE(bufoff, gbase, voff) do { _Pragma("unroll") for (int _i = 0; _i < 2; ++_i) \
        __builtin_amdgcn_global_load_lds((const unsigned*)((const char*)(gbase) + (voff)[_i]), (PG8_LAS unsigned*)(lds + (bufoff) + ldsw + _i * 8192), 16, 0, 0); } while (0)
#define PG8_LDA(dst, b, h) do { _Pragma("unroll") for (int m = 0; m < 4; ++m) _Pragma("unroll") for (int k = 0; k < 2; ++k) dst[m][k] = *(const PG8_LAS bf16x8*)(lds + PG8_SA(b, h) + aoff + m * 2048 + k * 1024); } while (0)
#define PG8_LDB(dst, b, h) do { _Pragma("unroll") for (int n = 0; n < 2; ++n) _Pragma("unroll") for (int k = 0; k < 2; ++k) dst[n][k] = *(const PG8_LAS bf16x8*)(lds + PG8_SB(b, h) + boff + n * 2048 + k * 1024); } while (0)
#define PG8_MMA(ai, bj, At, Bt) do { __builtin_amdgcn_s_setprio(1); _Pragma("unroll") for (int m = 0; m < 4; ++m) _Pragma("unroll") for (int n = 0; n < 2; ++n) _Pragma("unroll") for (int k = 0; k < 2; ++k) \
        acc[ai][bj][m][n] = __builtin_amdgcn_mfma_f32_16x16x32_bf16(Bt[n][k], At[m][k], acc[ai][bj][m][n], 0, 0, 0); __builtin_amdgcn_s_setprio(0); } while (0)
#define PG8_WAIT_V(n) asm volatile("s_waitcnt vmcnt(" #n ")" ::: "memory")
#define PG8_WAIT_L(n) asm volatile("s_waitcnt lgkmcnt(" #n ")" ::: "memory")
#define PG8_BAR __builtin_amdgcn_s_barrier()
#define PG8_SCHED __builtin_amdgcn_sched_barrier(0)
    Unit cur, nxt; int ui = 0;
    if (!S.next(0, cur)) return;
    f32x4 acc[2][2][4][2];
#pragma unroll
    for (int a = 0; a < 2; ++a)
#pragma unroll
        for (int b = 0; b < 2; ++b)
#pragma unroll
            for (int m = 0; m < 4; ++m)
#pragma unroll
                for (int n = 0; n < 2; ++n) acc[a][b][m][n] = (f32x4){0.f, 0.f, 0.f, 0.f};
    bf16x8 At[4][2], B0[2][2], B1[2][2];
    const char* cA = (const char*)g.A + (size_t)cur.pm * tstepA + cur.koff; const char* cB = (const char*)g.Bt + (size_t)cur.pn * tstepB + cur.koff;
    S.a_ready(cur);
    if constexpr (SP2) {
        PG8_STAGE(PG8_SB(0, 0), cB, voffB); PG8_STAGE(PG8_SB(0, 1), cB + hstepB, voffB); PG8_STAGE(PG8_SA(0, 0), cA, voffA); PG8_STAGE(PG8_SA(0, 1), cA + hstepA, voffA);
        if (wr == 1) PG8_BAR;
        PG8_WAIT_V(2); PG8_BAR;
        PG8_STAGE(PG8_SB(1, 0), cB + kstep, voffB); PG8_STAGE(PG8_SA(1, 0), cA + kstep, voffA); PG8_STAGE(PG8_SB(1, 1), cB + hstepB + kstep, voffB);
        PG8_WAIT_V(6); PG8_BAR;
    } else {
        PG8_STAGE(PG8_SB(0, 0), cB, voffB); PG8_STAGE(PG8_SA(0, 0), cA, voffA); PG8_STAGE(PG8_SB(0, 1), cB + hstepB, voffB); PG8_STAGE(PG8_SA(0, 1), cA + hstepA, voffA);
        if (wr == 1) PG8_BAR;
        PG8_WAIT_V(4); PG8_BAR;
        PG8_STAGE(PG8_SB(1, 0), cB + kstep, voffB); PG8_STAGE(PG8_SA(1, 0), cA + kstep, voffA); PG8_STAGE(PG8_SB(1, 1), cB + hstepB + kstep, voffB);
        PG8_WAIT_V(6); PG8_BAR;
    }
    for (;;) {
        const int nt = cur.nt ? cur.nt : ntdef;
        const bool has_next = S.next(ui + 1, nxt);
        const char* nA = has_next ? (const char*)g.A + (size_t)nxt.pm * tstepA + nxt.koff : cA; const char* nB = has_next ? (const char*)g.Bt + (size_t)nxt.pn * tstepB + nxt.koff : cB;
#pragma nounroll
        for (int t = 0; t < nt; t += 2) {
            const bool last = (t == nt - 2);
            const char* a1 = cA + (size_t)(t + 1) * kstep;
            const char* a2 = last ? nA : cA + (size_t)(t + 2) * kstep; const char* b2 = last ? nB : cB + (size_t)(t + 2) * kstep;
            const char* a3 = a2 + kstep; const char* b3 = b2 + kstep;
            if (last && has_next) S.a_ready(nxt);
            if constexpr (SP2) {
            PG8_LDB(B0, 0, 0); PG8_LDB(B1, 0, 1); PG8_SCHED; PG8_LDA(At, 0, 0); PG8_STAGE(PG8_SA(1, 1), a1 + hstepA, voffA);
            PG8_WAIT_V(8); PG8_WAIT_L(0); PG8_BAR; PG8_MMA(0, 0, At, B0); PG8_MMA(0, 1, At, B1); PG8_BAR; PG8_SCHED;
            PG8_LDA(At, 0, 1); PG8_STAGE(PG8_SB(0, 0), b2, voffB); PG8_STAGE(PG8_SB(0, 1), b2 + hstepB, voffB); PG8_STAGE(PG8_SA(0, 0), a2, voffA);
            PG8_WAIT_V(8); PG8_WAIT_L(0); PG8_BAR; PG8_MMA(1, 0, At, B0); PG8_MMA(1, 1, At, B1); PG8_BAR; PG8_SCHED;
            PG8_LDB(B0, 1, 0); PG8_LDB(B1, 1, 1); PG8_SCHED; PG8_LDA(At, 1, 0); PG8_STAGE(PG8_SA(0, 1), a2 + hstepA, voffA);
            PG8_WAIT_V(8); PG8_WAIT_L(0); PG8_BAR; PG8_MMA(0, 0, At, B0); PG8_MMA(0, 1, At, B1); PG8_BAR; PG8_SCHED;
            PG8_LDA(At, 1, 1); PG8_STAGE(PG8_SB(1, 0), b3, voffB); PG8_STAGE(PG8_SB(1, 1), b3 + hstepB, voffB); PG8_STAGE(PG8_SA(1, 0), a3, voffA);
            PG8_WAIT_V(8); PG8_WAIT_L(0); PG8_BAR; PG8_MMA(1, 0, At, B0); PG8_MMA(1, 1, At, B1); PG8_BAR; PG8_SCHED;
            } else {
            PG8_LDB(B0, 0, 0); PG8_SCHED; PG8_LDA(At, 0, 0); PG8_STAGE(PG8_SA(1, 1), a1 + hstepA, voffA);
            PG8_WAIT_L(8); PG8_BAR; PG8_WAIT_L(0); PG8_MMA(0, 0, At, B0); PG8_BAR; PG8_SCHED;
            PG8_LDB(B1, 0, 1); PG8_STAGE(PG8_SB(0, 0), b2, voffB);
            PG8_BAR; PG8_WAIT_L(0); PG8_MMA(0, 1, At, B1); PG8_BAR;
            PG8_LDA(At, 0, 1); PG8_STAGE(PG8_SA(0, 0), a2, voffA);
            PG8_BAR; PG8_WAIT_L(0); PG8_MMA(1, 0, At, B0); PG8_BAR; PG8_SCHED;
            PG8_STAGE(PG8_SB(0, 1), b2 + hstepB, voffB);
            PG8_WAIT_V(6); PG8_BAR; PG8_MMA(1, 1, At, B1); PG8_BAR;
            PG8_LDB(B0, 1, 0); PG8_SCHED; PG8_LDA(At, 1, 0); PG8_STAGE(PG8_SA(0, 1), a2 + hstepA, voffA);
            PG8_WAIT_L(8); PG8_BAR; PG8_WAIT_L(0); PG8_MMA(0, 0, At, B0); PG8_BAR; PG8_SCHED;
            PG8_LDB(B1, 1, 1); PG8_STAGE(PG8_SB(1, 0), b3, voffB);
            PG8_BAR; PG8_WAIT_L(0); PG8_MMA(0, 1, At, B1); PG8_BAR;
            PG8_LDA(At, 1, 1); PG8_STAGE(PG8_SA(1, 0), a3, voffA);
            PG8_BAR; PG8_WAIT_L(0); PG8_MMA(1, 0, At, B0); PG8_BAR; PG8_SCHED;
            PG8_STAGE(PG8_SB(1, 1), b3 + hstepB, voffB);
            PG8_WAIT_V(6); PG8_BAR; PG8_MMA(1, 1, At, B1); PG8_BAR;
            }
        }
        if constexpr (ALIGN_EPI) { if (wr == 0) PG8_BAR; }
        bool keep = false;
        if constexpr (Epi::KEEP) keep = E.seg(acc, cur, wr, wc, fr, fq); else { E(acc, cur, wr, wc, fr, fq); }
        S.done(cur);
        if (!has_next) break;
        if (!keep) {
#pragma unroll
        for (int a = 0; a < 2; ++a)
#pragma unroll
            for (int b = 0; b < 2; ++b)
#pragma unroll
                for (int m = 0; m < 4; ++m)
#pragma unroll
                    for (int n = 0; n < 2; ++n) acc[a][b][m][n] = (f32x4){0.f, 0.f, 0.f, 0.f};
        }
        cur = nxt; cA = nA; cB = nB; ++ui;
        if constexpr (ALIGN_EPI) { if (wr == 1) PG8_BAR; }
    }
    PG8_WAIT_V(0);
    if constexpr (!ALIGN_EPI) { if (wr == 0) PG8_BAR; }
    PG8_BAR;
#undef PG8_SA
#undef PG8_SB
#undef PG8_STAGE
#undef PG8_LDA
#undef PG8_LDB
#undef PG8_MMA
#undef PG8_WAIT_V
#undef PG8_WAIT_L
#undef PG8_BAR
#undef PG8_SCHED
}
}

__device__ __forceinline__ float bf2f(unsigned short b) { return __uint_as_float(((unsigned)b) << 16); }

namespace at {
typedef short bf16x8 __attribute__((ext_vector_type(8)));
typedef float f32x16 __attribute__((ext_vector_type(16)));
typedef float f32x2v __attribute__((ext_vector_type(2)));
typedef unsigned short bf16_t;
constexpr int VST = 144;
constexpr int KBYTES = 64 * 208, VBYTES = 64 * VST, BUFB = KBYTES + VBYTES;
constexpr int RPB_OFF = 2 * BUFB;
constexpr float LOG2E = 1.4426950408889634f;
enum { PLAIN = 0, WINDOW = 1, NATTEN = 2 };
struct Unit {
    const bf16_t *Q, *Q2, *K, *K2, *VT; bf16_t* O;
    int ldq, ldq2, ldk;
    int qrow0;
    int ntile, nloc, krow_loc0, krow_ctx0;
    int t0, j0;
    int rr, c0, krlo;
    float sink2; int has_sink;
};
__device__ __forceinline__ int sig(int r) { return (r & ~12) | ((r & 4) << 1) | ((r & 8) >> 1); }
__device__ __forceinline__ bf16x8 pack8(const f32x16& p, int s) {
    pg8::u32x4 w;
    w.x = pg8::cvt_pk_bf16(p[8 * s + 0], p[8 * s + 1]); w.y = pg8::cvt_pk_bf16(p[8 * s + 2], p[8 * s + 3]);
    w.z = pg8::cvt_pk_bf16(p[8 * s + 4], p[8 * s + 5]); w.w = pg8::cvt_pk_bf16(p[8 * s + 6], p[8 * s + 7]);
    return __builtin_bit_cast(bf16x8, w);
}
template <int DQK, int MODE>
__device__ __forceinline__ void attn_unit(unsigned char* lds_, const Unit& U, int tid) {
    static_assert(DQK == 64 && MODE != PLAIN, "masked 64-dim units only");
    typedef __attribute__((address_space(3))) unsigned char* ldsp_t;
    constexpr int NKS = DQK / 16, TK = 8192, TILE = 16384;
    const ldsp_t ldsl = (ldsp_t)lds_;
    unsigned char* const lds = lds_;
    const int lane = tid & 63, r = lane & 31, h = lane >> 5;
    const int wave = __builtin_amdgcn_readfirstlane(tid >> 6);
    bf16x8 qf[NKS];
    {
        const bf16_t* qp = U.Q + (unsigned)(U.qrow0 + r) * U.ldq + 8 * h;
#pragma unroll
        for (int ks = 0; ks < 4; ++ks) qf[ks] = *(const bf16x8*)(qp + 16 * ks);
    }
    f32x16 o0, o1;
#pragma unroll
    for (int i = 0; i < 16; ++i) { o0[i] = 0.f; o1[i] = 0.f; }
    float m = 0.f, lsum = 0.f;
    f32x16 negm;
#pragma unroll
    for (int i = 0; i < 16; ++i) negm[i] = 0.f;
    asm volatile("" : "+v"(negm));
    unsigned vm0 = 0u, vm1 = 0u; int vb = 0;
    if (MODE == NATTEN) {
        const int qc = U.c0 + r;
        int cst = qc - 8; cst = cst < 0 ? 0 : (cst > 48 ? 48 : cst);
#pragma unroll
        for (int i = 0; i < 16; ++i) {
            const int kc = 8 * h + (i & 7) + 16 * (i >> 3), e0 = kc - cst, e1 = kc + 32 - cst;
            if (e0 >= 0 && e0 < 16) vm0 |= 1u << i;
            if (e1 >= 0 && e1 < 16) vm1 |= 1u << i;
        }
        vb = 8 * h - qc + 15;
    }
    constexpr float THR = 8.f;
    const int drow = 8 * wave + (lane >> 3), dch = (lane & 7) ^ ((drow >> 1) & 7);
    const int sr = sig(r);
    unsigned kx[4], vx[4];
#pragma unroll
    for (int j = 0; j < 4; ++j) { kx[j] = (unsigned)(sr * 128 + (((2 * j + h) ^ ((sr >> 1) & 7)) << 4)); vx[j] = (unsigned)(TK + r * 128 + (((2 * j + h) ^ ((r >> 1) & 7)) << 4)); }
    auto tile_krow = [&](int ti) { return ti < U.nloc ? U.krow_loc0 + 64 * ti : U.krow_ctx0 + 64 * (ti - U.nloc); };
    auto issue = [&](int ti) {
        const int kr0 = tile_krow(ti); const unsigned pa = (unsigned)((ti & 1) * TILE + wave * 1024);
        __builtin_amdgcn_global_load_lds((const unsigned*)(U.K + (unsigned)(kr0 + drow) * U.ldk + dch * 8), (__attribute__((address_space(3))) unsigned*)(ldsl + pa), 16, 0, 0);
        __builtin_amdgcn_global_load_lds((const unsigned*)(U.VT + (unsigned)drow * MT + kr0 + dch * 8), (__attribute__((address_space(3))) unsigned*)(ldsl + pa + TK), 16, 0, 0);
    };
    auto need_of = [&](int ti, bool& masked, int& jt, int& kr) -> bool {
        bool need = true; masked = false; jt = 0; kr = 0;
        if (MODE == WINDOW && ti < U.nloc) {
            jt = U.j0 + 64 * ti;
            need = (jt + 63 >= U.t0 - 128) && (jt <= U.t0 + 31 + 128);
            masked = !((jt >= U.t0 + 31 - 128) && (jt + 63 <= U.t0 + 128));
        }
        if (MODE == NATTEN && ti < U.nloc) {
            kr = U.krlo + ti;
            int s0 = U.rr - 4; s0 = s0 < 0 ? 0 : (s0 > 24 ? 24 : s0);
            need = (kr >= s0) && (kr < s0 + 8);
            masked = true;
        }
        return need;
    };
    f32x16 c0, c1;
    issue(0);
    for (int ti = 0; ti < U.ntile; ++ti) {
        asm volatile("s_waitcnt vmcnt(0)" ::: "memory");
        __syncthreads();
        if (ti + 1 < U.ntile) issue(ti + 1);
        bool mk_c; int jt_c, kr_c;
        if (need_of(ti, mk_c, jt_c, kr_c)) {
            const ldsp_t tb = ldsl + (ti & 1) * TILE;
            {
#pragma unroll
                for (int ks = 0; ks < NKS; ++ks) {
                    const bf16x8 a0 = *(const __attribute__((address_space(3))) bf16x8*)(tb + kx[ks]), a1 = *(const __attribute__((address_space(3))) bf16x8*)(tb + kx[ks] + 32 * 128);
                    c0 = __builtin_amdgcn_mfma_f32_32x32x16_bf16(a0, qf[ks], ks == 0 ? negm : c0, 0, 0, 0);
                    c1 = __builtin_amdgcn_mfma_f32_32x32x16_bf16(a1, qf[ks], ks == 0 ? negm : c1, 0, 0, 0);
                }
            }
            if (mk_c) {
                if (MODE == WINDOW) {
                    const int t = U.t0 + r;
#pragma unroll
                    for (int i = 0; i < 16; ++i) {
                        const int j = jt_c + 8 * h + (i & 7) + 16 * (i >> 3);
                        const int d0 = t - j, d1 = t - (j + 32);
                        if (d0 > 128 || d0 < -128) c0[i] = -INFINITY;
                        if (d1 > 128 || d1 < -128) c1[i] = -INFINITY;
                    }
                }
                if (MODE == NATTEN) {
                    const float* rp = (const float*)(lds + RPB_OFF) + (kr_c - U.rr + 7) * 31 + vb;
#pragma unroll
                    for (int i = 0; i < 16; ++i) {
                        const int ko = (i & 7) + 16 * (i >> 3);
                        c0[i] = ((vm0 >> i) & 1u) ? c0[i] + rp[ko] : -INFINITY;
                        c1[i] = ((vm1 >> i) & 1u) ? c1[i] + rp[ko + 32] : -INFINITY;
                    }
                }
            }
            float mx = fmaxf(c0[0], c1[0]);
#pragma unroll
            for (int i = 1; i < 16; ++i) mx = fmaxf(fmaxf(mx, c0[i]), c1[i]);
            mx = fmaxf(mx, __shfl_xor(mx, 32));
            const bool grow = mx > THR, init = (lsum == 0.f) && (mx < -THR) && (mx > -1e30f);
            if (__any(grow || init)) {
                const float d = (grow || init) ? mx : 0.f;
                const float alpha = init ? 1.f : __builtin_amdgcn_exp2f(-d);
                m += d; lsum *= alpha;
#pragma unroll
                for (int i = 0; i < 16; ++i) { o0[i] *= alpha; o1[i] *= alpha; c0[i] -= d; c1[i] -= d; negm[i] -= d; }
                asm volatile("" : "+v"(negm));
            }
            f32x2v ps2 = {0.f, 0.f};
#pragma unroll
            for (int i = 0; i < 8; ++i) {
                c0[2 * i] = __builtin_amdgcn_exp2f(c0[2 * i]); c0[2 * i + 1] = __builtin_amdgcn_exp2f(c0[2 * i + 1]);
                c1[2 * i] = __builtin_amdgcn_exp2f(c1[2 * i]); c1[2 * i + 1] = __builtin_amdgcn_exp2f(c1[2 * i + 1]);
                const f32x2v a = {c0[2 * i], c0[2 * i + 1]}, bq = {c1[2 * i], c1[2 * i + 1]}; ps2 += a; ps2 += bq;
            }
            lsum += ps2.x + ps2.y;
#pragma unroll
            for (int s = 0; s < 2; ++s) {
                const bf16x8 p0 = pack8(c0, s), p1 = pack8(c1, s);
                const bf16x8 v00 = *(const __attribute__((address_space(3))) bf16x8*)(tb + vx[s]), v01 = *(const __attribute__((address_space(3))) bf16x8*)(tb + vx[s] + 32 * 128);
                const bf16x8 v10 = *(const __attribute__((address_space(3))) bf16x8*)(tb + vx[2 + s]), v11 = *(const __attribute__((address_space(3))) bf16x8*)(tb + vx[2 + s] + 32 * 128);
                o0 = __builtin_amdgcn_mfma_f32_32x32x16_bf16(v00, p0, o0, 0, 0, 0);
                o1 = __builtin_amdgcn_mfma_f32_32x32x16_bf16(v01, p0, o1, 0, 0, 0);
                o0 = __builtin_amdgcn_mfma_f32_32x32x16_bf16(v10, p1, o0, 0, 0, 0);
                o1 = __builtin_amdgcn_mfma_f32_32x32x16_bf16(v11, p1, o1, 0, 0, 0);
            }
        }
    }
    float l = lsum + __shfl_xor(lsum, 32);
    if (U.has_sink) l += __builtin_amdgcn_exp2f(U.sink2 - m);
    const float inv = 1.f / l;
    bf16_t* op = U.O + (unsigned)(U.qrow0 + r) * D + 4 * h;
#pragma unroll
    for (int g = 0; g < 4; ++g) {
        pg8::st_bf16x4(op + 8 * g, o0[4 * g] * inv, o0[4 * g + 1] * inv, o0[4 * g + 2] * inv, o0[4 * g + 3] * inv);
        pg8::st_bf16x4(op + 32 + 8 * g, o1[4 * g] * inv, o1[4 * g + 1] * inv, o1[4 * g + 2] * inv, o1[4 * g + 3] * inv);
    }
    __syncthreads();
}
template <int DQK>
__device__ __forceinline__ void attn_plain2(unsigned char* lds_, const Unit& U, int tid) {
    typedef __attribute__((address_space(3))) unsigned char* ldsp_t;
    constexpr int NKS = DQK / 16;
    constexpr int TK = 8192, TK2 = (DQK == 96 ? 4096 : 0), TV = 8192, TILE = TK + TK2 + TV, B2 = 2 * TILE;
    constexpr float THR = 8.f;
    const ldsp_t lds = (ldsp_t)lds_;
    const int lane = tid & 63, r = lane & 31, h = lane >> 5;
    const int wave = __builtin_amdgcn_readfirstlane(tid >> 6);
    bf16x8 qf[NKS];
    {
        const bf16_t* qp = U.Q + (unsigned)(U.qrow0 + r) * U.ldq + 8 * h;
#pragma unroll
        for (int ks = 0; ks < 4; ++ks) qf[ks] = *(const bf16x8*)(qp + 16 * ks);
        if (DQK == 96) {
            const bf16_t* qp2 = U.Q2 + (unsigned)(U.qrow0 + r) * U.ldq2 + 8 * h;
#pragma unroll
            for (int ks = 4; ks < NKS; ++ks) qf[ks] = *(const bf16x8*)(qp2 + 16 * (ks - 4));
        }
    }
    f32x16 o0, o1;
#pragma unroll
    for (int i = 0; i < 16; ++i) { o0[i] = 0.f; o1[i] = 0.f; }
    float m = 0.f, lsum = 0.f;
    f32x16 negm;
#pragma unroll
    for (int i = 0; i < 16; ++i) negm[i] = 0.f;
    asm volatile("" : "+v"(negm));
    const int drow = 8 * wave + (lane >> 3), dch = (lane & 7) ^ ((drow >> 1) & 7);
    const int d2row = 16 * wave + (lane >> 2), d2ch = (lane & 3) ^ ((d2row >> 2) & 3);
    const int sr = sig(r);
    unsigned kx[4], vx[4], k2x[2];
#pragma unroll
    for (int j = 0; j < 4; ++j) { kx[j] = (unsigned)(sr * 128 + (((2 * j + h) ^ ((sr >> 1) & 7)) << 4)); vx[j] = (unsigned)(TK + TK2 + r * 128 + (((2 * j + h) ^ ((r >> 1) & 7)) << 4)); }
#pragma unroll
    for (int j = 0; j < 2; ++j) k2x[j] = (unsigned)(TK + sr * 64 + (((2 * j + h) ^ ((sr >> 2) & 3)) << 4));
    auto tile_krow = [&](int ti) { return ti < U.nloc ? U.krow_loc0 + 64 * ti : U.krow_ctx0 + 64 * (ti - U.nloc); };
#define AT_DMA(src, dstoff) __builtin_amdgcn_global_load_lds((const unsigned*)(src), (__attribute__((address_space(3))) unsigned*)(lds + (dstoff)), 16, 0, 0)
    auto issue = [&](int si, const int buf) {
        const int ka0 = tile_krow(2 * si), kb0 = tile_krow(2 * si + 1);
        const unsigned pa = (unsigned)(buf * B2 + wave * 1024), pb = pa + TILE;
        AT_DMA(U.K + (unsigned)(ka0 + drow) * U.ldk + dch * 8, pa);
        AT_DMA(U.K + (unsigned)(kb0 + drow) * U.ldk + dch * 8, pb);
        if (DQK == 96) { if (wave < 4) { AT_DMA(U.K2 + (unsigned)(ka0 + d2row) * 32 + d2ch * 8, pa + TK); AT_DMA(U.K2 + (unsigned)(kb0 + d2row) * 32 + d2ch * 8, pb + TK); } }
        AT_DMA(U.VT + (unsigned)drow * MT + ka0 + dch * 8, pa + TK + TK2);
        AT_DMA(U.VT + (unsigned)drow * MT + kb0 + dch * 8, pb + TK + TK2);
    };
    const int nstep = U.ntile >> 1;
    auto step = [&](int si, const int buf) {
        asm volatile("s_waitcnt vmcnt(0)" ::: "memory");
        __syncthreads();
        if (si + 1 < nstep) issue(si + 1, buf ^ 1);
        const ldsp_t ba = lds + buf * B2; const ldsp_t bb = ba + TILE;
        f32x16 a0, a1, b0, b1;
        {
#pragma unroll
            for (int ks = 0; ks < NKS; ++ks) {
                const unsigned ko = ks < 4 ? kx[ks & 3] : k2x[(ks - 4) & 1]; const int hs = ks < 4 ? 32 * 128 : 32 * 64;
                const bf16x8 fa0 = *(const __attribute__((address_space(3))) bf16x8*)(ba + ko), fa1 = *(const __attribute__((address_space(3))) bf16x8*)(ba + ko + hs);
                const bf16x8 fb0 = *(const __attribute__((address_space(3))) bf16x8*)(bb + ko), fb1 = *(const __attribute__((address_space(3))) bf16x8*)(bb + ko + hs);
                a0 = __builtin_amdgcn_mfma_f32_32x32x16_bf16(fa0, qf[ks], ks == 0 ? negm : a0, 0, 0, 0);
                b0 = __builtin_amdgcn_mfma_f32_32x32x16_bf16(fb0, qf[ks], ks == 0 ? negm : b0, 0, 0, 0);
                a1 = __builtin_amdgcn_mfma_f32_32x32x16_bf16(fa1, qf[ks], ks == 0 ? negm : a1, 0, 0, 0);
                b1 = __builtin_amdgcn_mfma_f32_32x32x16_bf16(fb1, qf[ks], ks == 0 ? negm : b1, 0, 0, 0);
            }
        }
        float mx = fmaxf(a0[0], a1[0]), my = fmaxf(b0[0], b1[0]);
#pragma unroll
        for (int i = 1; i < 16; ++i) { mx = fmaxf(fmaxf(mx, a0[i]), a1[i]); my = fmaxf(fmaxf(my, b0[i]), b1[i]); }
        mx = fmaxf(mx, my);
        mx = fmaxf(mx, __shfl_xor(mx, 32));
        const bool grow = mx > THR, init = (lsum == 0.f) && (mx < -THR) && (mx > -1e30f);
        if (__any(grow || init)) {
            const float d = (grow || init) ? mx : 0.f;
            const float alpha = init ? 1.f : __builtin_amdgcn_exp2f(-d);
            m += d; lsum *= alpha;
#pragma unroll
            for (int i = 0; i < 16; ++i) { o0[i] *= alpha; o1[i] *= alpha; a0[i] -= d; a1[i] -= d; b0[i] -= d; b1[i] -= d; negm[i] -= d; }
            asm volatile("" : "+v"(negm));
        }
        f32x2v ps2 = {0.f, 0.f}, pt2 = {0.f, 0.f};
#pragma unroll
        for (int i = 0; i < 8; ++i) {
            a0[2 * i] = __builtin_amdgcn_exp2f(a0[2 * i]); a0[2 * i + 1] = __builtin_amdgcn_exp2f(a0[2 * i + 1]);
            a1[2 * i] = __builtin_amdgcn_exp2f(a1[2 * i]); a1[2 * i + 1] = __builtin_amdgcn_exp2f(a1[2 * i + 1]);
            const f32x2v x = {a0[2 * i], a0[2 * i + 1]}, y = {a1[2 * i], a1[2 * i + 1]}; ps2 += x; ps2 += y;
        }
#pragma unroll
        for (int st = 0; st < 2; ++st) {
            const bf16x8 p0 = pack8(a0, st), p1 = pack8(a1, st);
            const bf16x8 v00 = *(const __attribute__((address_space(3))) bf16x8*)(ba + vx[st]), v01 = *(const __attribute__((address_space(3))) bf16x8*)(ba + vx[st] + 32 * 128);
            const bf16x8 v10 = *(const __attribute__((address_space(3))) bf16x8*)(ba + vx[2 + st]), v11 = *(const __attribute__((address_space(3))) bf16x8*)(ba + vx[2 + st] + 32 * 128);
            o0 = __builtin_amdgcn_mfma_f32_32x32x16_bf16(v00, p0, o0, 0, 0, 0);
            o1 = __builtin_amdgcn_mfma_f32_32x32x16_bf16(v01, p0, o1, 0, 0, 0);
            o0 = __builtin_amdgcn_mfma_f32_32x32x16_bf16(v10, p1, o0, 0, 0, 0);
            o1 = __builtin_amdgcn_mfma_f32_32x32x16_bf16(v11, p1, o1, 0, 0, 0);
        }
#pragma unroll
        for (int i = 0; i < 8; ++i) {
            b0[2 * i] = __builtin_amdgcn_exp2f(b0[2 * i]); b0[2 * i + 1] = __builtin_amdgcn_exp2f(b0[2 * i + 1]);
            b1[2 * i] = __builtin_amdgcn_exp2f(b1[2 * i]); b1[2 * i + 1] = __builtin_amdgcn_exp2f(b1[2 * i + 1]);
            const f32x2v x = {b0[2 * i], b0[2 * i + 1]}, y = {b1[2 * i], b1[2 * i + 1]}; pt2 += x; pt2 += y;
        }
        lsum += (ps2.x + ps2.y) + (pt2.x + pt2.y);
#pragma unroll
        for (int st = 0; st < 2; ++st) {
            const bf16x8 p0 = pack8(b0, st), p1 = pack8(b1, st);
            const bf16x8 v00 = *(const __attribute__((address_space(3))) bf16x8*)(bb + vx[st]), v01 = *(const __attribute__((address_space(3))) bf16x8*)(bb + vx[st] + 32 * 128);
            const bf16x8 v10 = *(const __attribute__((address_space(3))) bf16x8*)(bb + vx[2 + st]), v11 = *(const __attribute__((address_space(3))) bf16x8*)(bb + vx[2 + st] + 32 * 128);
            o0 = __builtin_amdgcn_mfma_f32_32x32x16_bf16(v00, p0, o0, 0, 0, 0);
            o1 = __builtin_amdgcn_mfma_f32_32x32x16_bf16(v01, p0, o1, 0, 0, 0);
            o0 = __builtin_amdgcn_mfma_f32_32x32x16_bf16(v10, p1, o0, 0, 0, 0);
            o1 = __builtin_amdgcn_mfma_f32_32x32x16_bf16(v11, p1, o1, 0, 0, 0);
        }
    };
    issue(0, 0);
    for (int si = 0; si < nstep; si += 2) {
        step(si, 0);
        if (si + 1 < nstep) step(si + 1, 1);
    }
#undef AT_DMA
    float l = lsum + __shfl_xor(lsum, 32);
    if (U.has_sink) l += __builtin_amdgcn_exp2f(U.sink2 - m);
    const float inv = 1.f / l;
    bf16_t* op = U.O + (unsigned)(U.qrow0 + r) * D + 4 * h;
#pragma unroll
    for (int g = 0; g < 4; ++g) {
        pg8::st_bf16x4(op + 8 * g, o0[4 * g] * inv, o0[4 * g + 1] * inv, o0[4 * g + 2] * inv, o0[4 * g + 3] * inv);
        pg8::st_bf16x4(op + 32 + 8 * g, o1[4 * g] * inv, o1[4 * g + 1] * inv, o1[4 * g + 2] * inv, o1[4 * g + 3] * inv);
    }
    __syncthreads();
}
}

struct ConvDesc { const float* src; size_t ldn; unsigned short* dst; size_t ldd; int mode; };
__device__ __forceinline__ void conv_issue(const ConvDesc& d, float4 (&v)[4]) {
    const int tid = opaque_tid();
    const int rq = tid & 7, kk0 = tid >> 3;
    const int cq = d.mode == 1 ? (16 * (rq & 1) + 4 * (rq >> 1)) : rq * 4;
#pragma unroll
    for (int i = 0; i < 4; ++i) v[i] = d.mode == 2 ? make_float4(0.f, 0.f, 0.f, 0.f) : *(const float4*)(d.src + (size_t)(kk0 + 64 * i) * d.ldn + cq);
}
__device__ __forceinline__ void conv_finish(const ConvDesc& d, const float4 (&v)[4], float* t  ) {
    const int tid = opaque_tid();
    {
        const int rq = tid & 7, kk0 = tid >> 3;
        __syncthreads();
#pragma unroll
        for (int i = 0; i < 4; ++i) { float* p = t + (kk0 + 64 * i) * 33 + rq * 4; p[0] = v[i].x; p[1] = v[i].y; p[2] = v[i].z; p[3] = v[i].w; }
    }
    __syncthreads();
    {
        const int rr = tid >> 4, kq = tid & 15;
#pragma unroll
        for (int i = 0; i < 2; ++i) {
            const int k = i * 128 + kq * 8;
            float f[8];
#pragma unroll
            for (int j = 0; j < 8; ++j) f[j] = t[(k + j) * 33 + rr];
            pg8::u32x4 w; w.x = pg8::cvt_pk_bf16(f[0], f[1]); w.y = pg8::cvt_pk_bf16(f[2], f[3]); w.z = pg8::cvt_pk_bf16(f[4], f[5]); w.w = pg8::cvt_pk_bf16(f[6], f[7]);
            *(pg8::u32x4*)(d.dst + (size_t)rr * d.ldd + k) = w;
        }
    }
}
__device__ __forceinline__ ConvDesc conv_item(const float* src, size_t ldn, unsigned short* dst, size_t ldd, int mode = 0) {
    ConvDesc d; d.src = src; d.ldn = ldn; d.dst = dst; d.ldd = ldd; d.mode = mode; return d;
}
constexpr int FFN_CONV_ITEMS = 896 + 448;
__device__ __forceinline__ ConvDesc conv_ffn_item(int it, const float* w1, const float* w3, const float* w2, unsigned short* w13t, unsigned short* w2t) {
    if (it < 896) {
        const int rb = it >> 2, kb = it & 3, R0 = rb * 32, pn = R0 >> 8, cc = R0 & 255;
        const float* src = (cc < 128 ? w1 : w3) + (size_t)(kb * 256) * DFF + pn * 128 + (cc & 127);
        return conv_item(src, DFF, w13t + (size_t)R0 * D + kb * 256, D);
    } else {
        const int it2 = it - 896, rb = it2 / 14, kb = it2 % 14;
        return conv_item(w2 + (size_t)(kb * 256) * D + rb * 32, D, w2t + (size_t)(rb * 32) * DFF + kb * 256, DFF);
    }
}
__device__ __forceinline__ ConvDesc conv_win_item(const Ctx C, int l, int r) {
    const int rb = r >> 2, kb = r & 3, R0 = rb * 32, pc = R0 >> 8, cc = R0 & 255, wc = (cc >> 5) & 3, bj = cc >> 7;
    int col0, mode = 0;
    if (pc <= 4) col0 = (pc == 0 ? P_AQ : pc == 1 ? P_AK : pc == 2 ? P_AV : pc == 3 ? P_BQ : P_CQ) + 64 * wc + 32 * bj;
    else if (pc == 5) col0 = (wc < 2 ? P_BK + 64 * wc : P_CK + 64 * (wc - 2)) + 32 * bj;
    else if (pc == 6) col0 = (wc < 2 ? P_BV + 64 * wc : P_CV + 64 * (wc - 2)) + 32 * bj;
    else if (pc == 7) col0 = P_DQA + cc;
    else if (pc == 8) { if (cc < 128) col0 = P_DKVA + cc; else if (cc == 128) { col0 = P_DKVA + 128; mode = 1; } else { col0 = 0; mode = 2; } }
    else col0 = P_GATE + (pc - 9) * 256 + cc;
    return conv_item(C.w_in() + ((size_t)l * D + kb * 256) * INW + col0, INW, C.WIN() + ((size_t)l * INWP + R0) * D + kb * 256, D, mode);
}
__device__ __forceinline__ ConvDesc conv_brout_item(const Ctx C, int l, int r) {
    if (r < 128) { const int nb = (r >> 5) & 3, rb = r & 31;
        return conv_item(C.w_branch() + ((size_t)(l * 4 + nb) * 256) * D + rb * 32, D, C.WBR() + ((size_t)l * D + rb * 32) * D + nb * 256, D); }
    else { const int q = r - 128, rb = (q >> 2) & 31, kb = q & 3;
        return conv_item(C.w_out() + ((size_t)l * D + kb * 256) * D + rb * 32, D, C.WOUT() + ((size_t)l * D + rb * 32) * D + kb * 256, D); }
}
__device__ __forceinline__ ConvDesc conv_dense_item(const Ctx C, int l2, int r) {
    return conv_ffn_item(r, C.ffn_w1() + (size_t)l2 * D * DFF, C.ffn_w3() + (size_t)l2 * D * DFF, C.ffn_w2() + (size_t)l2 * DFF * D, C.W13D() + (size_t)l2 * 2 * DFF * D, C.W2D() + (size_t)l2 * D * DFF);
}
__device__ __forceinline__ ConvDesc conv_moe_item(const Ctx C, int l2, int it) {
    const int e = it / FFN_CONV_ITEMS, r = it % FFN_CONV_ITEMS; const size_t le = (size_t)l2 * NE + e;
    return conv_ffn_item(r, C.moe_w1() + le * D * DFF, C.moe_w3() + le * D * DFF, C.moe_w2() + le * DFF * D, C.W13M() + (size_t)e * 2 * DFF * D, C.W2M() + (size_t)e * D * DFF);
}
constexpr int MOE_CONV_ITEMS = NE * FFN_CONV_ITEMS;
constexpr int BG_J0 = 0, BG_J1 = BG_J0 + FFN_CONV_ITEMS  , BG_J2 = BG_J1 + 800  , BG_J3 = BG_J2 + 256  , BG_J4 = BG_J3 + MOE_CONV_ITEMS  ,
              BG_J5 = BG_J4 + 800  , BG_J6 = BG_J5 + 256  , BG_J7 = BG_J6 + FFN_CONV_ITEMS  , BG_J8 = BG_J7 + 800  ,
              BG_J9 = BG_J8 + 256  , BG_END = BG_J9 + MOE_CONV_ITEMS  ;
__device__ __forceinline__ ConvDesc bg_item(const Ctx C, int g) {
    if (g < BG_J1) return conv_dense_item(C, 0, g - BG_J0);
    if (g < BG_J2) return conv_win_item(C, 1, g - BG_J1);
    if (g < BG_J3) return conv_brout_item(C, 1, g - BG_J2);
    if (g < BG_J4) return conv_moe_item(C, 0, g - BG_J3);
    if (g < BG_J5) return conv_win_item(C, 2, g - BG_J4);
    if (g < BG_J6) return conv_brout_item(C, 2, g - BG_J5);
    if (g < BG_J7) return conv_dense_item(C, 1, g - BG_J6);
    if (g < BG_J8) return conv_win_item(C, 3, g - BG_J7);
    if (g < BG_J9) return conv_brout_item(C, 3, g - BG_J8);
    return conv_moe_item(C, 1, g - BG_J9);
}
__device__ __forceinline__ void bg_run(const Ctx C, int first, int limit, int per_wg, int rank, int nwg) {
    const int g0 = first + rank;
    if (per_wg > 0 && g0 < limit) {
        ConvDesc d0, d1; float4 v0[4], v1[4];
        d0 = bg_item(C, g0); conv_issue(d0, v0);
        for (int j = 0; j < per_wg; ++j) {
            const int gn = first + rank + (j + 1) * nwg; const bool hn = (j + 1 < per_wg) && (gn < limit);
            if (hn) { d1 = bg_item(C, gn); conv_issue(d1, v1); }
            conv_finish(d0, v0, C.lds);
            if (!hn) break;
            d0 = d1;
#pragma unroll
            for (int i = 0; i < 4; ++i) v0[i] = v1[i];
        }
    }
    __syncthreads();
}
constexpr int BGW_IN = 248 * 11, BGW_MLA = 224 * 7, BGW_BR = 224 * 18, BGW_LAYER = BGW_IN + BGW_MLA + BGW_BR;
static_assert(BGW_LAYER + BGW_IN + BGW_MLA + BGW_BR >= BG_J9 && BGW_LAYER + BGW_IN + BGW_MLA <= BG_J9, "layer 1's windows must end exactly at the start of MoE layer 3's items");
__device__ __forceinline__ int bg_layer_base(int l) { return l == 0 ? 0 : (l == 1 ? BGW_LAYER : (l == 2 ? BG_J9 : BG_J9 + BGW_LAYER)); }
static_assert(BG_J9 + BGW_LAYER + 120 * 11 + BGW_MLA >= BG_END, "the background list must be finished by the end of layer 3's MLA phase");

__device__ __forceinline__ void conv_prologue(const Ctx C) {
    const int tidx_ = opaque_tid();
    {
        auto desc = [&](int it, ConvDesc& d) { if (it < 800) d = conv_win_item(C, 0, it); else d = conv_brout_item(C, 0, it - 800); };
        int it = blockIdx.x;
        if (it < 800 + 256) {
            ConvDesc d0, d1; float4 v0[4], v1[4];
            desc(it, d0); conv_issue(d0, v0);
            for (;;) {
                const int itn = it + (int)gridDim.x; const bool hn = itn < 800 + 256;
                if (hn) { desc(itn, d1); conv_issue(d1, v1); }
                conv_finish(d0, v0, C.lds);
                if (!hn) break;
                d0 = d1; it = itn;
#pragma unroll
                for (int i = 0; i < 4; ++i) v0[i] = v1[i];
            }
        }
    }
    __syncthreads();
    for (int it = (int)blockIdx.x - (int)(gridDim.x / 2); it >= 0 && it < DEPTH * 32; it += (int)gridDim.x) {
        const int l = it >> 5, rb = it & 31;
        float* t = C.lds;
        {
            const int tc = tidx_ & 31, tr = tidx_ >> 5, R = rb * 32 + tc;
            const int pc = R >> 8, cc = R & 255, bj = cc >> 7, wc = (cc >> 5) & 3, sl = cc & 31;
            const bool qpart = pc < 2;
            int col = -1;
            if (pc == 0) col = wc * 96 + 32 * bj + sl;
            else if (pc == 1) { if (bj == 0) col = wc * 96 + 64 + 16 * ((sl >> 2) & 1) + 4 * (sl >> 3) + (sl & 3); }
            else if (pc == 2) col = wc * 128 + 32 * bj + sl;
            else col = wc * 128 + 64 + 32 * bj + sl;
            const float* wsrc = qpart ? C.mla_wqb() + (size_t)l * 256 * 384 : C.mla_wkvb() + (size_t)l * 128 * 512;
            const float* gsrc = qpart ? C.mla_qnorm() + l * 256 : C.mla_kvnorm() + l * 128;
            const int wst = qpart ? 384 : 512, kb = qpart ? 0 : 256, zb = qpart ? 256 : 0, nz = qpart ? 8 : 16;
            const int cl = col < 0 ? 0 : col;
            float wv[16], gv[16];
            if (qpart) {
#pragma unroll
                for (int j = 0; j < 16; ++j) { wv[j] = wsrc[(size_t)(tr + 16 * j) * wst + cl]; gv[j] = gsrc[tr + 16 * j]; }
#pragma unroll
                for (int j = 0; j < 16; ++j) t[(kb + tr + 16 * j) * 33 + tc] = col < 0 ? 0.f : wv[j] * gv[j];
            } else {
#pragma unroll
                for (int j = 0; j < 8; ++j) { wv[j] = wsrc[(size_t)(tr + 16 * j) * wst + cl]; gv[j] = gsrc[tr + 16 * j]; }
#pragma unroll
                for (int j = 0; j < 8; ++j) t[(kb + tr + 16 * j) * 33 + tc] = wv[j] * gv[j];
            }
            for (int j = 0; j < nz; ++j) t[(zb + tr + 16 * j) * 33 + tc] = 0.f;
        }
        __syncthreads();
        {
            const int rr = tidx_ >> 4, kq = tidx_ & 15;
#pragma unroll
            for (int j = 0; j < 3; ++j) {
                const int k = (j * 16 + kq) * 8;
                float f[8];
#pragma unroll
                for (int q = 0; q < 8; ++q) f[q] = t[(k + q) * 33 + rr];
                pg8::u32x4 w; w.x = pg8::cvt_pk_bf16(f[0], f[1]); w.y = pg8::cvt_pk_bf16(f[2], f[3]); w.z = pg8::cvt_pk_bf16(f[4], f[5]); w.w = pg8::cvt_pk_bf16(f[6], f[7]);
                *(pg8::u32x4*)(C.WMLA() + ((size_t)l * 1024 + rb * 32 + rr) * 384 + k) = w;
            }
        }
        __syncthreads();
    }
}
__device__ __forceinline__ void ph_prologue(const Ctx C) {
    const int tidx_ = opaque_tid();
    const int lane = tidx_ & 63, wave = tidx_ >> 6;
    {
        float* sc = C.lds;
        float* part = C.lds + 9 * D;
        for (int i = tidx_; i < 9 * D; i += NTHREADS) { const int r = i >> 10, d = i & (D - 1); sc[i] = siluf(r < 8 ? C.c()[r * D + d] : C.c_ctx()[d]); }
        __syncthreads();
        for (int it = blockIdx.x; it < DEPTH * (ADAW / 64); it += gridDim.x) {
            const int l = it / (ADAW / 64), e = (it % (ADAW / 64)) * 64 + lane;
            float acc[9];
#pragma unroll
            for (int r = 0; r < 9; ++r) acc[r] = 0.f;
            const float* w = C.w_ada() + ((size_t)l * D + wave * 128) * ADAW + e;
            for (int d0 = 0; d0 < 128; d0 += 8) {
                float wv[8];
#pragma unroll
                for (int q = 0; q < 8; ++q) wv[q] = w[(size_t)(d0 + q) * ADAW];
#pragma unroll
                for (int r = 0; r < 9; ++r) {
                    const float4 s0 = *(const float4*)(sc + r * D + wave * 128 + d0), s1 = *(const float4*)(sc + r * D + wave * 128 + d0 + 4);
                    acc[r] = fmaf(s0.x, wv[0], acc[r]); acc[r] = fmaf(s0.y, wv[1], acc[r]); acc[r] = fmaf(s0.z, wv[2], acc[r]); acc[r] = fmaf(s0.w, wv[3], acc[r]);
                    acc[r] = fmaf(s1.x, wv[4], acc[r]); acc[r] = fmaf(s1.y, wv[5], acc[r]); acc[r] = fmaf(s1.z, wv[6], acc[r]); acc[r] = fmaf(s1.w, wv[7], acc[r]);
                }
            }
#pragma unroll
            for (int r = 0; r < 9; ++r) part[(wave * 9 + r) * 64 + lane] = acc[r];
            __syncthreads();
            for (int i = tidx_; i < 9 * 64; i += NTHREADS) {
                float t = 0.f;
#pragma unroll
                for (int w8 = 0; w8 < 8; ++w8) t += part[w8 * 576 + i];
                const int r = i >> 6, ee = (it % (ADAW / 64)) * 64 + (i & 63);
                C.MOD()[((size_t)l * 9 + r) * ADAW + ee] = t + C.b_ada()[l * ADAW + ee];
            }
            __syncthreads();
        }
    }
    for (int i = blockIdx.x * NTHREADS + tidx_; i < SEQ * 32; i += gridDim.x * NTHREADS) {
        const int t = i >> 5, j = i & 31;
        const int pos = j < 16 ? (t / GW) : (t % GW);
        const float inv = powf(10000.f, -(float)(j & 15) / 16.f);
        const float ang = (float)pos * inv;
        C.ROPE()[t * 32 + j] = cosf(ang); C.ROPE()[SEQ * 32 + t * 32 + j] = sinf(ang);
        if (j < 16) {
            const int pos2 = j < 8 ? (t / GW) : (t % GW);
            const float inv2 = powf(10000.f, -(float)(j & 7) / 8.f);
            const float a2 = (float)pos2 * inv2;
            C.ROPE()[SEQ * 64 + t * 16 + j] = cosf(a2); C.ROPE()[SEQ * 64 + SEQ * 16 + t * 16 + j] = sinf(a2);
        }
    }
}

__device__ __forceinline__ int block_row(int b, int i, int nrows) { return (nrows == MT && i >= 64) ? ML + b * 8 + (i - 64) : b * 64 + i; }
__device__ __forceinline__ void ph_norm(const Ctx C, int l, int mode) {
    const int tidx_ = opaque_tid();
    const int lane = tidx_ & 63, wave = tidx_ >> 6;
#define CB(i) ((((i) >> 1) << 9) + lane * 8 + (((i) & 1) << 2))
    const bool moe_prev = (mode == 0 && l > 0 && ((l - 1) & 1)) || mode == 2;
    const int lp = (mode == 2) ? DEPTH - 1 : l - 1;
    const int nrows = (mode == 2) ? ML : ((mode == 1 && l == DEPTH - 1) ? ML : MT);
    const bool route = (mode == 1) && (l & 1);
    int* hist = (int*)C.lds;
    float* const Rl = C.lds + 64;
    if (route) {
        if (tidx_ < NE) hist[tidx_] = 0;
        const float* R = C.moe_router() + (size_t)(l >> 1) * D * NE;
        for (int q = tidx_; q < D * 2; q += NTHREADS) { const int d = q >> 1; *(float4*)(Rl + d * 8 + (d >> 3) * 4 + (q & 1) * 4) = *(const float4*)(R + q * 4); }
        __syncthreads();
    }
    const int rows_per_block = nrows / gridDim.x;
    const bool src_f32 = (mode == 0 && l == 0);
    auto ldrow = [&](int row, float4 (&dst)[4]) {
        if (src_f32) {
            const float* s0 = row < ML ? C.x() + (size_t)row * D : C.ctx() + (size_t)(row - ML) * D;
#pragma unroll
            for (int i = 0; i < 4; ++i) dst[i] = *(const float4*)(s0 + CB(i));
        } else {
            const unsigned short* s0 = C.X() + (size_t)row * D;
#pragma unroll
            for (int i = 0; i < 4; i += 2) { const uint4 t = *(const uint4*)(s0 + CB(i)); dst[i].x = __uint_as_float(t.x); dst[i].y = __uint_as_float(t.y); dst[i + 1].x = __uint_as_float(t.z); dst[i + 1].y = __uint_as_float(t.w); }
        }
    };
    float4 hA0, hA1, hA2, hA3, hB0, hB1, hB2, hB3;
    {
        const float* gn0 = mode == 2 ? C.final_g() : (mode == 0 ? C.norm1_g() : C.norm2_g()) + l * D;
        const float* md0 = C.MOD() + ((size_t)l * 9 + (blockIdx.x >> 5)) * ADAW + (mode == 0 ? 0 : 3 * D);
        auto ld = [&](int i, float4& a, float4& b) {
            const float4 g = *(const float4*)(gn0 + CB(i));
            float4 sh = make_float4(0.f, 0.f, 0.f, 0.f), sc = sh;
            if (mode != 2) { sh = *(const float4*)(md0 + CB(i)); sc = *(const float4*)(md0 + D + CB(i)); }
            a = make_float4(g.x * (1.f + sc.x), g.y * (1.f + sc.y), g.z * (1.f + sc.z), g.w * (1.f + sc.w)); b = sh;
        };
        ld(0, hA0, hB0); ld(1, hA1, hB1); ld(2, hA2, hB2); ld(3, hA3, hB3);
    }
    float4 gM0 = make_float4(0.f, 0.f, 0.f, 0.f), gM1 = gM0, gM2 = gM0, gM3 = gM0;
    if (moe_prev) { const float* g2 = C.MOD() + ((size_t)lp * 9 + (blockIdx.x >> 5)) * ADAW + 5 * D; gM0 = *(const float4*)(g2 + CB(0)); gM1 = *(const float4*)(g2 + CB(1)); gM2 = *(const float4*)(g2 + CB(2)); gM3 = *(const float4*)(g2 + CB(3)); }
    float4 vn[4], vm[4];
#pragma unroll
    for (int i = 0; i < 4; ++i) { vn[i] = make_float4(0.f, 0.f, 0.f, 0.f); vm[i] = vn[i]; }
    if (wave < rows_per_block) ldrow(block_row(blockIdx.x, wave, nrows), vn);
    if (wave + NWAVES < rows_per_block) ldrow(block_row(blockIdx.x, wave + NWAVES, nrows), vm);
    int cs0 = 0, cs1 = 0, ps0 = 0, ps1 = 0; float cw0 = 0.f, cw1 = 0.f, pw0 = 0.f, pw1 = 0.f;
    uint4 yn0[2] = {make_uint4(0, 0, 0, 0), make_uint4(0, 0, 0, 0)}, yn1[2] = {make_uint4(0, 0, 0, 0), make_uint4(0, 0, 0, 0)};
    if (moe_prev) {
        const int r0_ = block_row(blockIdx.x, wave, nrows); cs0 = C.SLOT()[r0_ * 2]; cs1 = C.SLOT()[r0_ * 2 + 1]; cw0 = C.TOPW()[r0_ * 2]; cw1 = C.TOPW()[r0_ * 2 + 1];
        if (wave + NWAVES < rows_per_block) { const int r1_ = block_row(blockIdx.x, wave + NWAVES, nrows); ps0 = C.SLOT()[r1_ * 2]; ps1 = C.SLOT()[r1_ * 2 + 1]; pw0 = C.TOPW()[r1_ * 2]; pw1 = C.TOPW()[r1_ * 2 + 1]; }
#pragma unroll
        for (int q = 0; q < 2; ++q) { yn0[q] = *(const uint4*)(C.Y() + (size_t)cs0 * D + CB(2 * q)); yn1[q] = *(const uint4*)(C.Y() + (size_t)cs1 * D + CB(2 * q)); }
    }
    for (int ri = wave; ri < rows_per_block; ri += NWAVES) {
        const int row = block_row(blockIdx.x, ri, nrows);
        const int mr = modrow(row);
        const int s0 = cs0, s1 = cs1; const float w0 = cw0, w1 = cw1;
        uint4 yr0[2], yr1[2];
#pragma unroll
        for (int q = 0; q < 2; ++q) { yr0[q] = yn0[q]; yr1[q] = yn1[q]; }
        if (moe_prev) {
            if (ri + NWAVES < rows_per_block) {
#pragma unroll
                for (int q = 0; q < 2; ++q) { yn0[q] = *(const uint4*)(C.Y() + (size_t)ps0 * D + CB(2 * q)); yn1[q] = *(const uint4*)(C.Y() + (size_t)ps1 * D + CB(2 * q)); }
            }
            cs0 = ps0; cs1 = ps1; cw0 = pw0; cw1 = pw1;
            if (ri + 2 * NWAVES < rows_per_block) { const int rn = block_row(blockIdx.x, ri + 2 * NWAVES, nrows); ps0 = C.SLOT()[rn * 2]; ps1 = C.SLOT()[rn * 2 + 1]; pw0 = C.TOPW()[rn * 2]; pw1 = C.TOPW()[rn * 2 + 1]; }
        }
        float4 v[4];
#pragma unroll
        for (int i = 0; i < 4; ++i) {
            if (src_f32) v[i] = vn[i];
            else { const unsigned a = __float_as_uint(vn[i].x), b = __float_as_uint(vn[i].y); v[i] = make_float4(__uint_as_float(a << 16), __uint_as_float(a & 0xffff0000u), __uint_as_float(b << 16), __uint_as_float(b & 0xffff0000u)); }
            vn[i] = vm[i];
        }
        if (ri + 2 * NWAVES < rows_per_block) ldrow(block_row(blockIdx.x, ri + 2 * NWAVES, nrows), vm);
        bool wr_x = (mode == 0 && l == 0);
        {
            const int np = (mode == 1 && l < DEPTH - 1) ? 4 : ((mode == 0 && l > 0 && !((l - 1) & 1)) ? 7 : 0);
            if (np && row >= ML) {
                const float* gt = (mode == 1) ? C.MOD() + ((size_t)l * 9 + 8) * ADAW + 2 * D : C.MOD() + ((size_t)(l - 1) * 9 + 8) * ADAW + 5 * D;
#pragma unroll
                for (int i = 0; i < 4; ++i) {
                    float4 sm = make_float4(0.f, 0.f, 0.f, 0.f);
#pragma unroll
                    for (int p = 0; p < 7; ++p) if (p < np) { const ushort4 pv = *(const ushort4*)(C.PART() + ((size_t)p * MC + (row - ML)) * D + CB(i)); sm.x += bf2f(pv.x); sm.y += bf2f(pv.y); sm.z += bf2f(pv.z); sm.w += bf2f(pv.w); }
                    const float4 g = *(const float4*)(gt + CB(i));
                    v[i].x += g.x * sm.x; v[i].y += g.y * sm.y; v[i].z += g.z * sm.z; v[i].w += g.w * sm.w;
                }
                wr_x = true;
            }
        }
        if (moe_prev && (row < ML || lp != DEPTH - 1)) {
            auto unp = [&](const uint4 t, float4& a, float4& b) {
                a = make_float4(__uint_as_float(t.x << 16), __uint_as_float(t.x & 0xffff0000u), __uint_as_float(t.y << 16), __uint_as_float(t.y & 0xffff0000u));
                b = make_float4(__uint_as_float(t.z << 16), __uint_as_float(t.z & 0xffff0000u), __uint_as_float(t.w << 16), __uint_as_float(t.w & 0xffff0000u));
            };
#pragma unroll
            for (int i = 0; i < 4; i += 2) {
                float4 y0a, y0b, y1a, y1b; unp(yr0[i >> 1], y0a, y0b); unp(yr1[i >> 1], y1a, y1b);
                if (s0 >= YSPLIT_P0 * 256) { float4 ta, tb; unp(*(const uint4*)(C.Y2() + (size_t)(s0 - YSPLIT_P0 * 256) * D + CB(i)), ta, tb); y0a.x += ta.x; y0a.y += ta.y; y0a.z += ta.z; y0a.w += ta.w; y0b.x += tb.x; y0b.y += tb.y; y0b.z += tb.z; y0b.w += tb.w; }
                if (s1 >= YSPLIT_P0 * 256) { float4 ta, tb; unp(*(const uint4*)(C.Y2() + (size_t)(s1 - YSPLIT_P0 * 256) * D + CB(i)), ta, tb); y1a.x += ta.x; y1a.y += ta.y; y1a.z += ta.z; y1a.w += ta.w; y1b.x += tb.x; y1b.y += tb.y; y1b.z += tb.z; y1b.w += tb.w; }
                float4 ga = i == 0 ? gM0 : gM2, gb = i == 0 ? gM1 : gM3;
                if (row >= ML) { const float* g2 = C.MOD() + ((size_t)lp * 9 + 8) * ADAW + 5 * D; ga = *(const float4*)(g2 + CB(i)); gb = *(const float4*)(g2 + CB(i + 1)); }
                v[i].x += ga.x * (w0 * y0a.x + w1 * y1a.x); v[i].y += ga.y * (w0 * y0a.y + w1 * y1a.y);
                v[i].z += ga.z * (w0 * y0a.z + w1 * y1a.z); v[i].w += ga.w * (w0 * y0a.w + w1 * y1a.w);
                v[i + 1].x += gb.x * (w0 * y0b.x + w1 * y1b.x); v[i + 1].y += gb.y * (w0 * y0b.y + w1 * y1b.y);
                v[i + 1].z += gb.z * (w0 * y0b.z + w1 * y1b.z); v[i + 1].w += gb.w * (w0 * y0b.w + w1 * y1b.w);
            }
            wr_x = true;
        }
        if (wr_x && mode != 2) {
#pragma unroll
            for (int i = 0; i < 4; i += 2) { pg8::u32x4 w; w.x = pg8::cvt_pk_bf16(v[i].x, v[i].y); w.y = pg8::cvt_pk_bf16(v[i].z, v[i].w); w.z = pg8::cvt_pk_bf16(v[i + 1].x, v[i + 1].y); w.w = pg8::cvt_pk_bf16(v[i + 1].z, v[i + 1].w); *(pg8::u32x4*)(C.X() + (size_t)row * D + CB(i)) = w; }
        }
        float ss = 0.f;
#pragma unroll
        for (int i = 0; i < 4; ++i) ss += v[i].x * v[i].x + v[i].y * v[i].y + v[i].z * v[i].z + v[i].w * v[i].w;
        ss = wave_sum(ss);
        const float rs = rsqrtf(ss * (1.0f / D) + EPS);
        float4 a0 = hA0, a1 = hA1, a2 = hA2, a3 = hA3, b0 = hB0, b1 = hB1, b2 = hB2, b3 = hB3;
        if (mode != 2 && row >= ML) {
            const float* gn = (mode == 0 ? C.norm1_g() : C.norm2_g()) + l * D;
            const float* md = C.MOD() + ((size_t)l * 9 + 8) * ADAW + (mode == 0 ? 0 : 3 * D);
            auto ldc = [&](int i, float4& a, float4& b) {
                const float4 g = *(const float4*)(gn + CB(i)), sc = *(const float4*)(md + D + CB(i));
                a = make_float4(g.x * (1.f + sc.x), g.y * (1.f + sc.y), g.z * (1.f + sc.z), g.w * (1.f + sc.w)); b = *(const float4*)(md + CB(i));
            };
            ldc(0, a0, b0); ldc(1, a1, b1); ldc(2, a2, b2); ldc(3, a3, b3);
        }
        float4 h[4];
#pragma unroll
        for (int i = 0; i < 4; ++i) {
            const float4 a = i == 0 ? a0 : i == 1 ? a1 : i == 2 ? a2 : a3, bsh = i == 0 ? b0 : i == 1 ? b1 : i == 2 ? b2 : b3;
            h[i].x = v[i].x * rs * a.x + bsh.x; h[i].y = v[i].y * rs * a.y + bsh.y;
            h[i].z = v[i].z * rs * a.z + bsh.z; h[i].w = v[i].w * rs * a.w + bsh.w;
            if (mode == 2) *(float4*)(C.out() + (size_t)row * D + CB(i)) = h[i];
            else { pg8::u32x2 w; w.x = pg8::cvt_pk_bf16(h[i].x, h[i].y); w.y = pg8::cvt_pk_bf16(h[i].z, h[i].w); *(pg8::u32x2*)(C.HB() + (size_t)row * D + CB(i)) = w; }
        }
        if (route) {
            float lg[NE];
#pragma unroll
            for (int e = 0; e < NE; ++e) lg[e] = 0.f;
#pragma unroll
            for (int i = 0; i < 4; ++i) {
                const float hv[4] = {h[i].x, h[i].y, h[i].z, h[i].w};
#pragma unroll
                for (int j = 0; j < 4; ++j) {
                    const int d = CB(i) + j;
                    const float4 ra = *(const float4*)(Rl + d * 8 + (d >> 3) * 4), rb = *(const float4*)(Rl + d * 8 + (d >> 3) * 4 + 4);
                    lg[0] = fmaf(hv[j], ra.x, lg[0]); lg[1] = fmaf(hv[j], ra.y, lg[1]); lg[2] = fmaf(hv[j], ra.z, lg[2]); lg[3] = fmaf(hv[j], ra.w, lg[3]);
                    lg[4] = fmaf(hv[j], rb.x, lg[4]); lg[5] = fmaf(hv[j], rb.y, lg[5]); lg[6] = fmaf(hv[j], rb.z, lg[6]); lg[7] = fmaf(hv[j], rb.w, lg[7]);
                }
            }
#pragma unroll
            for (int e = 0; e < NE; ++e) lg[e] = wave_sum(lg[e]);
            int e0 = 0; float v0 = lg[0];
#pragma unroll
            for (int e = 1; e < NE; ++e) if (lg[e] > v0) { v0 = lg[e]; e0 = e; }
            int e1 = -1; float v1 = -3.0e38f;
#pragma unroll
            for (int e = 0; e < NE; ++e) if (e != e0 && lg[e] > v1) { v1 = lg[e]; e1 = e; }
            const float p1 = expf(v1 - v0), w0 = 1.f / (1.f + p1), w1 = p1 / (1.f + p1);
            if (lane == 0) {
                C.TOPE()[row * 2] = e0; C.TOPE()[row * 2 + 1] = e1; C.TOPW()[row * 2] = w0; C.TOPW()[row * 2 + 1] = w1;
                atomicAdd(&hist[e0], 1); atomicAdd(&hist[e1], 1);
            }
        }
    }
    if (route) { __syncthreads(); if (tidx_ < NE) C.HIST()[blockIdx.x * NE + tidx_] = hist[tidx_]; __syncthreads(); }
}

#undef CB
__device__ __forceinline__ void ph_assign(const Ctx C, int l) {
    const int tidx_ = opaque_tid();
    const int tid = tidx_, lane = tid & 63, wave = tid >> 6;
    const int nrows = (l == DEPTH - 1) ? ML : MT;
    const int rpb = nrows / gridDim.x;
    int* sh = (int*)C.lds;
    int ev[3] = {-1, -1, -1};
    if (wave == 0) {
#pragma unroll
        for (int q = 0; q < 3; ++q) { const int idx = 64 * q + lane; if (idx < 2 * rpb) ev[q] = C.TOPE()[block_row(blockIdx.x, idx >> 1, nrows) * 2 + (idx & 1)]; }
    }
    {
        const int e = wave;
        int tot = 0, base = 0;
#pragma unroll
        for (int k = 0; k < 4; ++k) { const int b = lane + 64 * k; const int hh = (b < (int)gridDim.x) ? C.HIST()[b * NE + e] : 0; tot += hh; base += (b < (int)blockIdx.x) ? hh : 0; }
#pragma unroll
        for (int o = 1; o < 64; o <<= 1) { tot += __shfl_xor(tot, o); base += __shfl_xor(base, o); }
        if (lane == 0) { sh[e] = tot; sh[8 + e] = base; }
    }
    __syncthreads();
    if (tid == 0) { int sacc = 0; for (int e = 0; e < NE; ++e) { sh[16 + e] = sacc; sacc += (sh[e] + 255) / 256 * 256; } sh[24] = sacc; }
    __syncthreads();
    if (wave == 0) {
        int cur[NE];
#pragma unroll
        for (int e = 0; e < NE; ++e) cur[e] = sh[16 + e] + sh[8 + e];
#pragma unroll
        for (int q = 0; q < 3; ++q) {
            const int cb = 64 * q; if (cb >= 2 * rpb) break;
            const int idx = cb + lane; const bool valid = idx < 2 * rpb;
            const int erow = block_row(blockIdx.x, (valid ? idx : 0) >> 1, nrows);
            const int e = ev[q];
            int slot = 0;
#pragma unroll
            for (int ex = 0; ex < NE; ++ex) {
                const unsigned long long mask = __ballot(e == ex);
                const int rank = __popcll(mask & ((1ull << lane) - 1ull));
                if (e == ex) slot = cur[ex] + rank;
                cur[ex] += __popcll(mask);
            }
            if (valid) { C.SLOT()[erow * 2 + (idx & 1)] = slot; sh[64 + idx] = slot; }
        }
    }
    __syncthreads();
    for (int idx0 = wave; idx0 < 2 * rpb; idx0 += 6 * NWAVES) {
        const int last = 2 * rpb - 1;
#define AS_IDX(q) (idx0 + (q) * NWAVES > last ? idx0 : idx0 + (q) * NWAVES)
#define AS_SRC(q) ((const uint4*)(C.HB() + (size_t)block_row(blockIdx.x, AS_IDX(q) >> 1, nrows) * D))
#define AS_DST(q) ((uint4*)(C.AS() + (size_t)sh[64 + AS_IDX(q)] * D))
        const uint4 a0 = AS_SRC(0)[lane], a1 = AS_SRC(0)[lane + 64], b0 = AS_SRC(1)[lane], b1 = AS_SRC(1)[lane + 64], c0 = AS_SRC(2)[lane], c1 = AS_SRC(2)[lane + 64];
        const uint4 d0 = AS_SRC(3)[lane], d1 = AS_SRC(3)[lane + 64], e0 = AS_SRC(4)[lane], e1 = AS_SRC(4)[lane + 64], f0 = AS_SRC(5)[lane], f1 = AS_SRC(5)[lane + 64];
        AS_DST(0)[lane] = a0; AS_DST(0)[lane + 64] = a1; AS_DST(1)[lane] = b0; AS_DST(1)[lane + 64] = b1; AS_DST(2)[lane] = c0; AS_DST(2)[lane + 64] = c1;
        AS_DST(3)[lane] = d0; AS_DST(3)[lane + 64] = d1; AS_DST(4)[lane] = e0; AS_DST(4)[lane + 64] = e1; AS_DST(5)[lane] = f0; AS_DST(5)[lane + 64] = f1;
#undef AS_IDX
#undef AS_SRC
#undef AS_DST
    }
    for (int e = 0; e < NE; ++e) {
        const int beg = sh[16 + e] + sh[e], end = sh[16 + e + 1];
        for (int sl = beg + (int)blockIdx.x + wave * (int)gridDim.x; sl < end; sl += NWAVES * (int)gridDim.x) { uint4* dst = (uint4*)(C.AS() + (size_t)sl * D); dst[lane] = make_uint4(0, 0, 0, 0); dst[lane + 64] = make_uint4(0, 0, 0, 0); }
    }
    if (blockIdx.x == 0) {
        for (int e = 0; e < NE; ++e) for (int p = sh[16 + e] / 256 + tid; p < sh[16 + e + 1] / 256; p += NTHREADS) C.PEXP()[p] = e;
        if (tid == 0) C.PEXP()[MAXSLOT / 128] = sh[24] / 256;
    }
    __syncthreads();
}

__device__ __forceinline__ void ph_inproj(const Ctx C, int l) {
    PG8_LAS unsigned char* glds = (PG8_LAS unsigned char*)(C.ldsraw() + GEMM_LDS_OFF);
    pg8::Gemm g; g.A = C.HB(); g.Bt = C.WIN() + (size_t)l * INWP * D; g.K = D; g.lda = D; g.ldb = D;
    pg8::StaticOrder S; S.init(MT, INWP, gridDim.x, blockIdx.x);
    pg8::EpiInproj E; E.ws = C.a->ws; E.rope = C.ROPE(); E.gq = C.gb_qnorm() + l * 64; E.gk = C.gb_knorm() + l * 64;
    if (l == DEPTH - 1) { pg8::InprojLastOrder S2; S2.init(gridDim.x, blockIdx.x); pg8::gemm_phase<pg8::EpiInproj, pg8::InprojLastOrder, true, true>(glds, g, S2, E); }
    else pg8::gemm_phase<pg8::EpiInproj, pg8::StaticOrder, true, true>(glds, g, S, E);
    {
        const int c = blockIdx.x, base = bg_layer_base(l);
        if (l == DEPTH - 1) { if (c >= 136) bg_run(C, base, base + 120 * 11, 11, c - 136, 120); }
        else if (c >= 8) bg_run(C, base, base + BGW_IN, 11, c - 8, 248);
    }
}
__device__ __forceinline__ void ph_mla(const Ctx C, int l) {
    PG8_LAS unsigned char* glds = (PG8_LAS unsigned char*)(C.ldsraw() + GEMM_LDS_OFF);
    pg8::Gemm g; g.A = C.DA(); g.Bt = C.WMLA() + (size_t)l * 1024 * 384; g.K = 384; g.lda = 384; g.ldb = 384;
    pg8::StaticOrder S; S.init(MT, 1024, gridDim.x, blockIdx.x);
    pg8::EpiMla E; E.ws = C.a->ws; E.rope = C.ROPE();
    pg8::gemm_phase<pg8::EpiMla, pg8::StaticOrder, true, false>(glds, g, S, E);
    if (blockIdx.x >= 32) {
        const int base = bg_layer_base(l) + (l == DEPTH - 1 ? 120 * 11 : BGW_IN);
        bg_run(C, base, (l == DEPTH - 1) ? BG_END : base + BGW_MLA, 7, blockIdx.x - 32, 224);
    }
}

__device__ __forceinline__ void ph_attn(const Ctx C, int l) {
    const int tid = opaque_tid();
    const int wave = __builtin_amdgcn_readfirstlane(tid >> 6);
    unsigned char* lds = C.ldsraw() + GEMM_LDS_OFF;
    const int u = ((int)blockIdx.x & 7) * ((int)gridDim.x >> 3) + ((int)blockIdx.x >> 3);
    const bool has_ctx = (l < DEPTH - 1) && (u < 128);
    const int cb = u >> 4, cmx = (u >> 2) & 3, ch = u & 3, ckvh = ch >> 1;
    for (int pass = 0; pass < 2; ++pass) {
        if (pass == 1 && !(has_ctx && cmx < 3)) break;
        at::Unit U{}; U.Q2 = nullptr; U.ldq2 = 0; U.K2 = nullptr; U.ldq = 256;
        if (pass == 0) {
            const int b = u >> 5, kvh = (u >> 4) & 1, tb = u & 15, hq = 2 * kvh + (wave >> 2), t0 = tb * 128 + 32 * (wave & 3);
            U.Q = C.QB() + hq * 64; U.K = C.KB() + kvh * 64; U.ldk = 128; U.VT = C.VTB() + (size_t)(kvh * 64) * MT;
            U.O = C.O() + 256 + hq * 64; U.qrow0 = b * SEQ + t0; U.nloc = 32; U.ntile = 36; U.krow_loc0 = b * SEQ; U.krow_ctx0 = ML + b * CTX;
        } else {
            U.qrow0 = ML + cb * CTX + 32 * wave; U.nloc = 0; U.ntile = 4; U.krow_loc0 = 0; U.krow_ctx0 = ML + cb * CTX; U.O = C.O() + cmx * 256 + ch * 64;
            if (cmx == 0) { U.Q = C.QA() + ch * 64; U.K = C.KA() + ch * 64; U.ldk = 256; U.VT = C.VTA() + (size_t)(ch * 64) * MT; }
            else if (cmx == 1) { U.Q = C.QB() + ch * 64; U.K = C.KB() + ckvh * 64; U.ldk = 128; U.VT = C.VTB() + (size_t)(ckvh * 64) * MT; }
            else { U.Q = C.QC() + ch * 64; U.K = C.KC() + ckvh * 64; U.ldk = 128; U.VT = C.VTC() + (size_t)(ckvh * 64) * MT; U.sink2 = C.wc_sink()[l * 4 + ch] * at::LOG2E; U.has_sink = 1; }
        }
        at::attn_plain2<64>(lds, U, tid);
    }
    for (int pass = 0; pass < 2; ++pass) {
        if (pass == 1 && !(has_ctx && cmx == 3)) break;
        at::Unit U{}; U.ldq = 256; U.ldq2 = 128; U.ldk = 256; U.K2 = C.KPE();
        if (pass == 0) {
            const int b = u >> 5, h = (u >> 3) & 3, tb = u & 7, t0 = tb * 256 + 32 * wave;
            U.Q = C.QDN() + h * 64; U.Q2 = C.QDP() + h * 32; U.K = C.KDN() + h * 64; U.VT = C.VTD() + (size_t)(h * 64) * MT;
            U.O = C.O() + 768 + h * 64; U.qrow0 = b * SEQ + t0; U.nloc = 32; U.ntile = 36; U.krow_loc0 = b * SEQ; U.krow_ctx0 = ML + b * CTX;
        } else {
            U.Q = C.QDN() + ch * 64; U.Q2 = C.QDP() + ch * 32; U.K = C.KDN() + ch * 64; U.VT = C.VTD() + (size_t)(ch * 64) * MT;
            U.O = C.O() + 768 + ch * 64; U.qrow0 = ML + cb * CTX + 32 * wave; U.nloc = 0; U.ntile = 4; U.krow_loc0 = 0; U.krow_ctx0 = ML + cb * CTX;
        }
        at::attn_plain2<96>(lds, U, tid);
    }
    {
        const int b = u >> 5, kvh = (u >> 4) & 1, tb = u & 15, hq = 2 * kvh + (wave >> 2), t0 = tb * 128 + 32 * (wave & 3);
        const int jlo = tb * 128 - 128 < 0 ? 0 : tb * 128 - 128, jhi = tb * 128 + 256 > SEQ ? SEQ : tb * 128 + 256;
        at::Unit U{}; U.Q = C.QC() + hq * 64; U.ldq = 256; U.Q2 = nullptr; U.ldq2 = 0; U.K = C.KC() + kvh * 64; U.ldk = 128; U.K2 = nullptr; U.VT = C.VTC() + (size_t)(kvh * 64) * MT;
        U.O = C.O() + 512 + hq * 64; U.qrow0 = b * SEQ + t0; U.nloc = (jhi - jlo) >> 6; U.ntile = U.nloc + 4; U.krow_loc0 = b * SEQ + jlo; U.krow_ctx0 = ML + b * CTX;
        U.t0 = t0; U.j0 = jlo; U.sink2 = C.wc_sink()[l * 4 + hq] * at::LOG2E; U.has_sink = 1;
        at::attn_unit<64, at::WINDOW>(lds, U, tid);
    }
    {
        const int b = u >> 5, h = (u >> 3) & 3, rb = u & 7, r0 = 4 * rb, rr = r0 + (wave >> 1), c0 = 32 * (wave & 1);
        int krlo = r0 - 4; krlo = krlo < 0 ? 0 : (krlo > 24 ? 24 : krlo);
        int krhi = r0 + 3 - 4; krhi = (krhi < 0 ? 0 : (krhi > 24 ? 24 : krhi)) + 8;
        float* rpb = (float*)(lds + at::RPB_OFF);
        for (int i = tid; i < 465; i += NTHREADS) rpb[i] = C.na_rpb()[(l * 4 + h) * 465 + i] * at::LOG2E;
        at::Unit U{}; U.Q = C.QA() + h * 64; U.ldq = 256; U.Q2 = nullptr; U.ldq2 = 0; U.K = C.KA() + h * 64; U.ldk = 256; U.K2 = nullptr; U.VT = C.VTA() + (size_t)(h * 64) * MT;
        U.O = C.O() + h * 64; U.qrow0 = b * SEQ + rr * 64 + c0; U.nloc = krhi - krlo; U.ntile = U.nloc + 4; U.krow_loc0 = b * SEQ + 64 * krlo; U.krow_ctx0 = ML + b * CTX;
        U.rr = rr; U.c0 = c0; U.krlo = krlo;
        at::attn_unit<64, at::NATTEN>(lds, U, tid);
    }
}

__device__ __forceinline__ void ph_branch(const Ctx C, int l) {
    PG8_LAS unsigned char* glds = (PG8_LAS unsigned char*)(C.ldsraw() + GEMM_LDS_OFF);
    pg8::Gemm g; g.A = C.O(); g.Bt = C.WBR() + (size_t)l * D * D; g.K = 256; g.lda = D; g.ldb = D;
    pg8::BranchOrder S; S.init((l == DEPTH - 1) ? ML : MT, gridDim.x, blockIdx.x);
    pg8::EpiBranch E; E.MIX = C.MIX(); E.GATE = C.GATE();
    pg8::gemm_phase<pg8::EpiBranch, pg8::BranchOrder, true, true>(glds, g, S, E);
    if (l < DEPTH - 1 && blockIdx.x >= 32) {
        const int base = bg_layer_base(l) + BGW_IN + BGW_MLA;
        bg_run(C, base, (l == 1) ? BG_J9 : base + BGW_BR, 18, blockIdx.x - 32, 224);
    }
}
__device__ __forceinline__ void ph_out(const Ctx C, int l) {
    PG8_LAS unsigned char* glds = (PG8_LAS unsigned char*)(C.ldsraw() + GEMM_LDS_OFF);
    pg8::Gemm g; g.A = C.MIX(); g.Bt = C.WOUT() + (size_t)l * D * D; g.K = D; g.lda = D; g.ldb = D;
    if (l == DEPTH - 1) {
        pg8::StaticOrder S; S.init(ML, D, gridDim.x, blockIdx.x);
        pg8::EpiResid E; E.X = C.X(); E.ldc = D; E.gate = C.MOD() + (size_t)l * 9 * ADAW + 2 * D;
        pg8::gemm_phase<pg8::EpiResid, pg8::StaticOrder, true, true>(glds, g, S, E);
    } else {
        pg8::TailOrder S; S.init(gridDim.x, blockIdx.x, 4, 256);
        pg8::EpiResidTail E; E.X = C.X(); E.gate = C.MOD() + (size_t)l * 9 * ADAW + 2 * D; E.PART = C.PART();
        pg8::gemm_phase<pg8::EpiResidTail, pg8::TailOrder, true, false>(glds, g, S, E);
    }
}

__device__ __forceinline__ void ph_up(const Ctx C, int l) {
    PG8_LAS unsigned char* glds = (PG8_LAS unsigned char*)(C.ldsraw() + GEMM_LDS_OFF);
    pg8::EpiSwiglu E; E.O = C.ACT(); E.ldc = DFF;
    if (l & 1) {
        pg8::Gemm g; g.A = C.AS(); g.Bt = C.W13M(); g.K = D; g.lda = D; g.ldb = D;
        const int np_ = __builtin_amdgcn_readfirstlane(C.PEXP()[MAXSLOT / 128]);
        {
            PG8_LAS int* pt = (PG8_LAS int*)(glds + pg8::STAGE_BYTES);
            const int t_ = opaque_tid(); if (t_ < np_) pt[t_] = C.PEXP()[t_];
            __syncthreads();
        }
        pg8::MoeOrder S; S.init(np_, 2 * DFF, gridDim.x, blockIdx.x, (const PG8_LAS int*)(glds + pg8::STAGE_BYTES));
        pg8::gemm_phase<pg8::EpiSwiglu, pg8::MoeOrder, true, true>(glds, g, S, E);
    } else {
        pg8::Gemm g; g.A = C.HB(); g.Bt = C.W13D() + (size_t)(l >> 1) * 2 * DFF * D; g.K = D; g.lda = D; g.ldb = D;
        pg8::StaticOrder S; S.init(MT, 2 * DFF, gridDim.x, blockIdx.x);
        pg8::gemm_phase<pg8::EpiSwiglu, pg8::StaticOrder, true, true>(glds, g, S, E);
    }
}

__device__ __forceinline__ void ph_down(const Ctx C, int l) {
    PG8_LAS unsigned char* glds = (PG8_LAS unsigned char*)(C.ldsraw() + GEMM_LDS_OFF);
    if (l & 1) {
        pg8::Gemm g; g.A = C.ACT(); g.Bt = C.W2M(); g.K = DFF; g.lda = DFF; g.ldb = DFF;
        const int np_ = __builtin_amdgcn_readfirstlane(C.PEXP()[MAXSLOT / 128]);
        {
            PG8_LAS int* pt = (PG8_LAS int*)(glds + pg8::STAGE_BYTES);
            const int t_ = opaque_tid(); if (t_ < np_) pt[t_] = C.PEXP()[t_];
            __syncthreads();
        }
        pg8::MoeDownOrder S; S.init(np_, gridDim.x, blockIdx.x, DFF / 2, (const PG8_LAS int*)(glds + pg8::STAGE_BYTES));
        pg8::EpiY E; E.Y = C.Y(); E.Y2 = C.Y2();
        pg8::gemm_phase<pg8::EpiY, pg8::MoeDownOrder, true, true>(glds, g, S, E);
    } else {
        pg8::Gemm g; g.A = C.ACT(); g.Bt = C.W2D() + (size_t)(l >> 1) * D * DFF; g.K = DFF; g.lda = DFF; g.ldb = DFF;
        pg8::TailOrder S; S.init(gridDim.x, blockIdx.x, 7, 512);
        pg8::EpiResidTail E; E.X = C.X(); E.gate = C.MOD() + (size_t)l * 9 * ADAW + 5 * D; E.PART = C.PART();
        pg8::gemm_phase<pg8::EpiResidTail, pg8::TailOrder, true, true>(glds, g, S, E);
    }
}

template <int KMASK>
__global__ void __launch_bounds__(NTHREADS, 2) fwd_kernel(Args args) {
    extern __shared__ __attribute__((aligned(16))) unsigned char lds_raw[];
    Ctx C; C.a = (ArgsP)__builtin_amdgcn_kernarg_segment_ptr(); C.lds = (float*)(lds_raw + 64);
    volatile LAS unsigned* stw = (volatile LAS unsigned*)(LAS unsigned char*)lds_raw;
    if (threadIdx.x < 4) stw[threadIdx.x] = 0u;
    __syncthreads();
    const int lo = args.ph_lo, hi = args.ph_hi;
    XcdBarrier bar; bar.bar = (unsigned*)(args.ws + WS_CTL); bar.x = 0; bar.st = stw;
    if (hi - lo > 1) bar = xcd_barrier_post((unsigned*)(args.ws + WS_CTL), stw);
    int ph = 0;
#ifndef ONLY
#define ONLY -1
#endif
#ifndef PHMASK
#define PHMASK 0xFFFF
#endif
#ifndef DBL_ID
#define DBL_ID -1
#endif
#define PHASE(id, body) do { if ((ONLY < 0 || ONLY == (id)) && ((PHMASK >> (id)) & 1) && ((KMASK >> (id)) & 1) && ph >= lo && ph < hi) { body; if ((id) == DBL_ID && (((id) != 1 && (id) != 10) || (l & 1))) { xcd_barrier(bar); body; } if (ph + 1 < hi) xcd_barrier(bar); } ++ph; } while (0)
    { const int l = 0; PHASE(0, (ph_prologue(C), conv_prologue(C))); }
    for (int l = 0; l < DEPTH; ++l) {
        PHASE(1, ph_norm(C, l, 0));
        PHASE(2, ph_inproj(C, l));
        PHASE(3, ph_mla(C, l));
        PHASE(4, ph_attn(C, l));
        PHASE(5, ph_branch(C, l));
        PHASE(6, ph_out(C, l));
        PHASE(7, ph_norm(C, l, 1));
        if (l & 1) PHASE(8, ph_assign(C, l));
        PHASE(9, ph_up(C, l));
        PHASE(10, ph_down(C, l));
    }
    { const int l = 0; PHASE(11, ph_norm(C, DEPTH - 1, 2)); }
#undef PHASE
}
constexpr int N_PHASES = 1 + DEPTH * 9 + (DEPTH / 2) + 1;

extern "C" void kernel_launch(void* const* d_in, const int* in_sizes, int n_in, void* d_out, int out_size, void* d_ws, size_t ws_size, hipStream_t stream) {
    static int grid = 0;
    if (grid == 0) {
        if (n_in != 27 || out_size != ML * D || ws_size < WS_END) {
            fprintf(stderr, "kernel_launch: unexpected shapes: n_in %d out %d ws %zu (need %zu)\n", n_in, out_size, ws_size, (size_t)WS_END); grid = -1; return; }
        int dev = 0, cus = 0, per_cu = 0;
        if (hipGetDevice(&dev) != hipSuccess || hipDeviceGetAttribute(&cus, hipDeviceAttributeMultiprocessorCount, dev) != hipSuccess) { grid = -1; return; }
#if ONE_LAUNCH
        if (hipFuncSetAttribute((const void*)fwd_kernel<0xFFFF>, hipFuncAttributeMaxDynamicSharedMemorySize, LDS_BYTES) != hipSuccess) { fprintf(stderr, "kernel_launch: hipFuncSetAttribute failed\n"); grid = -1; return; }
        if (hipOccupancyMaxActiveBlocksPerMultiprocessor(&per_cu, (const void*)fwd_kernel<0xFFFF>, NTHREADS, LDS_BYTES) != hipSuccess || per_cu < 1)
            fprintf(stderr, "kernel_launch: occupancy query reports %d blocks per CU\n", per_cu);
#else
        if (hipFuncSetAttribute((const void*)fwd_kernel<0xFFEF>, hipFuncAttributeMaxDynamicSharedMemorySize, LDS_BYTES) != hipSuccess ||
            hipFuncSetAttribute((const void*)fwd_kernel<0x0010>, hipFuncAttributeMaxDynamicSharedMemorySize, LDS_BYTES) != hipSuccess) { fprintf(stderr, "kernel_launch: hipFuncSetAttribute failed\n"); grid = -1; return; }
#endif
        (void)hipGetLastError();
        grid = cus;
        if (grid != 256) fprintf(stderr, "kernel_launch: %d CUs (built for 256)\n", grid);
        if (grid > 256 || (ML % grid) || (MT % grid)) grid = 256;
    }
    if (grid < 0) return;
    (void)hipMemsetAsync((char*)d_ws + WS_CTL, 0, CTL_BYTES, stream);
#ifdef NAN_POISON
    (void)hipMemsetAsync((char*)d_ws + CTL_BYTES, 0xFF, WS_END - CTL_BYTES, stream);
#endif
    Args a{};
    for (int i = 0; i < 27; ++i) a.in[i] = (const float*)d_in[i];
    a.out = (float*)d_out; a.ws = (unsigned char*)d_ws;
#if ONE_LAUNCH
    a.ph_lo = 0; a.ph_hi = N_PHASES;
    hipLaunchKernelGGL(fwd_kernel<0xFFFF>, dim3(grid), dim3(NTHREADS), LDS_BYTES, stream, a);
#else
    {
        int p = 0;
        auto launch = [&](int id) { a.ph_lo = p; a.ph_hi = p + 1; ++p;
            if (id == 4) hipLaunchKernelGGL(fwd_kernel<0x0010>, dim3(grid), dim3(NTHREADS), LDS_BYTES, stream, a);
            else hipLaunchKernelGGL(fwd_kernel<0xFFEF>, dim3(grid), dim3(NTHREADS), LDS_BYTES, stream, a); };
        launch(0);
        for (int l = 0; l < DEPTH; ++l) { for (int id = 1; id <= 7; ++id) launch(id); if (l & 1) launch(8); launch(9); launch(10); }
        launch(11);
    }
#endif
}
```
